# Optimizing an MI355X kernel written in HIP

```python
import math
import jax, jax.numpy as jnp
from jax import lax
import numpy as np


D_MODEL = 1024
BATCH = 32
SEQ = 2048
DEPTH = 2

PLE_DIM = 256
EPS = 1e-6
ROPE_THETA = 10000.0

CONV_WIDTH = D_MODEL // 2
CONV_K = 3
ATT_HEADS = 8
ATT_HEAD_DIM = 64
ATT_WIDTH = ATT_HEADS * ATT_HEAD_DIM
IDX_HEADS = 8
IDX_DIM = 64
IDX_ROPE_DIM = 32
TOPK_MAX = 256
Q_BLOCK = 128
DN_HEADS = 8
DN_DK = 128
DN_DV = 128
DN_CONV_K = 4
DN_CHUNK = 64
D_FF = -(-8 * D_MODEL // (3 * 256)) * 256

EVEN_SPLITS = (CONV_WIDTH, CONV_WIDTH, CONV_WIDTH, ATT_WIDTH, ATT_WIDTH, ATT_WIDTH, IDX_HEADS * IDX_DIM, IDX_DIM, IDX_HEADS)
EVEN_IN = sum(EVEN_SPLITS)
EVEN_MIX = CONV_WIDTH + ATT_WIDTH
DN_QKV = 2 * DN_HEADS * DN_DK + DN_HEADS * DN_DV
ODD_SPLITS = (DN_QKV, DN_HEADS * DN_DV, DN_HEADS, DN_HEADS)
ODD_IN = sum(ODD_SPLITS)
ODD_MIX = DN_HEADS * DN_DV
N_EVEN = (DEPTH + 1) // 2
N_ODD = DEPTH // 2

kernel_name = 'hybrid_conv_dsa_deltanet_block'


def split_cols(z, sizes):
    return jnp.split(z, [int(c) for c in np.cumsum(sizes)[:-1]], axis=-1)


def rmsnorm(x, g):
    xf = x.astype(jnp.float32)
    y = xf * lax.rsqrt(jnp.mean(xf * xf, axis=-1, keepdims=True) + EPS)
    return (y * g.astype(jnp.float32)).astype(x.dtype)


def layernorm(x, g, b):
    xf = x.astype(jnp.float32)
    mu = jnp.mean(xf, axis=-1, keepdims=True)
    var = jnp.mean(jnp.square(xf - mu), axis=-1, keepdims=True)
    y = (xf - mu) * lax.rsqrt(var + EPS)
    return (y * g.astype(jnp.float32) + b.astype(jnp.float32)).astype(x.dtype)


def l2norm(x):
    return x * lax.rsqrt(jnp.sum(x * x, axis=-1, keepdims=True) + EPS)


def rope_tables(positions, dim):
    inv_freq = 1.0 / (ROPE_THETA ** (jnp.arange(0, dim, 2, dtype=jnp.float32) / dim))
    ang = positions.astype(jnp.float32)[..., None] * inv_freq
    return jnp.cos(ang), jnp.sin(ang)


def apply_rope(x, cos, sin):
    x1, x2 = jnp.split(x.astype(jnp.float32), 2, axis=-1)
    c = cos[:, :, None, :]
    s = sin[:, :, None, :]
    return jnp.concatenate([x1 * c - x2 * s, x1 * s + x2 * c], axis=-1).astype(x.dtype)


def partial_rope(x, cos, sin):
    return jnp.concatenate([apply_rope(x[..., :IDX_ROPE_DIM], cos, sin), x[..., IDX_ROPE_DIM:]], axis=-1)


def causal_dwconv(u, w):
    k, s = w.shape[0], u.shape[1]
    up = jnp.pad(u, ((0, 0), (k - 1, 0), (0, 0)))
    y = up[:, 0:s] * w[0]
    for j in range(1, k):
        y = y + up[:, j:j + s] * w[j]
    return y


def dsa_attention(q, k, v, qi, ki, wi):
    b_, s_, _, dh = q.shape
    topk = min(TOPK_MAX, s_ // 4)
    nb = s_ // Q_BLOCK
    key_pos = jnp.arange(s_)
    wi = wi * (IDX_HEADS ** -0.5 * IDX_DIM ** -0.5)

    def to_blocks(t):
        return jnp.swapaxes(t.reshape(b_, nb, Q_BLOCK, *t.shape[2:]), 0, 1)

    def block(args):
        qb, qib, wib, start = args
        qpos = start + jnp.arange(Q_BLOCK)
        causal = key_pos[None, :] <= qpos[:, None]
        rel = jax.nn.relu(jnp.einsum('bqhd,bkd->bqhk', qib, ki).astype(jnp.float32))
        score = jnp.einsum('bqhk,bqh->bqk', rel, wib.astype(jnp.float32))
        score = jnp.where(causal[None], score, -jnp.inf)
        _, idx = lax.top_k(score, topk)
        valid = idx <= qpos[None, :, None]
        kg = jax.vmap(lambda kk, ii: kk[ii])(k, idx)
        vg = jax.vmap(lambda vv, ii: vv[ii])(v, idx)
        logits = jnp.einsum('bqhd,bqnhd->bhqn', qb, kg).astype(jnp.float32) * (dh ** -0.5)
        logits = jnp.where(valid[:, None], logits, -jnp.inf)
        prob = jax.nn.softmax(logits, axis=-1)
        return jnp.einsum('bhqn,bqnhd->bqhd', prob.astype(vg.dtype), vg)

    starts = jnp.arange(nb, dtype=jnp.int32) * Q_BLOCK
    out = lax.map(block, (to_blocks(q), to_blocks(qi), to_blocks(wi), starts))
    return jnp.swapaxes(out, 0, 1).reshape(b_, s_, q.shape[2], dh)


def conv_dsa_mixer(h, cos_a, sin_a, cos_i, sin_i, w_in, conv_w, q_norm_g, k_norm_g, ik_ln_g, ik_ln_b, w_out):
    b_, s_, _ = h.shape
    zb, zc, zh, q, k, v, qi, ki, wi = split_cols(h @ w_in, EVEN_SPLITS)
    y_a = zb * causal_dwconv(zc * zh, conv_w)
    heads = lambda t: t.reshape(b_, s_, ATT_HEADS, ATT_HEAD_DIM)
    q = apply_rope(rmsnorm(heads(q), q_norm_g), cos_a, sin_a)
    k = apply_rope(rmsnorm(heads(k), k_norm_g), cos_a, sin_a)
    v = heads(v)
    qi = partial_rope(qi.reshape(b_, s_, IDX_HEADS, IDX_DIM), cos_i, sin_i)
    ki = partial_rope(layernorm(ki, ik_ln_g, ik_ln_b)[:, :, None, :], cos_i, sin_i)[:, :, 0, :]
    y_b = dsa_attention(q, k, v, qi, ki, wi).reshape(b_, s_, ATT_WIDTH)
    return jnp.concatenate([y_a, y_b], axis=-1) @ w_out


def gated_delta_rule(q, k, v, g, beta):
    b_, s_, h_, dk = q.shape
    dv = v.shape[-1]
    c = DN_CHUNK
    n = s_ // c
    q = l2norm(q) * (dk ** -0.5)
    k = l2norm(k)

    def chunks(t):
        t = jnp.moveaxis(t, 2, 1)
        return t.reshape(b_, h_, n, c, *t.shape[3:])

    q, k, v, g, beta = chunks(q), chunks(k), chunks(v), chunks(g), chunks(beta)
    g = jnp.cumsum(g, axis=-1)
    tril = jnp.tril(jnp.ones((c, c), bool))
    strict = jnp.tril(jnp.ones((c, c), bool), -1)
    decay = jnp.exp(jnp.where(tril, g[..., :, None] - g[..., None, :], -jnp.inf))
    kb = k * beta[..., None]
    vb = v * beta[..., None]
    m = jnp.where(strict, jnp.einsum('bhncd,bhnsd->bhncs', kb, k) * decay, 0.0)
    eye = jnp.eye(c, dtype=q.dtype)
    t_inv = lax.linalg.triangular_solve(eye + m, jnp.broadcast_to(eye, m.shape), left_side=True, lower=True, unit_diagonal=True)
    u = t_inv @ vb
    w = t_inv @ (kb * jnp.exp(g)[..., None])
    qk = jnp.where(tril, jnp.einsum('bhncd,bhnsd->bhncs', q, k) * decay, 0.0)

    def step(state, xs):
        q_c, k_c, u_c, w_c, g_c, qk_c = xs
        v_new = u_c - w_c @ state
        o = (q_c * jnp.exp(g_c)[..., None]) @ state + qk_c @ v_new
        g_last = g_c[..., -1]
        k_dec = k_c * jnp.exp(g_last[..., None] - g_c)[..., None]
        state = state * jnp.exp(g_last)[..., None, None] + jnp.einsum('bhcd,bhce->bhde', k_dec, v_new)
        return state, o

    xs = tuple(jnp.moveaxis(t, 2, 0) for t in (q, k, u, w, g, qk))
    state0 = jnp.zeros((b_, h_, dk, dv), q.dtype)
    _, o = lax.scan(step, state0, xs)
    o = jnp.moveaxis(o, 0, 2).reshape(b_, h_, s_, dv)
    return jnp.moveaxis(o, 1, 2)


def gated_deltanet_mixer(h, w_in, conv_w, a_log, dt_bias, o_norm_g, w_out):
    b_, s_, _ = h.shape
    qkv, z, a, bt = split_cols(h @ w_in, ODD_SPLITS)
    qkv = jax.nn.silu(causal_dwconv(qkv, conv_w))
    q, k, v = split_cols(qkv, (DN_HEADS * DN_DK, DN_HEADS * DN_DK, DN_HEADS * DN_DV))
    f32 = jnp.float32
    q = q.reshape(b_, s_, DN_HEADS, DN_DK).astype(f32)
    k = k.reshape(b_, s_, DN_HEADS, DN_DK).astype(f32)
    v = v.reshape(b_, s_, DN_HEADS, DN_DV).astype(f32)
    g = -jnp.exp(a_log.astype(f32)) * jax.nn.softplus(a.astype(f32) + dt_bias.astype(f32))
    beta = jax.nn.sigmoid(bt.astype(f32))
    o = gated_delta_rule(q, k, v, g, beta)
    o = rmsnorm(o, o_norm_g) * jax.nn.silu(z.reshape(b_, s_, DN_HEADS, DN_DV).astype(f32))
    return o.reshape(b_, s_, ODD_MIX).astype(h.dtype) @ w_out


def swiglu(h, w_gate, w_up, w_down):
    return (jax.nn.silu(h @ w_gate) * (h @ w_up)) @ w_down


def setup_inputs(seed: int = 0) -> dict:
    key = jax.random.key(seed)
    k = jax.random.split(key, 25)
    f32 = jnp.float32
    nrm = lambda kk, shape, scale: jax.random.normal(kk, shape, f32) * scale
    gain = lambda kk, shape: 1.0 + 0.02 * jax.random.normal(kk, shape, f32)
    x = nrm(k[0], (BATCH, SEQ, D_MODEL), 1.0)
    p = nrm(k[1], (DEPTH, BATCH, SEQ, PLE_DIM), 1.0)
    offset = jax.random.randint(k[2], (BATCH, 1), 0, 4096, dtype=jnp.int32)
    positions = offset + jnp.arange(SEQ, dtype=jnp.int32)[None, :]
    norm_mix_g = gain(k[3], (DEPTH, D_MODEL))
    norm_ffn_g = gain(k[4], (DEPTH, D_MODEL))
    ev_w_in = nrm(k[5], (N_EVEN, D_MODEL, EVEN_IN), D_MODEL ** -0.5)
    ev_conv_w = nrm(k[6], (N_EVEN, CONV_K, CONV_WIDTH), CONV_K ** -0.5)
    ev_q_norm_g = gain(k[7], (N_EVEN, ATT_HEAD_DIM))
    ev_k_norm_g = gain(k[8], (N_EVEN, ATT_HEAD_DIM))
    ev_ik_ln_g = gain(k[9], (N_EVEN, IDX_DIM))
    ev_ik_ln_b = nrm(k[10], (N_EVEN, IDX_DIM), 0.02)
    ev_w_out = nrm(k[11], (N_EVEN, EVEN_MIX, D_MODEL), 0.5 * EVEN_MIX ** -0.5)
    od_w_in = nrm(k[12], (N_ODD, D_MODEL, ODD_IN), D_MODEL ** -0.5)
    od_conv_w = nrm(k[13], (N_ODD, DN_CONV_K, DN_QKV), 0.5)
    dt = jnp.exp(jax.random.uniform(k[14], (N_ODD, DN_HEADS), f32, math.log(1e-3), math.log(1e-1)))
    od_dt_bias = dt + jnp.log(-jnp.expm1(-dt))
    od_a_log = jnp.log(jax.random.uniform(k[15], (N_ODD, DN_HEADS), f32, 1.0, 16.0))
    od_o_norm_g = gain(k[16], (N_ODD, DN_DV))
    od_w_out = nrm(k[17], (N_ODD, ODD_MIX, D_MODEL), 0.5 * ODD_MIX ** -0.5)
    ffn_w_gate = nrm(k[18], (DEPTH, D_MODEL, D_FF), D_MODEL ** -0.5)
    ffn_w_up = nrm(k[19], (DEPTH, D_MODEL, D_FF), D_MODEL ** -0.5)
    ffn_w_down = nrm(k[20], (DEPTH, D_FF, D_MODEL), 0.5 * D_FF ** -0.5)
    ple_w_proj = nrm(k[21], (DEPTH, PLE_DIM, D_MODEL), PLE_DIM ** -0.5)
    ple_post_norm_g = gain(k[22], (DEPTH, D_MODEL))
    ple_norm_g = gain(k[23], (DEPTH, D_MODEL))
    ple_w_gate = nrm(k[24], (DEPTH, D_MODEL, D_MODEL), D_MODEL ** -0.5)
    return {'x': x, 'p': p, 'positions': positions, 'norm_mix_g': norm_mix_g, 'norm_ffn_g': norm_ffn_g,
            'ev_w_in': ev_w_in, 'ev_conv_w': ev_conv_w, 'ev_q_norm_g': ev_q_norm_g, 'ev_k_norm_g': ev_k_norm_g,
            'ev_ik_ln_g': ev_ik_ln_g, 'ev_ik_ln_b': ev_ik_ln_b, 'ev_w_out': ev_w_out,
            'od_w_in': od_w_in, 'od_conv_w': od_conv_w, 'od_a_log': od_a_log, 'od_dt_bias': od_dt_bias,
            'od_o_norm_g': od_o_norm_g, 'od_w_out': od_w_out,
            'ffn_w_gate': ffn_w_gate, 'ffn_w_up': ffn_w_up, 'ffn_w_down': ffn_w_down,
            'ple_w_proj': ple_w_proj, 'ple_post_norm_g': ple_post_norm_g, 'ple_norm_g': ple_norm_g, 'ple_w_gate': ple_w_gate}


def reference(x, p, positions, norm_mix_g, norm_ffn_g, ev_w_in, ev_conv_w, ev_q_norm_g, ev_k_norm_g, ev_ik_ln_g, ev_ik_ln_b, ev_w_out, od_w_in, od_conv_w, od_a_log, od_dt_bias, od_o_norm_g, od_w_out, ffn_w_gate, ffn_w_up, ffn_w_down, ple_w_proj, ple_post_norm_g, ple_norm_g, ple_w_gate):
    cos_a, sin_a = rope_tables(positions, ATT_HEAD_DIM)
    cos_i, sin_i = rope_tables(positions, IDX_ROPE_DIM)
    h = x
    for i in range(DEPTH):
        j = i // 2
        hn = rmsnorm(h, norm_mix_g[i])
        if i % 2 == 0:
            h = h + conv_dsa_mixer(hn, cos_a, sin_a, cos_i, sin_i, ev_w_in[j], ev_conv_w[j], ev_q_norm_g[j],
                                   ev_k_norm_g[j], ev_ik_ln_g[j], ev_ik_ln_b[j], ev_w_out[j])
        else:
            h = h + gated_deltanet_mixer(hn, od_w_in[j], od_conv_w[j], od_a_log[j], od_dt_bias[j],
                                         od_o_norm_g[j], od_w_out[j])
        h = h + swiglu(rmsnorm(h, norm_ffn_g[i]), ffn_w_gate[i], ffn_w_up[i], ffn_w_down[i])
        e = rmsnorm(p[i] @ ple_w_proj[i], ple_post_norm_g[i])
        h = h + e * jax.nn.sigmoid(rmsnorm(h, ple_norm_g[i]) @ ple_w_gate[i])
    return h
```

```cpp
#include <hip/hip_runtime.h>
#include <hip/hip_cooperative_groups.h>
#include <cstdio>
#include <cstdint>
#include <cstddef>
namespace cg = cooperative_groups;
namespace pg8 {
#define PG8_LAS __attribute__((address_space(3)))
typedef unsigned short bf16_t;
typedef short bf16x8 __attribute__((ext_vector_type(8)));
typedef float f32x4 __attribute__((ext_vector_type(4)));
typedef unsigned u32x4 __attribute__((ext_vector_type(4)));
constexpr int BM = 256, BK = 64, HALF = 128, HTB = HALF * BK * 2  , STAGE_BYTES = 8 * HTB, NXCD = 8, WGM = 8;

__host__ __device__ __forceinline__ int lds_byte(int r, int c) { const int st = (r >> 4) * 2 + (c >> 5), rr = r & 15, cc = c & 31, ob = rr * 64 + cc * 2; return st * 1024 + (ob ^ (((ob >> 9) & 1) << 5)); }
__host__ __device__ __forceinline__ void stage_rc(int b, int& R, int& C) { const int st = b / 1024, sb = b % 1024, swz = sb ^ (((sb >> 9) & 1) << 5); R = (st >> 1) * 16 + swz / 64; C = (st & 1) * 32 + (swz % 64) / 2; }
__host__ __device__ __forceinline__ int perm32(int rho) { const int n = rho >> 4, i = rho & 15; return 8 * (i >> 2) + 4 * n + (i & 3); }

struct Unit { int pm, pn; };
struct Gemm { const bf16_t* A; const bf16_t* Bt; int M, N, K; };

struct StaticOrder {
    int nM, nN, nwg, G, c;
    __host__ __device__ void init(int M, int N, int G_, int c_) { nM = M / BM; nN = N / BM; nwg = nM * nN; G = G_; c = c_; }
    __host__ __device__ bool next(int i, Unit& u) const {
        const long L = (long)i * G + c; if (L >= nwg) return false;
        int wgid = (int)L; { const int q = nwg / NXCD, r = nwg % NXCD, xcd = wgid % NXCD, off = wgid / NXCD; wgid = (xcd < r ? xcd * (q + 1) : r * (q + 1) + (xcd - r) * q) + off; }
        const int nig = WGM * nN, gid = wgid / nig, fm = gid * WGM, gsz = (nM - fm) < WGM ? (nM - fm) : WGM;
        u.pm = fm + ((wgid % nig) % gsz); u.pn = (wgid % nig) / gsz; return true;
    }
    __device__ __forceinline__ void a_ready(const Unit&) const {}
    __device__ __forceinline__ void done(const Unit&) const {}
};
typedef float f32x2cv __attribute__((ext_vector_type(2))); typedef __bf16 bf16x2cv __attribute__((ext_vector_type(2)));
__device__ __forceinline__ unsigned cvt_pk_bf16(float lo, float hi) { const f32x2cv v = {lo, hi}; const bf16x2cv b = __builtin_convertvector(v, bf16x2cv); return __builtin_bit_cast(unsigned, b); }
typedef unsigned u32x4e __attribute__((ext_vector_type(4)));
typedef unsigned u32x2e __attribute__((ext_vector_type(2)));
constexpr float NORM_EPS = 1e-6f;
__device__ __forceinline__ float rstd_of(const float* rowsq, int row) { return __builtin_amdgcn_rsqf(rowsq[row] * (1.0f / 1024.0f) + NORM_EPS); }
struct EpiZ {
    static constexpr bool PERM = true, AFTER_DRAIN = false;
    bf16_t* O; int ldc; const float* rowsq;
    __device__ __forceinline__ void operator()(const f32x4 (&acc)[2][2][4][2], const Unit& u, int wr, int wc, int fr, int fq) const {
        const int row0 = u.pm * BM + wr * 64 + fr, col0 = u.pn * BM + wc * 32 + 8 * fq;
#pragma unroll
        for (int ai = 0; ai < 2; ++ai)
#pragma unroll
            for (int m = 0; m < 4; ++m) { const int row = row0 + ai * HALF + m * 16; const float rs = rstd_of(rowsq, row); bf16_t* rowp = O + (size_t)row * ldc + col0;
#pragma unroll
                for (int bj = 0; bj < 2; ++bj) { const f32x4 v0 = acc[ai][bj][m][0] * rs, v1 = acc[ai][bj][m][1] * rs;
                    u32x4e w; w.x = cvt_pk_bf16(v0[0], v0[1]); w.y = cvt_pk_bf16(v0[2], v0[3]); w.z = cvt_pk_bf16(v1[0], v1[1]); w.w = cvt_pk_bf16(v1[2], v1[3]);
                    *(u32x4e*)(rowp + bj * HALF) = w; } asm volatile("" ::: "memory"); }
    }
};
struct EpiEraw {
    static constexpr bool PERM = true, AFTER_DRAIN = false;
    bf16_t* O; float* rowsq;
    __device__ __forceinline__ void operator()(const f32x4 (&acc)[2][2][4][2], const Unit& u, int wr, int wc, int fr, int fq) const {
        const int row0 = u.pm * BM + wr * 64 + fr, col0 = u.pn * BM + wc * 32 + 8 * fq;
#pragma unroll
        for (int ai = 0; ai < 2; ++ai)
#pragma unroll
            for (int m = 0; m < 4; ++m) { const int row = row0 + ai * HALF + m * 16; bf16_t* rowp = O + (size_t)row * 1024 + col0; float ss = 0.f;
#pragma unroll
                for (int bj = 0; bj < 2; ++bj) { const f32x4 v0 = acc[ai][bj][m][0], v1 = acc[ai][bj][m][1];
                    ss += (v0[0] * v0[0] + v0[1] * v0[1]) + (v0[2] * v0[2] + v0[3] * v0[3]) + (v1[0] * v1[0] + v1[1] * v1[1]) + (v1[2] * v1[2] + v1[3] * v1[3]);
                    u32x4e w; w.x = cvt_pk_bf16(v0[0], v0[1]); w.y = cvt_pk_bf16(v0[2], v0[3]); w.z = cvt_pk_bf16(v1[0], v1[1]); w.w = cvt_pk_bf16(v1[2], v1[3]);
                    *(u32x4e*)(rowp + bj * HALF) = w; }
                ss += __shfl_xor(ss, 16); ss += __shfl_xor(ss, 32);
                if (fq == 0) atomicAdd(rowsq + row, ss); asm volatile("" ::: "memory"); }
    }
};
struct EpiSwiGLU {
    static constexpr bool PERM = true, AFTER_DRAIN = false;
    bf16_t* O; const float* rowsq;
    __device__ __forceinline__ void operator()(const f32x4 (&acc)[2][2][4][2], const Unit& u, int wr, int wc, int fr, int fq) const {
        const int row0 = u.pm * BM + wr * 64 + fr, col0 = u.pn * HALF + wc * 32 + 8 * fq;
#pragma unroll
        for (int ai = 0; ai < 2; ++ai)
#pragma unroll
            for (int m = 0; m < 4; ++m) { const int row = row0 + ai * HALF + m * 16; const float rs = rstd_of(rowsq, row); float h[8];
#pragma unroll
                for (int n = 0; n < 2; ++n)
#pragma unroll
                    for (int e = 0; e < 4; ++e) { const float g = acc[ai][0][m][n][e] * rs, up = acc[ai][1][m][n][e] * rs;
                        h[4 * n + e] = g * __builtin_amdgcn_rcpf(1.0f + __builtin_amdgcn_exp2f(-1.4426950408889634f * g)) * up; }
                u32x4e w; w.x = cvt_pk_bf16(h[0], h[1]); w.y = cvt_pk_bf16(h[2], h[3]); w.z = cvt_pk_bf16(h[4], h[5]); w.w = cvt_pk_bf16(h[6], h[7]);
                *(u32x4e*)(O + (size_t)row * 2816 + col0) = w; asm volatile("" ::: "memory"); }
    }
};
struct EpiRes {
    static constexpr bool PERM = false, AFTER_DRAIN = false;
    const float* base; float* out; bf16_t* hb; float* rowsq;
    __device__ __forceinline__ void operator()(const f32x4 (&acc)[2][2][4][2], const Unit& u, int wr, int wc, int fr, int fq) const {
        const int row0 = u.pm * BM + wr * 64 + fr, col0 = u.pn * BM + wc * 32 + 4 * fq;
#pragma unroll
        for (int ai = 0; ai < 2; ++ai)
#pragma unroll
            for (int m = 0; m < 4; ++m) { const int row = row0 + ai * HALF + m * 16; const size_t off = (size_t)row * 1024 + col0; float ss = 0.f;
#pragma unroll
                for (int bj = 0; bj < 2; ++bj)
#pragma unroll
                    for (int n = 0; n < 2; ++n) { const size_t o2 = off + bj * HALF + n * 16; const f32x4 o = *(const f32x4*)(base + o2) + acc[ai][bj][m][n];
                        *(f32x4*)(out + o2) = o; u32x2e w; w.x = cvt_pk_bf16(o[0], o[1]); w.y = cvt_pk_bf16(o[2], o[3]); *(u32x2e*)(hb + o2) = w;
                        ss += (o[0] * o[0] + o[1] * o[1]) + (o[2] * o[2] + o[3] * o[3]); }
                ss += __shfl_xor(ss, 16); ss += __shfl_xor(ss, 32);
                if (fq == 0) atomicAdd(rowsq + row, ss); asm volatile("" ::: "memory"); }
    }
};
struct EpiPle {
    static constexpr bool PERM = false, AFTER_DRAIN = false;
    const float* base; float* out; bf16_t* hb; float* rowsq_out; const bf16_t* eraw; const float* rowsqE; const float* rowsqH; const float* postg;
    __device__ __forceinline__ void operator()(const f32x4 (&acc)[2][2][4][2], const Unit& u, int wr, int wc, int fr, int fq) const {
        const int row0 = u.pm * BM + wr * 64 + fr, col0 = u.pn * BM + wc * 32 + 4 * fq;
#pragma unroll
        for (int ai = 0; ai < 2; ++ai)
#pragma unroll
            for (int m = 0; m < 4; ++m) { const int row = row0 + ai * HALF + m * 16; const size_t off = (size_t)row * 1024 + col0; float ss = 0.f;
                const float rsE = rstd_of(rowsqE, row), rsH = rstd_of(rowsqH, row);
#pragma unroll
                for (int bj = 0; bj < 2; ++bj)
#pragma unroll
                    for (int n = 0; n < 2; ++n) { const size_t o2 = off + bj * HALF + n * 16; const int c2 = col0 + bj * HALF + n * 16;
                        const u32x2e ew = *(const u32x2e*)(eraw + o2); const f32x4 pg = *(const f32x4*)(postg + c2); const f32x4 b = *(const f32x4*)(base + o2);
                        float ev[4] = {__uint_as_float(ew.x << 16), __uint_as_float(ew.x & 0xffff0000u), __uint_as_float(ew.y << 16), __uint_as_float(ew.y & 0xffff0000u)};
                        f32x4 o;
#pragma unroll
                        for (int e = 0; e < 4; ++e) { const float gt = __builtin_amdgcn_rcpf(1.0f + __builtin_amdgcn_exp2f(-1.4426950408889634f * acc[ai][bj][m][n][e] * rsH)); o[e] = b[e] + ev[e] * rsE * pg[e] * gt; }
                        *(f32x4*)(out + o2) = o;
                        if (hb) { u32x2e w; w.x = cvt_pk_bf16(o[0], o[1]); w.y = cvt_pk_bf16(o[2], o[3]); *(u32x2e*)(hb + o2) = w; }
                        ss += (o[0] * o[0] + o[1] * o[1]) + (o[2] * o[2] + o[3] * o[3]); }
                if (rowsq_out) { ss += __shfl_xor(ss, 16); ss += __shfl_xor(ss, 32); if (fq == 0) atomicAdd(rowsq_out + row, ss); } asm volatile("" ::: "memory"); }
    }
};
template <class Epi, class Sched, bool ALIGN_EPI = false, bool SP2 = false>
__device__ __forceinline__ void gemm_phase(PG8_LAS unsigned char* lds, const Gemm g, const Sched& S, const Epi& E, int tid_in) {
    const int tid = tid_in, wid = __builtin_amdgcn_readfirstlane(tid >> 6), lane = tid & 63, wr = wid >> 2, wc = wid & 3, fr = lane & 15, fq = lane >> 4;
    const int K = g.K, nt = K / BK;
    unsigned voffA[2], voffB[2];
#pragma unroll
    for (int i = 0; i < 2; ++i) { int R, C; stage_rc(tid * 16 + i * 8192, R, C); const int Rb = Epi::PERM ? ((R & ~31) + perm32(R & 31)) : R;
        voffA[i] = (unsigned)(R * K + C) * 2u; voffB[i] = (unsigned)(Rb * K + C) * 2u; }
    const size_t kstep = (size_t)(BK * 2);
    const size_t hstep = (size_t)HALF * K * 2;
    const size_t tstep = 2 * hstep;
    const unsigned ldsw = (unsigned)wid * 1024u;
    const int aoff = lds_byte(wr * 64 + fr, fq * 8), boff = lds_byte(wc * 32 + fr, fq * 8);
#define PG8_SA(b, h) (((b) * 2 + (h)) * HTB)
#define PG8_SB(b, h) ((4 + (b) * 2 + (h)) * HTB)
#define PG8_STAGE(bufoff, gbase, voff) do { _Pragma("unroll") for (int _i = 0; _i < 2; ++_i) \
        __builtin_amdgcn_global_load_lds((const unsigned*)((const char*)(gbase) + (voff)[_i]), (PG8_LAS unsigned*)(lds + (bufoff) + ldsw + _i * 8192), 16, 0, 0); } while (0)
#define PG8_LDA(dst, b, h) do { _Pragma("unroll") for (int m = 0; m < 4; ++m) _Pragma("unroll") for (int k = 0; k < 2; ++k) dst[m][k] = *(const PG8_LAS bf16x8*)(lds + PG8_SA(b, h) + aoff + m * 2048 + k * 1024); } while (0)
#define PG8_LDB(dst, b, h) do { _Pragma("unroll") for (int n = 0; n < 2; ++n) _Pragma("unroll") for (int k = 0; k < 2; ++k) dst[n][k] = *(const PG8_LAS bf16x8*)(lds + PG8_SB(b, h) + boff + n * 2048 + k * 1024); } while (0)
#define PG8_MMA(ai, bj, At, Bt) do { __builtin_amdgcn_s_setprio(1); _Pragma("unroll") for (int m = 0; m < 4; ++m) _Pragma("unroll") for (int n = 0; n < 2; ++n) _Pragma("unroll") for (int k = 0; k < 2; ++k) \
        acc[ai][bj][m][n] = __builtin_amdgcn_mfma_f32_16x16x32_bf16(Bt[n][k], At[m][k], acc[ai][bj][m][n], 0, 0, 0); __builtin_amdgcn_s_setprio(0); } while (0)
#define PG8_WAIT_V(n) asm volatile("s_waitcnt vmcnt(" #n ")" ::: "memory")
#define PG8_WAIT_L(n) asm volatile("s_waitcnt lgkmcnt(" #n ")" ::: "memory")
#define PG8_BAR __builtin_amdgcn_s_barrier()
#define PG8_SCHED __builtin_amdgcn_sched_barrier(0)
    Unit cur, nxt; int ui = 0;
    if (!S.next(0, cur)) return;
    f32x4 acc[2][2][4][2];
#pragma unroll
    for (int a = 0; a < 2; ++a)
#pragma unroll
        for (int b = 0; b < 2; ++b)
#pragma unroll
            for (int m = 0; m < 4; ++m)
#pragma unroll
                for (int n = 0; n < 2; ++n) acc[a][b][m][n] = (f32x4){0.f, 0.f, 0.f, 0.f};
    bf16x8 At[4][2], B0[2][2], B1[2][2];
    const char* cA = (const char*)g.A + (size_t)cur.pm * tstep; const char* cB = (const char*)g.Bt + (size_t)cur.pn * tstep;
    S.a_ready(cur);
    if constexpr (SP2) {
        PG8_STAGE(PG8_SB(0, 0), cB, voffB); PG8_STAGE(PG8_SB(0, 1), cB + hstep, voffB); PG8_STAGE(PG8_SA(0, 0), cA, voffA); PG8_STAGE(PG8_SA(0, 1), cA + hstep, voffA);
        if (wr == 1) PG8_BAR;
        PG8_WAIT_V(2); PG8_BAR;
        PG8_STAGE(PG8_SB(1, 0), cB + kstep, voffB); PG8_STAGE(PG8_SA(1, 0), cA + kstep, voffA); PG8_STAGE(PG8_SB(1, 1), cB + hstep + kstep, voffB);
        PG8_WAIT_V(6); PG8_BAR;
    } else {
        PG8_STAGE(PG8_SB(0, 0), cB, voffB); PG8_STAGE(PG8_SA(0, 0), cA, voffA); PG8_STAGE(PG8_SB(0, 1), cB + hstep, voffB); PG8_STAGE(PG8_SA(0, 1), cA + hstep, voffA);
        if (wr == 1) PG8_BAR;
        PG8_WAIT_V(4); PG8_BAR;
        PG8_STAGE(PG8_SB(1, 0), cB + kstep, voffB); PG8_STAGE(PG8_SA(1, 0), cA + kstep, voffA); PG8_STAGE(PG8_SB(1, 1), cB + hstep + kstep, voffB);
        PG8_WAIT_V(6); PG8_BAR;
    }
    for (;;) {
        const bool has_next = S.next(ui + 1, nxt);
        const char* nA = has_next ? (const char*)g.A + (size_t)nxt.pm * tstep : cA; const char* nB = has_next ? (const char*)g.Bt + (size_t)nxt.pn * tstep : cB;
        for (int t = 0; t < nt; t += 2) {
            const bool last = (t == nt - 2);
            const char* a1 = cA + (size_t)(t + 1) * kstep;
            const char* a2 = last ? nA : cA + (size_t)(t + 2) * kstep; const char* b2 = last ? nB : cB + (size_t)(t + 2) * kstep;
            const char* a3 = a2 + kstep; const char* b3 = b2 + kstep;
            if (last && has_next) S.a_ready(nxt);
            if constexpr (SP2) {
            PG8_LDB(B0, 0, 0); PG8_LDB(B1, 0, 1); PG8_SCHED; PG8_LDA(At, 0, 0); PG8_STAGE(PG8_SA(1, 1), a1 + hstep, voffA);
            PG8_WAIT_V(8); PG8_WAIT_L(0); PG8_BAR; PG8_MMA(0, 0, At, B0); PG8_MMA(0, 1, At, B1); PG8_BAR; PG8_SCHED;
            PG8_LDA(At, 0, 1); PG8_STAGE(PG8_SB(0, 0), b2, voffB); PG8_STAGE(PG8_SB(0, 1), b2 + hstep, voffB); PG8_STAGE(PG8_SA(0, 0), a2, voffA);
            PG8_WAIT_V(8); PG8_WAIT_L(0); PG8_BAR; PG8_MMA(1, 0, At, B0); PG8_MMA(1, 1, At, B1); PG8_BAR; PG8_SCHED;
            PG8_LDB(B0, 1, 0); PG8_LDB(B1, 1, 1); PG8_SCHED; PG8_LDA(At, 1, 0); PG8_STAGE(PG8_SA(0, 1), a2 + hstep, voffA);
            PG8_WAIT_V(8); PG8_WAIT_L(0); PG8_BAR; PG8_MMA(0, 0, At, B0); PG8_MMA(0, 1, At, B1); PG8_BAR; PG8_SCHED;
            PG8_LDA(At, 1, 1); PG8_STAGE(PG8_SB(1, 0), b3, voffB); PG8_STAGE(PG8_SB(1, 1), b3 + hstep, voffB); PG8_STAGE(PG8_SA(1, 0), a3, voffA);
            PG8_WAIT_V(8); PG8_WAIT_L(0); PG8_BAR; PG8_MMA(1, 0, At, B0); PG8_MMA(1, 1, At, B1); PG8_BAR; PG8_SCHED;
            } else {
            PG8_LDB(B0, 0, 0); PG8_SCHED; PG8_LDA(At, 0, 0); PG8_STAGE(PG8_SA(1, 1), a1 + hstep, voffA);
            PG8_WAIT_L(8); PG8_BAR; PG8_WAIT_L(0); PG8_MMA(0, 0, At, B0); PG8_BAR; PG8_SCHED;
            PG8_LDB(B1, 0, 1); PG8_STAGE(PG8_SB(0, 0), b2, voffB);
            PG8_BAR; PG8_WAIT_L(0); PG8_MMA(0, 1, At, B1); PG8_BAR;
            PG8_LDA(At, 0, 1); PG8_STAGE(PG8_SA(0, 0), a2, voffA);
            PG8_BAR; PG8_WAIT_L(0); PG8_MMA(1, 0, At, B0); PG8_BAR; PG8_SCHED;
            PG8_STAGE(PG8_SB(0, 1), b2 + hstep, voffB);
            PG8_WAIT_V(6); PG8_BAR; PG8_MMA(1, 1, At, B1); PG8_BAR;
            PG8_LDB(B0, 1, 0); PG8_SCHED; PG8_LDA(At, 1, 0); PG8_STAGE(PG8_SA(0, 1), a2 + hstep, voffA);
            PG8_WAIT_L(8); PG8_BAR; PG8_WAIT_L(0); PG8_MMA(0, 0, At, B0); PG8_BAR; PG8_SCHED;
            PG8_LDB(B1, 1, 1); PG8_STAGE(PG8_SB(1, 0), b3, voffB);
            PG8_BAR; PG8_WAIT_L(0); PG8_MMA(0, 1, At, B1); PG8_BAR;
            PG8_LDA(At, 1, 1); PG8_STAGE(PG8_SA(1, 0), a3, voffA);
            PG8_BAR; PG8_WAIT_L(0); PG8_MMA(1, 0, At, B0); PG8_BAR; PG8_SCHED;
            PG8_STAGE(PG8_SB(1, 1), b3 + hstep, voffB);
            PG8_WAIT_V(6); PG8_BAR; PG8_MMA(1, 1, At, B1); PG8_BAR;
            }
        }
        if constexpr (ALIGN_EPI) { if (wr == 0) PG8_BAR; }
        if constexpr (!Epi::AFTER_DRAIN) { E(acc, cur, wr, wc, fr, fq); S.done(cur); }
        if (!has_next) break;
#pragma unroll
        for (int a = 0; a < 2; ++a)
#pragma unroll
            for (int b = 0; b < 2; ++b)
#pragma unroll
                for (int m = 0; m < 4; ++m)
#pragma unroll
                    for (int n = 0; n < 2; ++n) acc[a][b][m][n] = (f32x4){0.f, 0.f, 0.f, 0.f};
        cur = nxt; cA = nA; cB = nB; ++ui;
        if constexpr (ALIGN_EPI) { if (wr == 1) PG8_BAR; }
    }
    PG8_WAIT_V(0);
    if constexpr (!ALIGN_EPI) { if (wr == 0) PG8_BAR; }
    PG8_BAR;
    if constexpr (Epi::AFTER_DRAIN) { E.fused(acc, cur, wr, wc, fr, fq, lds, wid, lane); S.done(cur); }
#undef PG8_SA
#undef PG8_SB
#undef PG8_STAGE
#undef PG8_LDA
#undef PG8_LDB
#undef PG8_MMA
#undef PG8_WAIT_V
#undef PG8_WAIT_L
#undef PG8_BAR
#undef PG8_SCHED
}
}
#define LAS __attribute__((address_space(3)))
typedef unsigned short bf16;
typedef short bf16x8 __attribute__((ext_vector_type(8)));
typedef float f32x4 __attribute__((ext_vector_type(4)));
typedef float f32x16 __attribute__((ext_vector_type(16)));
typedef unsigned u32x4 __attribute__((ext_vector_type(4)));
typedef unsigned long long u64;
constexpr int NB = 32, SEQ = 2048, DM = 1024, M = NB * SEQ;
constexpr int EV_N = 3656, EV_NP = 3840, OD_N = 4112, OD_NP = 4352, DFF = 2816;
constexpr float EPS = 1e-6f;
constexpr size_t MiB = (size_t)1 << 20;
constexpr size_t WS_RSQ = 0;
constexpr size_t WS_BAR = 3 * MiB;
constexpr size_t WS_W = 4 * MiB;
constexpr size_t W_EVIN = WS_W, W_EVOUT = W_EVIN + (size_t)EV_NP * 1024 * 2, W_ODIN = W_EVOUT + 2 * MiB, W_ODOUT = W_ODIN + (size_t)OD_NP * 1024 * 2;
constexpr size_t W_GU = W_ODOUT + 2 * MiB, W_DN = W_GU + 2 * (size_t)2 * DFF * 1024 * 2, W_PJ = W_DN + 2 * (size_t)DFF * 1024 * 2, W_PG = W_PJ + 2 * (size_t)256 * 1024 * 2, W_END = W_PG + 4 * MiB;
static_assert(W_END <= 62 * MiB, "weights");
constexpr size_t WS_HBA = 62 * MiB, WS_HBB = 190 * MiB, WS_Y = 318 * MiB, WS_Z = 446 * MiB, WS_TAIL = 990 * MiB, WS_END = 1024 * MiB;
constexpr size_t WS_QP = WS_HBA, WS_KP = WS_HBA + 64 * MiB;
constexpr size_t WS_QI = 926 * MiB, WS_KI = WS_TAIL, WS_WI = WS_TAIL + 8 * MiB, WS_MASK = WS_TAIL + 10 * MiB;
constexpr size_t WS_HID = WS_Z, WS_ERAW = WS_Z + 352 * MiB, WS_PB = WS_TAIL;
constexpr size_t WS_TG = WS_HBA, WS_KPD = WS_HBB, WS_VBD = WS_Y, WS_GCUM = WS_TAIL, WS_BETA = WS_TAIL + 2 * MiB;
constexpr int LDS_BYTES = 160 * 1024;
constexpr int NPH = 16;

__device__ __forceinline__ float bf2f(unsigned short b) { return __uint_as_float((unsigned)b << 16); }
__device__ __forceinline__ unsigned pk2(float lo, float hi) { return pg8::cvt_pk_bf16(lo, hi); }
__device__ __forceinline__ unsigned short f2bf(float f) { return (unsigned short)(pk2(f, 0.f) & 0xffffu); }
__device__ __forceinline__ void unpack8(const u32x4 w, float* v) {
    v[0] = __uint_as_float(w.x << 16); v[1] = __uint_as_float(w.x & 0xffff0000u); v[2] = __uint_as_float(w.y << 16); v[3] = __uint_as_float(w.y & 0xffff0000u);
    v[4] = __uint_as_float(w.z << 16); v[5] = __uint_as_float(w.z & 0xffff0000u); v[6] = __uint_as_float(w.w << 16); v[7] = __uint_as_float(w.w & 0xffff0000u); }
__device__ __forceinline__ void ld8(const bf16* p, float* v) { unpack8(*(const u32x4*)p, v); }
__device__ __forceinline__ u32x4 pack8(const float* v) { u32x4 w; w.x = pk2(v[0], v[1]); w.y = pk2(v[2], v[3]); w.z = pk2(v[4], v[5]); w.w = pk2(v[6], v[7]); return w; }
__device__ __forceinline__ void st8(bf16* p, const float* v) { *(u32x4*)p = pack8(v); }
__device__ __forceinline__ float sigmoidf_(float x) { return __builtin_amdgcn_rcpf(1.0f + __builtin_amdgcn_exp2f(-1.4426950408889634f * x)); }
__device__ __forceinline__ float siluf_(float x) { return x * sigmoidf_(x); }
#define MFMA16(a, b, c) __builtin_amdgcn_mfma_f32_16x16x32_bf16((a), (b), (c), 0, 0, 0)
#define MFMA32(a, b, c) __builtin_amdgcn_mfma_f32_32x32x16_bf16((a), (b), (c), 0, 0, 0)

struct Args { const void* in[25]; float* out; unsigned char* ws; int ph_lo, ph_hi, coop, pad; };
typedef const __attribute__((address_space(4))) Args CArgs;
__device__ __forceinline__ CArgs* launder_args(CArgs* p) { asm volatile("" : "+s"(p)); return p; }

__device__ __forceinline__ void transpose_item(const float* W, int K, int N, int NP, bf16* WT, const float* gain, int mode, LAS float* scr, int item, int lane) {
    const int nnb = NP / 32, kb = item / nnb, nb = item % nnb, k0 = 64 * kb, n0 = 32 * nb;
    const int n = n0 + (lane & 31);
#pragma unroll 8
    for (int i = 0; i < 32; ++i) { const int kk = 2 * i + (lane >> 5); float v = 0.f; if (n < N) { v = W[(size_t)(k0 + kk) * N + n]; if (gain) v *= gain[k0 + kk]; } scr[kk * 33 + (lane & 31)] = v; }
    asm volatile("s_waitcnt lgkmcnt(0)" ::: "memory");
    const int c = lane & 7;
    const int r0 = (mode == 0) ? n0 : ((n0 >> 7) * 256 + (mode == 2 ? 128 : 0) + (n0 & 127));
#pragma unroll
    for (int j = 0; j < 4; ++j) { const int nn = (lane >> 3) + 8 * j; const LAS float* s = scr + (8 * c) * 33 + nn;
        u32x4 o; o.x = pk2(s[0 * 33], s[1 * 33]); o.y = pk2(s[2 * 33], s[3 * 33]); o.z = pk2(s[4 * 33], s[5 * 33]); o.w = pk2(s[6 * 33], s[7 * 33]);
        *(u32x4*)(WT + (size_t)(r0 + nn) * K + k0 + 8 * c) = o; }
    asm volatile("s_waitcnt lgkmcnt(0)" ::: "memory");
}
__device__ __forceinline__ float wave_sum(float v) {
#pragma unroll
    for (int o = 1; o < 64; o <<= 1) v += __shfl_xor(v, o);
    return v;
}
__device__ __forceinline__ void prologue(CArgs& a, LAS unsigned char* lds, int tid) {
    const int lane = tid & 63, wave = tid >> 6, gw = blockIdx.x * 8 + wave, NGW = gridDim.x * 8;
    LAS float* scr = (LAS float*)(lds + wave * 16384);
    unsigned char* ws = a.ws;
    int it = gw;
#define DO_MAT(Wp, K_, N_, NP_, dst, gain, mode) { const int cnt = ((K_) / 64) * ((NP_) / 32); for (; it < cnt; it += NGW) transpose_item((Wp), (K_), (N_), (NP_), (bf16*)(dst), (gain), (mode), scr, it, lane); it -= cnt; }
    const float* nmg = (const float*)a.in[3]; const float* nfg = (const float*)a.in[4]; const float* png = (const float*)a.in[23];
    DO_MAT((const float*)a.in[5], 1024, EV_N, EV_NP, ws + W_EVIN, nmg, 0)
    DO_MAT((const float*)a.in[11], 1024, 1024, 1024, ws + W_EVOUT, (const float*)nullptr, 0)
    DO_MAT((const float*)a.in[12], 1024, OD_N, OD_NP, ws + W_ODIN, nmg + 1024, 0)
    DO_MAT((const float*)a.in[17], 1024, 1024, 1024, ws + W_ODOUT, (const float*)nullptr, 0)
    for (int l = 0; l < 2; ++l) {
        DO_MAT((const float*)a.in[18] + (size_t)l * 1024 * DFF, 1024, DFF, DFF, ws + W_GU + (size_t)l * 2 * DFF * 1024 * 2, nfg + l * 1024, 1)
        DO_MAT((const float*)a.in[19] + (size_t)l * 1024 * DFF, 1024, DFF, DFF, ws + W_GU + (size_t)l * 2 * DFF * 1024 * 2, nfg + l * 1024, 2)
        DO_MAT((const float*)a.in[20] + (size_t)l * 1024 * DFF, DFF, 1024, 1024, ws + W_DN + (size_t)l * DFF * 1024 * 2, (const float*)nullptr, 0)
        DO_MAT((const float*)a.in[21] + (size_t)l * 256 * 1024, 256, 1024, 1024, ws + W_PJ + (size_t)l * 256 * 1024 * 2, (const float*)nullptr, 0)
        DO_MAT((const float*)a.in[24] + (size_t)l * 1024 * 1024, 1024, 1024, 1024, ws + W_PG + (size_t)l * 1024 * 1024 * 2, png + l * 1024, 0)
    }
#undef DO_MAT
    const float* x = (const float*)a.in[0]; bf16* xb = (bf16*)(ws + WS_HBB); float* rsq = (float*)(ws + WS_RSQ);
    for (int m = gw; m < M; m += NGW) {
        const f32x4* xr = (const f32x4*)(x + (size_t)m * DM) + lane; unsigned long long* o8 = (unsigned long long*)(xb + (size_t)m * DM) + lane; float s = 0.f;
#pragma unroll
        for (int j = 0; j < 4; ++j) { const f32x4 v = xr[64 * j]; s += (v.x * v.x + v.y * v.y) + (v.z * v.z + v.w * v.w); o8[64 * j] = (unsigned long long)pk2(v.x, v.y) | ((unsigned long long)pk2(v.z, v.w) << 32); }
        s = wave_sum(s); if (lane == 0) rsq[m] = s;
    }
    for (int i = blockIdx.x * 512 + tid; i < 7 * M; i += gridDim.x * 512) rsq[M + i] = 0.f;
}
__device__ __forceinline__ void convert_p(const float* p, bf16* pb, int tid) {
    for (size_t i = (size_t)blockIdx.x * 512 + tid; i < (size_t)M * 256 / 8; i += (size_t)gridDim.x * 512) {
        const f32x4 v0 = *(const f32x4*)(p + i * 8), v1 = *(const f32x4*)(p + i * 8 + 4);
        u32x4 w; w.x = pk2(v0.x, v0.y); w.y = pk2(v0.z, v0.w); w.z = pk2(v1.x, v1.y); w.w = pk2(v1.z, v1.w); *(u32x4*)(pb + i * 8) = w; }
}

__device__ __forceinline__ void rope8(float* x, const LAS float* cs, const LAS float* sn, int i0, int xorm, bool first, bool active) {
#pragma unroll
    for (int e = 0; e < 8; ++e) { const float p = __shfl_xor(x[e], xorm); const float c = cs[i0 + e], s = sn[i0 + e]; const float r = first ? x[e] * c - p * s : p * s + x[e] * c; if (active) x[e] = r; }
}
__device__ __forceinline__ void even_post(CArgs& a, LAS unsigned char* lds, int tid) {
    const int lane = tid & 63, wave = tid >> 6, gw = blockIdx.x * 8 + wave, NGW = gridDim.x * 8, j = lane & 7, col = 8 * lane;
    LAS float* rs = (LAS float*)(lds + wave * 512);
    unsigned char* ws = a.ws;
    const bf16* Z = (const bf16*)(ws + WS_Z); bf16* Y = (bf16*)(ws + WS_Y); bf16* QP = (bf16*)(ws + WS_QP); bf16* KP = (bf16*)(ws + WS_KP);
    bf16* QI = (bf16*)(ws + WS_QI); bf16* KI = (bf16*)(ws + WS_KI); float* WI = (float*)(ws + WS_WI);
    const int* positions = (const int*)a.in[2]; const float* cw = (const float*)a.in[6];
    const float* qg = (const float*)a.in[7]; const float* kg = (const float*)a.in[8]; const float* lng = (const float*)a.in[9]; const float* lnb = (const float*)a.in[10];
    float cw0[8], cw1[8], cw2[8], qgv[8], kgv[8];
#pragma unroll
    for (int e = 0; e < 8; ++e) { cw0[e] = cw[col + e]; cw1[e] = cw[512 + col + e]; cw2[e] = cw[1024 + col + e]; qgv[e] = qg[(col & 63) + e]; kgv[e] = kg[(col & 63) + e]; }
    const float inva = 1.0f / powf(10000.f, (float)(2 * (lane & 31)) / 64.f), invi = 1.0f / powf(10000.f, (float)(2 * (lane & 15)) / 32.f);
    for (int row = gw; row < M; row += NGW) {
        const int t = row & (SEQ - 1); const float pos = (float)positions[row];
        if (lane < 32) { const float ang = pos * inva; rs[lane] = cosf(ang); rs[32 + lane] = sinf(ang); }
        else if (lane < 48) { const float ang = pos * invi; rs[64 + lane - 32] = cosf(ang); rs[80 + lane - 32] = sinf(ang); }
        const bf16* z = Z + (size_t)row * EV_NP;
        float v[8], u0[8], u1[8], u2[8], tmp[8];
        ld8(z + 512 + col, u0); ld8(z + 1024 + col, tmp);
#pragma unroll
        for (int e = 0; e < 8; ++e) { u0[e] *= tmp[e]; u1[e] = 0.f; u2[e] = 0.f; }
        if (t >= 1) { ld8(z - EV_NP + 512 + col, u1); ld8(z - EV_NP + 1024 + col, tmp);
#pragma unroll
            for (int e = 0; e < 8; ++e) u1[e] *= tmp[e]; }
        if (t >= 2) { ld8(z - 2 * EV_NP + 512 + col, u2); ld8(z - 2 * EV_NP + 1024 + col, tmp);
#pragma unroll
            for (int e = 0; e < 8; ++e) u2[e] *= tmp[e]; }
        ld8(z + col, v);
#pragma unroll
        for (int e = 0; e < 8; ++e) v[e] = v[e] * (cw0[e] * u2[e] + cw1[e] * u1[e] + cw2[e] * u0[e]);
        st8(Y + (size_t)row * 1024 + col, v);
#pragma unroll
        for (int which = 0; which < 2; ++which) {
            ld8(z + 1536 + which * 512 + col, v); float ss = 0.f;
#pragma unroll
            for (int e = 0; e < 8; ++e) ss += v[e] * v[e];
            ss += __shfl_xor(ss, 1); ss += __shfl_xor(ss, 2); ss += __shfl_xor(ss, 4);
            const float r = __builtin_amdgcn_rsqf(ss * (1.0f / 64.0f) + EPS);
#pragma unroll
            for (int e = 0; e < 8; ++e) v[e] = v[e] * r * (which ? kgv[e] : qgv[e]);
            rope8(v, rs, rs + 32, 8 * (j & 3), 4, j < 4, true);
            if (which == 0) {
#pragma unroll
                for (int e = 0; e < 8; ++e) v[e] *= 0.125f * 1.4426950408889634f;
                st8(QP + (size_t)row * 512 + col, v);
            } else st8(KP + (size_t)row * 512 + col, v);
        }
        ld8(z + 3072 + col, v);
        rope8(v, rs + 64, rs + 80, 8 * (j & 1), 2, j < 2, j < 4);
        st8(QI + (size_t)row * 512 + col, v);
        ld8(z + 3584 + 8 * j, v);
        { float s = 0.f;
#pragma unroll
            for (int e = 0; e < 8; ++e) s += v[e];
            s += __shfl_xor(s, 1); s += __shfl_xor(s, 2); s += __shfl_xor(s, 4);
            const float mu = s * (1.0f / 64.0f); float q = 0.f;
#pragma unroll
            for (int e = 0; e < 8; ++e) { v[e] -= mu; q += v[e] * v[e]; }
            q += __shfl_xor(q, 1); q += __shfl_xor(q, 2); q += __shfl_xor(q, 4);
            const float r = __builtin_amdgcn_rsqf(q * (1.0f / 64.0f) + EPS);
#pragma unroll
            for (int e = 0; e < 8; ++e) v[e] = v[e] * r * lng[8 * j + e] + lnb[8 * j + e];
            rope8(v, rs + 64, rs + 80, 8 * (j & 1), 2, j < 2, j < 4);
            if (lane < 8) st8(KI + (size_t)row * 64 + 8 * j, v);
        }
        if (lane == 8) { ld8(z + 3648, v); float* wo = WI + (size_t)row * 8;
#pragma unroll
            for (int e = 0; e < 8; ++e) wo[e] = v[e] * 0.044194173824159216f; }
    }
}
#define XB_TMO      128
#define XB_XCNT(j)  (256  + 64 * (j))
#define XB_XSUB(j)  (1280 + 64 * (j))
#define XB_XGEN(j)  (2304 + 64 * (j))
#define XB_TOP      3328
#define XB_TOPGEN   3392
#define XCD_BAR_WORDS 3456
#define XB_SPIN_CAP (1u << 18)

__device__ __forceinline__ unsigned xb_ld(unsigned* p)              { return __hip_atomic_load(p, __ATOMIC_RELAXED, __HIP_MEMORY_SCOPE_AGENT); }
__device__ __forceinline__ unsigned xb_add(unsigned* p, unsigned v) { return __hip_atomic_fetch_add(p, v, __ATOMIC_RELAXED, __HIP_MEMORY_SCOPE_AGENT); }
__device__ __forceinline__ unsigned xb_xcc_id() { return (unsigned)__builtin_amdgcn_s_getreg((3 << 11) | 20) & 0xFu; }
#define XB_SPIN(cond, bar) do { unsigned _sp = 0; while (cond) { __builtin_amdgcn_s_sleep(1); \
    if ((++_sp & 255u) == 0u) { if (xb_ld(&(bar)[XB_TMO])) break; if (_sp > XB_SPIN_CAP) { atomicAdd(&(bar)[XB_TMO], 1u); break; } } } } while (0)

struct XcdBarrier {
    unsigned* bar; unsigned x;
    volatile LAS unsigned* st;
};

__device__ __forceinline__ XcdBarrier xcd_barrier_post(unsigned* bar, volatile LAS unsigned* st) {
    XcdBarrier b; b.bar = bar; b.x = xb_xcc_id(); b.st = st;
    if (threadIdx.x == 0) (void)xb_add(&bar[XB_XCNT(b.x)], 1u);
    return b;
}
__device__ __forceinline__ void xcd_barrier_complete(unsigned* bar, unsigned x, unsigned& nloc, unsigned& nx) {
    const unsigned G = gridDim.x * gridDim.y * gridDim.z;
    unsigned sum, cnt, mine, sp = 0u;
    for (;;) {
        sum = 0u; cnt = 0u; mine = 0u;
#pragma unroll
        for (unsigned j = 0; j < 16; ++j) { const unsigned c = xb_ld(&bar[XB_XCNT(j)]); sum += c; cnt += (c > 0u) ? 1u : 0u; mine = (j == x) ? c : mine; }
        if (sum == G) break;
        __builtin_amdgcn_s_sleep(1);
        if ((++sp & 255u) == 0u) { if (xb_ld(&bar[XB_TMO])) break; if (sp > XB_SPIN_CAP) { atomicAdd(&bar[XB_TMO], 1u); break; } }
    }
    nloc = mine > 0u ? mine : 1u; nx = cnt > 0u ? cnt : 1u;
}

__device__ __forceinline__ void xcd_barrier(const XcdBarrier& b) {
    asm volatile("s_waitcnt vmcnt(0)" ::: "memory");
    __syncthreads();
    if (threadIdx.x == 0) {
        unsigned* bar = b.bar;
        __builtin_amdgcn_s_waitcnt(0);
        unsigned nloc = b.st[0], nx = b.st[1];
        if (nloc == 0u) { xcd_barrier_complete(bar, b.x, nloc, nx); b.st[0] = nloc; b.st[1] = nx; }
        const unsigned old = xb_add(&bar[XB_XSUB(b.x)], 1u);
        const unsigned gen = old / nloc;
        if (old + 1u == (gen + 1u) * nloc) {
            __builtin_amdgcn_fence(__ATOMIC_RELEASE, "agent");
            asm volatile("s_waitcnt vmcnt(0)" ::: "memory");
            const unsigned og = xb_add(&bar[XB_TOP], 1u);
            const unsigned tg = og / nx;
            if (og + 1u == (tg + 1u) * nx) xb_add(&bar[XB_TOPGEN], 1u);
            else XB_SPIN(xb_ld(&bar[XB_TOPGEN]) == tg, bar);
            __builtin_amdgcn_fence(__ATOMIC_ACQUIRE, "agent");
            xb_add(&bar[XB_XGEN(b.x)], 1u);
            asm volatile("s_waitcnt vmcnt(0)" ::: "memory");
        } else {
            XB_SPIN(xb_ld(&bar[XB_XGEN(b.x)]) == gen, bar);
            __builtin_amdgcn_fence(__ATOMIC_ACQUIRE, "agent");
            asm volatile("s_waitcnt vmcnt(0)" ::: "memory");
        }
    }
    __syncthreads();
}
__device__ __forceinline__ void idx_phase(LAS unsigned char* lds, const bf16* QI, const bf16* KI, const float* WI, u64* MASK, int tid) {
    const int lane = tid & 63, wave = __builtin_amdgcn_readfirstlane(tid >> 6), l15 = lane & 15, kq = lane >> 4;
    LAS float* sc = (LAS float*)lds; constexpr int SCP = 2052;
    for (int u = blockIdx.x; u < 4096; u += gridDim.x) {
        const int b = u & 31, r = u >> 5, rnd = r >> 3, sub = r & 7; const int qt = rnd * 8 + ((rnd & 1) ? 7 - sub : sub);
        const int q0 = qt * 16; const size_t rb = (size_t)b * SEQ;
        if (q0 < 256) {
            for (int qq = 2 * wave; qq < 2 * wave + 2; ++qq) { const int t = q0 + qq; if (lane < 32) { const int n = t + 1 - 64 * lane; const u64 w = n <= 0 ? 0ull : (n >= 64 ? ~0ull : ((1ull << n) - 1ull)); MASK[(rb + t) * 32 + lane] = w; } }
            continue;
        }
        bf16x8 Bq[8][2]; float wv[8];
        { const bf16* qp = QI + (rb + q0 + l15) * 512 + kq * 8; const float* wp = WI + (rb + q0 + l15) * 8;
#pragma unroll
            for (int h = 0; h < 8; ++h) { Bq[h][0] = *(const bf16x8*)(qp + h * 64); Bq[h][1] = *(const bf16x8*)(qp + h * 64 + 32); wv[h] = wp[h]; } }
        for (int kt = wave; kt <= qt; kt += 8) {
            const bf16* kp = KI + (rb + 16 * kt + l15) * 64 + kq * 8;
            const bf16x8 A0 = *(const bf16x8*)kp, A1 = *(const bf16x8*)(kp + 32);
            f32x4 s = {0.f, 0.f, 0.f, 0.f};
#pragma unroll
            for (int h = 0; h < 8; ++h) { f32x4 D = {0.f, 0.f, 0.f, 0.f}; D = MFMA16(A0, Bq[h][0], D); D = MFMA16(A1, Bq[h][1], D);
#pragma unroll
                for (int e = 0; e < 4; ++e) s[e] = fmaf(wv[h], fmaxf(D[e], 0.f), s[e]); }
            *(LAS f32x4*)(sc + l15 * SCP + 16 * kt + 4 * kq) = s;
        }
        __syncthreads();
        for (int qq = 2 * wave; qq < 2 * wave + 2; ++qq) {
            const int t = q0 + qq, nrows = (t >> 6) + 1;
            unsigned kv[32];
#pragma unroll
            for (int i = 0; i < 32; ++i) { const int idx = 64 * i + lane; unsigned k = 0u;
                if (idx <= t) { const float f = sc[qq * SCP + idx]; unsigned ub = __float_as_uint(f); if (f == 0.f) ub = 0u; k = (ub & 0x80000000u) ? ~ub : (ub | 0x80000000u); }
                kv[i] = k; }
            unsigned T = 0u;
            for (int bit = 31; bit >= 0; --bit) {
                const unsigned cand = T | (1u << bit); int cnt = 0;
#pragma unroll
                for (int i = 0; i < 32; ++i) if (i < nrows) cnt += __popcll(__ballot(kv[i] >= cand));
                if (cnt >= 256) { T = cand; if (cnt == 256) break; }
            }
            int cgt = 0;
#pragma unroll
            for (int i = 0; i < 32; ++i) if (i < nrows) cgt += __popcll(__ballot(kv[i] > T));
            const int need = 256 - cgt; int tb = 0; u64 word = 0ull; const u64 ltm = (1ull << lane) - 1ull;
#pragma unroll
            for (int i = 0; i < 32; ++i) if (i < nrows) {
                const u64 eqm = __ballot(kv[i] == T); const int rank = tb + __popcll(eqm & ltm);
                const u64 selm = __ballot(kv[i] > T || (kv[i] == T && rank < need)); tb += __popcll(eqm);
                if (lane == i) word = selm; }
            if (lane < 32) MASK[(rb + t) * 32 + lane] = word;
        }
        __syncthreads();
    }
}

__device__ __forceinline__ int crow(int r, int hi) { return (r & 3) + 8 * (r >> 2) + 4 * hi; }
__device__ __forceinline__ void attn_phase(LAS unsigned char* lds, const bf16* QP, const bf16* KP, const bf16* Z0, const u64* MASK, bf16* Y, int tid) {
    const int lane = tid & 63, wave = __builtin_amdgcn_readfirstlane(tid >> 6), l31 = lane & 31, hi = lane >> 5;
    LAS bf16* Kb = (LAS bf16*)lds; LAS bf16* Vt = (LAS bf16*)(lds + 18432); LAS float* lsc = (LAS float*)(lds + 36864) + wave * 32;
    const int lk = tid >> 3, lc = tid & 7;
    for (int u = blockIdx.x; u < 256; u += gridDim.x) {
        const int b = u >> 3, h = u & 7; const size_t rb = (size_t)b * SEQ;
        for (int qb = 7; qb >= 0; --qb) {
            const int q0 = qb * 256, NT = 4 * (qb + 1), qw0 = q0 + 32 * wave, q = qw0 + l31;
            bf16x8 qr[4];
#pragma unroll
            for (int d0 = 0; d0 < 4; ++d0) qr[d0] = *(const bf16x8*)(QP + (rb + q) * 512 + h * 64 + 16 * d0 + 8 * hi);
            f32x16 O0, O1;
#pragma unroll
            for (int r = 0; r < 16; ++r) { O0[r] = 0.f; O1[r] = 0.f; }
            float l = 0.f;
            u32x4 kreg = *(const u32x4*)(KP + (rb + lk) * 512 + h * 64 + 8 * lc), vreg = *(const u32x4*)(Z0 + (rb + lk) * EV_NP + 2560 + h * 64 + 8 * lc);
#define ATT_STORE(buf) do { *(LAS u32x4*)(Kb + (buf) * 4608 + lk * 72 + 8 * lc) = kreg; LAS bf16* vt_ = Vt + (buf) * 4608 + (8 * lc) * 72 + lk; \
            vt_[0] = (bf16)(vreg.x & 0xffffu); vt_[72] = (bf16)(vreg.x >> 16); vt_[144] = (bf16)(vreg.y & 0xffffu); vt_[216] = (bf16)(vreg.y >> 16); \
            vt_[288] = (bf16)(vreg.z & 0xffffu); vt_[360] = (bf16)(vreg.z >> 16); vt_[432] = (bf16)(vreg.w & 0xffffu); vt_[504] = (bf16)(vreg.w >> 16); } while (0)
            ATT_STORE(0);
            __syncthreads();
            for (int t = 0; t < NT; ++t) {
                const int cur = t & 1;
                if (t + 1 < NT) { kreg = *(const u32x4*)(KP + (rb + 64 * (t + 1) + lk) * 512 + h * 64 + 8 * lc); vreg = *(const u32x4*)(Z0 + (rb + 64 * (t + 1) + lk) * EV_NP + 2560 + h * 64 + 8 * lc); }
                if (64 * t <= qw0 + 31) {
                    const u64 mw = MASK[(rb + q) * 32 + t];
                    f32x16 S0, S1;
#pragma unroll
                    for (int r = 0; r < 16; ++r) { S0[r] = 0.f; S1[r] = 0.f; }
                    const LAS bf16* kb = Kb + cur * 4608 + l31 * 72 + 8 * hi;
#pragma unroll
                    for (int d0 = 0; d0 < 4; ++d0) { const bf16x8 a0 = *(const LAS bf16x8*)(kb + 16 * d0), a1 = *(const LAS bf16x8*)(kb + 32 * 72 + 16 * d0);
                        S0 = MFMA32(a0, qr[d0], S0); S1 = MFMA32(a1, qr[d0], S1); }
                    const unsigned mlo = (unsigned)mw >> (4 * hi), mhi = (unsigned)(mw >> 32) >> (4 * hi);
                    float ps = 0.f;
#pragma unroll
                    for (int r = 0; r < 16; ++r) { const int cb = (r & 3) + 8 * (r >> 2);
                        const unsigned b0 = (unsigned)__builtin_amdgcn_sbfe(mlo, cb, 1), b1 = (unsigned)__builtin_amdgcn_sbfe(mhi, cb, 1);
                        const float p0 = __uint_as_float(__float_as_uint(__builtin_amdgcn_exp2f(S0[r])) & b0), p1 = __uint_as_float(__float_as_uint(__builtin_amdgcn_exp2f(S1[r])) & b1);
                        ps += p0 + p1; S0[r] = p0; S1[r] = p1; }
                    l += ps;
                    u32x4 pw[4];
                    pw[0] = (u32x4){pk2(S0[0], S0[1]), pk2(S0[2], S0[3]), pk2(S0[4], S0[5]), pk2(S0[6], S0[7])};
                    pw[1] = (u32x4){pk2(S0[8], S0[9]), pk2(S0[10], S0[11]), pk2(S0[12], S0[13]), pk2(S0[14], S0[15])};
                    pw[2] = (u32x4){pk2(S1[0], S1[1]), pk2(S1[2], S1[3]), pk2(S1[4], S1[5]), pk2(S1[6], S1[7])};
                    pw[3] = (u32x4){pk2(S1[8], S1[9]), pk2(S1[10], S1[11]), pk2(S1[12], S1[13]), pk2(S1[14], S1[15])};
                    const LAS bf16* vt = Vt + cur * 4608 + l31 * 72 + 4 * hi;
#pragma unroll
                    for (int m = 0; m < 4; ++m) { const int base = 16 * (m & 1) + 32 * (m >> 1);
                        const u64 lo0 = *(const LAS u64*)(vt + base), hi0 = *(const LAS u64*)(vt + base + 8), lo1 = *(const LAS u64*)(vt + 32 * 72 + base), hi1 = *(const LAS u64*)(vt + 32 * 72 + base + 8);
                        const u32x4 v0 = {(unsigned)lo0, (unsigned)(lo0 >> 32), (unsigned)hi0, (unsigned)(hi0 >> 32)}, v1 = {(unsigned)lo1, (unsigned)(lo1 >> 32), (unsigned)hi1, (unsigned)(hi1 >> 32)};
                        O0 = MFMA32(__builtin_bit_cast(bf16x8, pw[m]), __builtin_bit_cast(bf16x8, v0), O0);
                        O1 = MFMA32(__builtin_bit_cast(bf16x8, pw[m]), __builtin_bit_cast(bf16x8, v1), O1); }
                }
                if (t + 1 < NT) ATT_STORE(cur ^ 1);
                __syncthreads();
            }
#undef ATT_STORE
            l += __shfl_xor(l, 32);
            if (hi == 0) lsc[l31] = l;
            asm volatile("s_waitcnt lgkmcnt(0)" ::: "memory");
#pragma unroll
            for (int r = 0; r < 16; ++r) { const int qr_ = crow(r, hi); const float rl = __builtin_amdgcn_rcpf(lsc[qr_]);
                bf16* yp = Y + (rb + qw0 + qr_) * 1024 + 512 + h * 64 + l31; yp[0] = f2bf(O0[r] * rl); yp[32] = f2bf(O1[r] * rl); }
        }
    }
}
__device__ __forceinline__ void conv16(const bf16* zbase, int t, const float* cwp, float* out) {
    float acc[16];
#pragma unroll
    for (int e = 0; e < 16; ++e) acc[e] = 0.f;
#pragma unroll
    for (int jt = 0; jt < 4; ++jt) { if (t - 3 + jt >= 0) { float x[16]; ld8(zbase + (ptrdiff_t)(jt - 3) * OD_NP, x); ld8(zbase + (ptrdiff_t)(jt - 3) * OD_NP + 8, x + 8);
            const float* w = cwp + jt * 3072;
#pragma unroll
            for (int e = 0; e < 16; ++e) acc[e] = fmaf(w[e], x[e], acc[e]); } }
#pragma unroll
    for (int e = 0; e < 16; ++e) out[e] = siluf_(acc[e]);
}
__device__ __forceinline__ void dn_prep(CArgs& a, LAS unsigned char* lds, int tid) {
    const int lane = tid & 63, wave = __builtin_amdgcn_readfirstlane(tid >> 6), l15 = lane & 15, kq = lane >> 4;
    unsigned char* ws = a.ws;
    const bf16* Z1 = (const bf16*)(ws + WS_Z); bf16* KPD = (bf16*)(ws + WS_KPD); bf16* VBD = (bf16*)(ws + WS_VBD); bf16* TG = (bf16*)(ws + WS_TG);
    float* GCUM = (float*)(ws + WS_GCUM); float* BETA = (float*)(ws + WS_BETA);
    const float* cw = (const float*)a.in[13]; const float* a_log = (const float*)a.in[14]; const float* dt_bias = (const float*)a.in[15];
    LAS bf16* KN = (LAS bf16*)lds; LAS float* AM = (LAS float*)(lds + 17408); LAS float* GC = (LAS float*)(lds + 17408 + 131072); LAS float* BT = GC + 64;
    const int row = tid >> 3, c8 = tid & 7;
    for (int grp = blockIdx.x; grp < 1024; grp += gridDim.x) {
        const int bh = grp >> 2, ng = grp & 3, b = bh >> 3, h = bh & 7; const size_t rb = (size_t)b * SEQ;
#ifndef NO_PREPA
        for (int ci = 0; ci < 8; ++ci) {
            const int n = ng * 8 + ci, t0 = 64 * n, t = t0 + row;
            if (tid < 64) { const int tt = t0 + tid; const bf16* zr = Z1 + (rb + tt) * OD_NP;
                const float av = bf2f(zr[4096 + h]), bv = bf2f(zr[4104 + h]); const float xx = av + dt_bias[h];
                const float sp = xx > 20.f ? xx : log1pf(expf(xx)); float g = -expf(a_log[h]) * sp; const float beta = sigmoidf_(bv);
#pragma unroll
                for (int o = 1; o < 64; o <<= 1) { const float up = __shfl_up(g, o); if (lane >= o) g += up; }
                GC[tid] = g; BT[tid] = beta; GCUM[(size_t)bh * SEQ + tt] = g; BETA[(size_t)bh * SEQ + tt] = beta; }
            const bf16* zr = Z1 + (rb + t) * OD_NP;
            float x[16];
            conv16(zr + 1024 + h * 128 + 16 * c8, t, cw + 1024 + h * 128 + 16 * c8, x);
            float ss = 0.f;
#pragma unroll
            for (int e = 0; e < 16; ++e) ss += x[e] * x[e];
            ss += __shfl_xor(ss, 1); ss += __shfl_xor(ss, 2); ss += __shfl_xor(ss, 4);
            const float rn = __builtin_amdgcn_rsqf(ss + EPS);
#pragma unroll
            for (int e = 0; e < 16; ++e) x[e] *= rn;
            { const u32x4 w0 = pack8(x), w1 = pack8(x + 8); bf16* kp = KPD + (rb + t) * 1024 + h * 128 + 16 * c8; *(u32x4*)kp = w0; *(u32x4*)(kp + 8) = w1;
              LAS bf16* kl = KN + row * 136 + 16 * c8; *(LAS u32x4*)kl = w0; *(LAS u32x4*)(kl + 8) = w1; }
            conv16(zr + 2048 + h * 128 + 16 * c8, t, cw + 2048 + h * 128 + 16 * c8, x);
            { const float beta = sigmoidf_(bf2f(zr[4104 + h]));
#pragma unroll
              for (int e = 0; e < 16; ++e) x[e] *= beta;
              bf16* vp = VBD + (rb + t) * 1024 + h * 128 + 16 * c8; *(u32x4*)vp = pack8(x); *(u32x4*)(vp + 8) = pack8(x + 8); }
            __syncthreads();
#pragma unroll
            for (int ti = 0; ti < 2; ++ti) { const int id = 2 * wave + ti, ct = id >> 2, st = id & 3; LAS float* am = AM + ci * 4096;
                f32x4 D = {0.f, 0.f, 0.f, 0.f};
                if (st <= ct) {
#pragma unroll
                    for (int ks = 0; ks < 4; ++ks) { const bf16x8 A = *(const LAS bf16x8*)(KN + (16 * ct + l15) * 136 + 32 * ks + 8 * kq), B = *(const LAS bf16x8*)(KN + (16 * st + l15) * 136 + 32 * ks + 8 * kq); D = MFMA16(A, B, D); }
                }
                const int s = 16 * st + l15; const float gs = GC[s];
#pragma unroll
                for (int e = 0; e < 4; ++e) { const int c = 16 * ct + 4 * kq + e; am[c * 64 + s] = (c > s) ? BT[c] * __expf(GC[c] - gs) * D[e] : 0.f; } }
            __syncthreads();
        }
#endif
#ifndef NO_FSUB
        {
            const LAS float* am = AM + wave * 4096; const int n = ng * 8 + wave; bf16* tg = TG + ((size_t)bh * 32 + n) * 4096;
            for (int i = 0; i < 64; ++i) { float acc = (i == lane) ? 1.f : 0.f;
                for (int jj = 0; jj < (i + 3) / 4; ++jj) { const f32x4 a4 = *(const LAS f32x4*)(am + i * 64 + 4 * jj);
#pragma unroll
                    for (int e = 0; e < 4; ++e) acc = fmaf(-a4[e], am[(4 * jj + e) * 64 + lane], acc); }
                ((LAS float*)am)[i * 64 + lane] = acc; tg[i * 64 + lane] = f2bf(acc); }
        }
#endif
        __syncthreads();
    }
}

__device__ __forceinline__ void dn_scan(CArgs& a, LAS unsigned char* lds, int tid) {
    const int lane = tid & 63, wave = __builtin_amdgcn_readfirstlane(tid >> 6); int l15 = lane & 15, kq = lane >> 4;
    unsigned char* ws = a.ws;
    const bf16* Z1 = (const bf16*)(ws + WS_Z); const bf16* KPD = (const bf16*)(ws + WS_KPD); const bf16* VBD = (const bf16*)(ws + WS_VBD); const bf16* TG = (const bf16*)(ws + WS_TG);
    const float* GCUM = (const float*)(ws + WS_GCUM); const float* BETA = (const float*)(ws + WS_BETA); bf16* Y = (bf16*)(ws + WS_Y);
    const float* cw = (const float*)a.in[13]; const float* ong = (const float*)a.in[16];
    LAS bf16* TM = (LAS bf16*)lds; LAS bf16* KN = (LAS bf16*)(lds + 9216); LAS bf16* KT = (LAS bf16*)(lds + 26624); LAS bf16* QN = (LAS bf16*)(lds + 45056);
    LAS bf16* VB = (LAS bf16*)(lds + 62464); LAS bf16* STB = (LAS bf16*)(lds + 80896); LAS bf16* RT = (LAS bf16*)(lds + 115712); LAS bf16* VNT = (LAS bf16*)(lds + 134144);
    LAS float* GC = (LAS float*)(lds + 152576); LAS float* COEF = GC + 64; LAS float* EGL = GC + 128; LAS float* EG = GC + 192; LAS float* ONP = GC + 256;
    LAS bf16* QK = TM; LAS bf16* VNS = VB;
    int row = tid >> 3, c8 = tid & 7;
#define RELAUNDER() asm volatile("" : "+v"(l15), "+v"(kq), "+v"(row), "+v"(c8))
    for (int bh = blockIdx.x; bh < 256; bh += gridDim.x) {
        const int b = bh >> 3, h = bh & 7; const size_t rb = (size_t)b * SEQ;
        f32x4 St[8];
#pragma unroll
        for (int i = 0; i < 8; ++i) St[i] = (f32x4){0.f, 0.f, 0.f, 0.f};
        for (int i = tid; i < 128 * 136 / 8; i += 512) *(LAS u32x4*)(STB + 8 * i) = (u32x4){0u, 0u, 0u, 0u};
        float ongv = ong[16 * wave + l15];
#ifndef DBG_NCH
#define DBG_NCH 32
#endif
        for (int n = 0; n < DBG_NCH; ++n) {
            RELAUNDER();
            const int t0 = 64 * n, t = t0 + row;
            *(LAS u32x4*)(TM + row * 72 + 8 * c8) = *(const u32x4*)(TG + ((size_t)bh * 32 + n) * 4096 + tid * 8);
            { const bf16* kp = KPD + (rb + t) * 1024 + h * 128 + 16 * c8; const u32x4 w0 = *(const u32x4*)kp, w1 = *(const u32x4*)(kp + 8);
              LAS bf16* kl = KN + row * 136 + 16 * c8; *(LAS u32x4*)kl = w0; *(LAS u32x4*)(kl + 8) = w1;
              LAS bf16* ktp = KT + (16 * c8) * 72 + row; const unsigned ww[8] = {w0.x, w0.y, w0.z, w0.w, w1.x, w1.y, w1.z, w1.w};
#pragma unroll
              for (int e = 0; e < 8; ++e) { ktp[(2 * e) * 72] = (bf16)(ww[e] & 0xffffu); ktp[(2 * e + 1) * 72] = (bf16)(ww[e] >> 16); } }
            __builtin_amdgcn_sched_barrier(0);
            { const bf16* vp = VBD + (rb + t) * 1024 + h * 128 + 16 * c8; LAS bf16* vl = VB + row * 136 + 16 * c8; *(LAS u32x4*)vl = *(const u32x4*)vp; *(LAS u32x4*)(vl + 8) = *(const u32x4*)(vp + 8); }
            __builtin_amdgcn_sched_barrier(0);
            { float x[16]; conv16(Z1 + (rb + t) * OD_NP + h * 128 + 16 * c8, t, cw + h * 128 + 16 * c8, x); float ss = 0.f;
#pragma unroll
              for (int e = 0; e < 16; ++e) ss += x[e] * x[e];
              ss += __shfl_xor(ss, 1); ss += __shfl_xor(ss, 2); ss += __shfl_xor(ss, 4);
              const float rn = __builtin_amdgcn_rsqf(ss + EPS) * 0.08838834764831845f;
#pragma unroll
              for (int e = 0; e < 16; ++e) x[e] *= rn;
              LAS bf16* ql = QN + row * 136 + 16 * c8; *(LAS u32x4*)ql = pack8(x); *(LAS u32x4*)(ql + 8) = pack8(x + 8); }
            const float gl = GCUM[(size_t)bh * SEQ + t0 + 63];
            if (tid < 64) { const float gc = GCUM[(size_t)bh * SEQ + t0 + tid], beta = BETA[(size_t)bh * SEQ + t0 + tid]; GC[tid] = gc; COEF[tid] = beta * __expf(gc); EGL[tid] = __expf(gl - gc); EG[tid] = __expf(gc); }
            const float egl_last = __expf(gl);
            __syncthreads(); RELAUNDER();
#pragma nounroll
            for (int st = 0; st < 4; ++st) { f32x4 D = {0.f, 0.f, 0.f, 0.f};
#pragma unroll
                for (int ks = 0; ks < 4; ++ks) { const bf16x8 A = *(const LAS bf16x8*)(STB + (16 * wave + l15) * 136 + 32 * ks + 8 * kq), B = *(const LAS bf16x8*)(KN + (16 * st + l15) * 136 + 32 * ks + 8 * kq); D = MFMA16(A, B, D); }
                const int s = 16 * st + l15; const float coef = COEF[s];
#pragma unroll
                for (int e = 0; e < 4; ++e) { const int dv = 16 * wave + 4 * kq + e; RT[dv * 72 + s] = f2bf(bf2f(VB[s * 136 + dv]) - coef * D[e]); } __builtin_amdgcn_sched_barrier(0); }
            __syncthreads(); RELAUNDER();
#pragma nounroll
            for (int ct = 0; ct < 4; ++ct) { f32x4 D = {0.f, 0.f, 0.f, 0.f};
#pragma unroll
                for (int ks = 0; ks < 2; ++ks) { const bf16x8 A = *(const LAS bf16x8*)(RT + (16 * wave + l15) * 72 + 32 * ks + 8 * kq), B = *(const LAS bf16x8*)(TM + (16 * ct + l15) * 72 + 32 * ks + 8 * kq); D = MFMA16(A, B, D); }
                const int c = 16 * ct + l15; const float egl = EGL[c];
#pragma unroll
                for (int e = 0; e < 4; ++e) { const int dv = 16 * wave + 4 * kq + e; VNT[dv * 72 + c] = f2bf(D[e]); VNS[dv * 72 + c] = f2bf(D[e] * egl); } __builtin_amdgcn_sched_barrier(0); }
            __syncthreads(); RELAUNDER();
#pragma unroll
            for (int ti = 0; ti < 2; ++ti) { const int id = 2 * wave + ti, ct = id >> 2, st = id & 3; f32x4 D = {0.f, 0.f, 0.f, 0.f};
                if (st <= ct) {
#pragma unroll
                    for (int ks = 0; ks < 4; ++ks) { const bf16x8 A = *(const LAS bf16x8*)(QN + (16 * ct + l15) * 136 + 32 * ks + 8 * kq), B = *(const LAS bf16x8*)(KN + (16 * st + l15) * 136 + 32 * ks + 8 * kq); D = MFMA16(A, B, D); }
                }
                const int s = 16 * st + l15; const float gs = GC[s];
#pragma unroll
                for (int e = 0; e < 4; ++e) { const int c = 16 * ct + 4 * kq + e; QK[c * 72 + s] = (c >= s) ? f2bf(D[e] * __expf(GC[c] - gs)) : (bf16)0; } __builtin_amdgcn_sched_barrier(0); }
            f32x4 Oa[4];
#pragma unroll
            for (int ct = 0; ct < 4; ++ct) { f32x4 D = {0.f, 0.f, 0.f, 0.f};
#pragma unroll
                for (int ks = 0; ks < 4; ++ks) { const bf16x8 A = *(const LAS bf16x8*)(QN + (16 * ct + l15) * 136 + 32 * ks + 8 * kq), B = *(const LAS bf16x8*)(STB + (16 * wave + l15) * 136 + 32 * ks + 8 * kq); D = MFMA16(A, B, D); }
#pragma unroll
                for (int e = 0; e < 4; ++e) D[e] *= EG[16 * ct + 4 * kq + e];
                Oa[ct] = D; __builtin_amdgcn_sched_barrier(0); }
            __syncthreads(); RELAUNDER();
#pragma unroll
            for (int ct = 0; ct < 4; ++ct) {
#pragma unroll
                for (int ks = 0; ks < 2; ++ks) { const bf16x8 A = *(const LAS bf16x8*)(QK + (16 * ct + l15) * 72 + 32 * ks + 8 * kq), B = *(const LAS bf16x8*)(VNT + (16 * wave + l15) * 72 + 32 * ks + 8 * kq); Oa[ct] = MFMA16(A, B, Oa[ct]); }
#pragma unroll
                for (int e = 0; e < 4; ++e) { float q2 = Oa[ct][e] * Oa[ct][e]; q2 += __shfl_xor(q2, 1); q2 += __shfl_xor(q2, 2); q2 += __shfl_xor(q2, 4); q2 += __shfl_xor(q2, 8);
                    if (l15 == 0) ONP[(16 * ct + 4 * kq + e) * 8 + wave] = q2; } __builtin_amdgcn_sched_barrier(0); }
#pragma unroll
            for (int dkt = 0; dkt < 8; ++dkt) { f32x4 D = St[dkt] * egl_last;
#pragma unroll
                for (int ks = 0; ks < 2; ++ks) { const bf16x8 A = *(const LAS bf16x8*)(VNS + (16 * wave + l15) * 72 + 32 * ks + 8 * kq), B = *(const LAS bf16x8*)(KT + (16 * dkt + l15) * 72 + 32 * ks + 8 * kq); D = MFMA16(A, B, D); }
                St[dkt] = D;
#pragma unroll
                for (int e = 0; e < 4; ++e) STB[(16 * wave + 4 * kq + e) * 136 + 16 * dkt + l15] = f2bf(D[e]); __builtin_amdgcn_sched_barrier(0); }
            __syncthreads(); RELAUNDER();
#pragma unroll
            for (int ct = 0; ct < 4; ++ct) {
#pragma unroll
                for (int e = 0; e < 4; ++e) { const int c = 16 * ct + 4 * kq + e;
                    const f32x4 pa = *(const LAS f32x4*)(ONP + c * 8), pb = *(const LAS f32x4*)(ONP + c * 8 + 4);
                    const float tot = ((pa[0] + pa[1]) + (pa[2] + pa[3])) + ((pb[0] + pb[1]) + (pb[2] + pb[3]));
                    const float rstd = __builtin_amdgcn_rsqf(tot * (1.0f / 128.0f) + EPS); const int dv = 16 * wave + l15;
                    const float z = bf2f(Z1[(rb + t0 + c) * OD_NP + 3072 + h * 128 + dv]);
#if defined(DBG_Q) && DBG_Q == 1
                    Y[(rb + t0 + c) * 1024 + h * 128 + dv] = f2bf(Oa[ct][e] * 64.f + 0.f * rstd * z); }
#elif defined(DBG_Q) && DBG_Q == 2
                    Y[(rb + t0 + c) * 1024 + h * 128 + dv] = f2bf(bf2f(VNT[dv * 72 + c]) * 64.f + 0.f * rstd * z); }
#elif defined(DBG_Q) && DBG_Q == 5
                    Y[(rb + t0 + c) * 1024 + h * 128 + dv] = f2bf(bf2f(RT[dv * 72 + c]) * 64.f + 0.f * rstd * z); }
#elif defined(DBG_Q) && DBG_Q == 3
                    Y[(rb + t0 + c) * 1024 + h * 128 + dv] = f2bf(bf2f(QK[c * 72 + (dv & 63)]) * 64.f + 0.f * rstd * z); }
#elif defined(DBG_Q) && DBG_Q == 4
                    Y[(rb + t0 + c) * 1024 + h * 128 + dv] = f2bf(bf2f(TM[c * 72 + (dv & 63)]) * 64.f + 0.f * rstd * z); }
#else
                    Y[(rb + t0 + c) * 1024 + h * 128 + dv] = f2bf(Oa[ct][e] * rstd * ongv * siluf_(z)); }
#endif
                __builtin_amdgcn_sched_barrier(0); }
            __syncthreads(); RELAUNDER();
        }
    }
}
#undef RELAUNDER

#if defined(DBG_CUT)
#define DBGCUT(k, ptr, pitch, coloff) do { if ((k) == DBG_CUT) { asm volatile("s_waitcnt vmcnt(0) lgkmcnt(0)" ::: "memory"); cg::this_grid().sync(); \
        const bf16* src_ = (const bf16*)(ptr); float* dst_ = a.out; \
        for (size_t i_ = (size_t)blockIdx.x * 512 + tid; i_ < (size_t)M * 1024; i_ += (size_t)gridDim.x * 512) { const size_t r_ = i_ >> 10, c_ = i_ & 1023; dst_[i_] = bf2f(src_[r_ * (pitch) + (coloff) + c_]); } \
        return; } } while (0)
#else
#define DBGCUT(k, ptr, pitch, coloff) do {} while (0)
#endif
__global__ void __launch_bounds__(512, 2) mega(Args a_unused) {
    extern __shared__ __attribute__((aligned(16))) unsigned char lds_raw[];
    LAS unsigned char* lds = (LAS unsigned char*)lds_raw;
    int tid = threadIdx.x;
    volatile LAS unsigned* xb_st = (volatile LAS unsigned*)(lds + LDS_BYTES - 64);
    if (tid < 16) xb_st[tid] = 0u;
    __syncthreads();
    XcdBarrier bar = xcd_barrier_post((unsigned*)(((CArgs*)__builtin_amdgcn_kernarg_segment_ptr())->ws + WS_BAR), xb_st);
    CArgs* ap = (CArgs*)__builtin_amdgcn_kernarg_segment_ptr();
#define a (*launder_args(ap))
#define ws (a.ws)
#define rsq ((float*)(ws + WS_RSQ))
    const int lo = a.ph_lo, hi = a.ph_hi;
#ifndef PHMASK
#define PHMASK 0xFFFFFFFFu
#endif
#define IN(k) (((PHMASK >> ((k) > 11 ? (k) - 7 : (k))) & 1u) && lo <= (k) && (k) < hi)
#define SEAM(k) do { if (IN(k) && IN((k) + 1)) { if ((k) == 0) { asm volatile("s_waitcnt vmcnt(0) lgkmcnt(0)" ::: "memory"); cg::this_grid().sync(); \
        if (tid == 0) { __builtin_amdgcn_fence(__ATOMIC_ACQUIRE, "agent"); asm volatile("s_waitcnt vmcnt(0)" ::: "memory"); } __syncthreads(); } else { xcd_barrier(bar); } } } while (0)
#define GEMM(EpiT, Aptr, Bptr, N_, K_, ...) do { int k_ = (K_); asm volatile("" : "+s"(k_)); pg8::Gemm g{(const pg8::bf16_t*)(Aptr), (const pg8::bf16_t*)(Bptr), M, (N_), k_}; pg8::StaticOrder S; S.init(M, (N_), (int)gridDim.x, (int)blockIdx.x); \
        pg8::EpiT E{__VA_ARGS__}; pg8::gemm_phase<pg8::EpiT, pg8::StaticOrder, true, true>(lds, g, S, E, tid); } while (0)
    asm volatile("; ==== PHASE 0" : "+v"(tid)); if (IN(0)) { prologue(a, lds, tid); } SEAM(0);
    asm volatile("; ==== PHASE 1" : "+v"(tid)); if (IN(1)) { GEMM(EpiZ, ws + WS_HBB, ws + W_EVIN, EV_NP, 1024, (pg8::bf16_t*)(ws + WS_Z), EV_NP, rsq); } SEAM(1); DBGCUT(1, ws + WS_Z, EV_NP, DBG_COL);
    asm volatile("; ==== PHASE 2" : "+v"(tid)); if (IN(2)) { even_post(a, lds, tid); } SEAM(2); DBGCUT(2, ws + WS_QI, 512, 0);
    asm volatile("; ==== PHASE 3" : "+v"(tid)); if (IN(3)) { idx_phase(lds, (const bf16*)(ws + WS_QI), (const bf16*)(ws + WS_KI), (const float*)(ws + WS_WI), (u64*)(ws + WS_MASK), tid); } SEAM(3);
    asm volatile("; ==== PHASE 4" : "+v"(tid)); if (IN(4)) { attn_phase(lds, (const bf16*)(ws + WS_QP), (const bf16*)(ws + WS_KP), (const bf16*)(ws + WS_Z), (const u64*)(ws + WS_MASK), (bf16*)(ws + WS_Y), tid); } SEAM(4); DBGCUT(4, ws + WS_Y, 1024, 0);
    for (int l = 0; l < 2; ++l) {
        const int pb = 5 + 7 * l;
        const float* base0 = l == 0 ? (const float*)a.in[0] : a.out;
        bf16* hb1 = (bf16*)(ws + (l == 0 ? WS_HBA : WS_HBB)); bf16* hb2 = (bf16*)(ws + (l == 0 ? WS_HBB : WS_HBA));
        float* rs1 = rsq + (size_t)(1 + 3 * l) * M; float* rs2 = rs1 + M; float* rs3 = rs2 + M; float* rsE = rsq + (size_t)(6 + l) * M;
        asm volatile("; ==== PHASE pb" : "+v"(tid)); if (IN(pb)) { convert_p((const float*)a.in[1] + (size_t)l * M * 256, (bf16*)(ws + WS_PB), tid);
            GEMM(EpiRes, ws + WS_Y, ws + (l == 0 ? W_EVOUT : W_ODOUT), 1024, 1024, base0, a.out, (pg8::bf16_t*)hb1, rs1); } SEAM(pb);
        asm volatile("; ==== PHASE pb1" : "+v"(tid)); if (IN(pb + 1)) {
#ifndef NO_SWIGLU
 GEMM(EpiSwiGLU, hb1, ws + W_GU + (size_t)l * 2 * DFF * 1024 * 2, 2 * DFF, 1024, (pg8::bf16_t*)(ws + WS_HID), rs1);
#endif
#ifndef NO_ERAW
            GEMM(EpiEraw, ws + WS_PB, ws + W_PJ + (size_t)l * 256 * 1024 * 2, 1024, 256, (pg8::bf16_t*)(ws + WS_ERAW), rsE);
#endif
 } SEAM(pb + 1);
        asm volatile("; ==== PHASE pb2" : "+v"(tid)); if (IN(pb + 2)) { GEMM(EpiRes, ws + WS_HID, ws + W_DN + (size_t)l * DFF * 1024 * 2, 1024, DFF, (const float*)a.out, a.out, (pg8::bf16_t*)hb2, rs2); } SEAM(pb + 2);
        asm volatile("; ==== PHASE pb3" : "+v"(tid)); if (IN(pb + 3)) { GEMM(EpiPle, hb2, ws + W_PG + (size_t)l * 1024 * 1024 * 2, 1024, 1024, (const float*)a.out, a.out, (pg8::bf16_t*)(l == 0 ? hb1 : nullptr), (l == 0 ? rs3 : nullptr),
                               (const pg8::bf16_t*)(ws + WS_ERAW), rsE, rs2, (const float*)a.in[22] + l * 1024); } SEAM(pb + 3);
        if (l == 0) {
            asm volatile("; ==== PHASE 9" : "+v"(tid)); if (IN(9)) { GEMM(EpiZ, hb1, ws + W_ODIN, OD_NP, 1024, (pg8::bf16_t*)(ws + WS_Z), OD_NP, rs3); } SEAM(9); DBGCUT(9, ws + WS_Z, OD_NP, DBG_COL);
            asm volatile("; ==== PHASE 10" : "+v"(tid)); if (IN(10)) { dn_prep(a, lds, tid); } SEAM(10);
#if defined(DBG_CUT) && DBG_CUT == 10
            { asm volatile("s_waitcnt vmcnt(0) lgkmcnt(0)" ::: "memory"); cg::this_grid().sync();
              const bf16* s1_ = (const bf16*)(ws + WS_KPD); const bf16* s2_ = (const bf16*)(ws + WS_VBD); const float* s3_ = (const float*)(ws + WS_GCUM); float* dst_ = a.out;
              for (size_t i_ = (size_t)blockIdx.x * 512 + tid; i_ < (size_t)M * 1024; i_ += (size_t)gridDim.x * 512) dst_[i_] = bf2f(s1_[i_]) + 3.f * bf2f(s2_[i_]) + (i_ < (size_t)M * 16 ? s3_[i_] : 0.f);
              return; }
#endif
            asm volatile("; ==== PHASE 11" : "+v"(tid)); if (IN(11)) { dn_scan(a, lds, tid); } SEAM(11); DBGCUT(11, ws + WS_Y, 1024, 0);
        }
    }
#undef IN
#undef SEAM
#undef GEMM
#undef a
#undef ws
#undef rsq
}

extern "C" void kernel_launch(void* const* d_in, const int* in_sizes, int n_in, void* d_out, int out_size, void* d_ws, size_t ws_size, hipStream_t stream) {
    static int grid = 0;
    if (grid == 0) {
        if (n_in != 25 || out_size != M * DM || ws_size < WS_END) { fprintf(stderr, "kernel_launch: unexpected problem (n_in %d, out %d, ws %zu)\n", n_in, out_size, ws_size); grid = -1; return; }
        int dev = 0, cus = 0, per_cu = 0;
        hipGetDevice(&dev); hipDeviceGetAttribute(&cus, hipDeviceAttributeMultiprocessorCount, dev);
        hipFuncSetAttribute((const void*)mega, hipFuncAttributeMaxDynamicSharedMemorySize, LDS_BYTES);
        hipOccupancyMaxActiveBlocksPerMultiprocessor(&per_cu, (const void*)mega, 512, LDS_BYTES);
        (void)hipGetLastError();
        if (per_cu < 1) { fprintf(stderr, "kernel_launch: occupancy query says %d blocks per CU\n", per_cu); per_cu = 1; }
        grid = cus;
        if (grid > 256) grid = 256;
    }
    if (grid < 0) return;
    Args a{};
    for (int i = 0; i < 25; ++i) a.in[i] = d_in[i];
    a.out = (float*)d_out; a.ws = (unsigned char*)d_ws; a.ph_lo = 0; a.ph_hi = NPH; a.coop = 1; a.pad = 0;
    if (hipMemsetAsync((char*)d_ws + WS_BAR, 0, 16384, stream) != hipSuccess) { fprintf(stderr, "kernel_launch: memset failed\n"); return; }
#if defined(MK_MULTI)
    for (int p = 0; p < NPH; ++p) { a.ph_lo = p; a.ph_hi = p + 1; hipLaunchKernelGGL(mega, dim3(grid), dim3(512), LDS_BYTES, stream, a); }
#else
    void* args[] = {&a};
    hipError_t e = hipLaunchCooperativeKernel((const void*)mega, dim3(grid), dim3(512), args, LDS_BYTES, stream);
    if (e != hipSuccess) fprintf(stderr, "kernel_launch: cooperative launch failed: %s (grid %d)\n", hipGetErrorString(e), grid);
#endif
}
```

```cpp
#include <hip/hip_runtime.h>
#include <hip/hip_cooperative_groups.h>
#include <cstdio>
#include <cstdint>
#include <cstddef>
namespace cg = cooperative_groups;
namespace pg8 {
#define PG8_LAS __attribute__((address_space(3)))
typedef unsigned short bf16_t;
typedef short bf16x8 __attribute__((ext_vector_type(8)));
typedef float f32x4 __attribute__((ext_vector_type(4)));
typedef unsigned u32x4 __attribute__((ext_vector_type(4)));
constexpr int BM = 256, BK = 64, HALF = 128, HTB = HALF * BK * 2  , STAGE_BYTES = 8 * HTB, NXCD = 8, WGM = 8;

__host__ __device__ __forceinline__ int lds_byte(int r, int c) { const int st = (r >> 4) * 2 + (c >> 5), rr = r & 15, cc = c & 31, ob = rr * 64 + cc * 2; return st * 1024 + (ob ^ (((ob >> 9) & 1) << 5)); }
__host__ __device__ __forceinline__ void stage_rc(int b, int& R, int& C) { const int st = b / 1024, sb = b % 1024, swz = sb ^ (((sb >> 9) & 1) << 5); R = (st >> 1) * 16 + swz / 64; C = (st & 1) * 32 + (swz % 64) / 2; }
__host__ __device__ __forceinline__ int perm32(int rho) { const int n = rho >> 4, i = rho & 15; return 8 * (i >> 2) + 4 * n + (i & 3); }

struct Unit { int pm, pn; };
struct Gemm { const bf16_t* A; const bf16_t* Bt; int M, N, K; };

struct StaticOrder {
    int nM, nN, nwg, G, c;
    __host__ __device__ void init(int M, int N, int G_, int c_) { nM = M / BM; nN = N / BM; nwg = nM * nN; G = G_; c = c_; }
    __host__ __device__ bool next(int i, Unit& u) const {
        const long L = (long)i * G + c; if (L >= nwg) return false;
        int wgid = (int)L; { const int q = nwg / NXCD, r = nwg % NXCD, xcd = wgid % NXCD, off = wgid / NXCD; wgid = (xcd < r ? xcd * (q + 1) : r * (q + 1) + (xcd - r) * q) + off; }
        const int nig = WGM * nN, gid = wgid / nig, fm = gid * WGM, gsz = (nM - fm) < WGM ? (nM - fm) : WGM;
        u.pm = fm + ((wgid % nig) % gsz); u.pn = (wgid % nig) / gsz; return true;
    }
    __device__ __forceinline__ void a_ready(const Unit&) const {}
    __device__ __forceinline__ void done(const Unit&) const {}
};
typedef float f32x2cv __attribute__((ext_vector_type(2))); typedef __bf16 bf16x2cv __attribute__((ext_vector_type(2)));
__device__ __forceinline__ unsigned cvt_pk_bf16(float lo, float hi) { const f32x2cv v = {lo, hi}; const bf16x2cv b = __builtin_convertvector(v, bf16x2cv); return __builtin_bit_cast(unsigned, b); }
typedef unsigned u32x4e __attribute__((ext_vector_type(4)));
typedef unsigned u32x2e __attribute__((ext_vector_type(2)));
constexpr float NORM_EPS = 1e-6f;
__device__ __forceinline__ float rstd_of(const float* rowsq, int row) { return __builtin_amdgcn_rsqf(rowsq[row] * (1.0f / 1024.0f) + NORM_EPS); }
struct EpiZ {
    static constexpr bool PERM = true, AFTER_DRAIN = false;
    bf16_t* O; int ldc; const float* rowsq;
    __device__ __forceinline__ void operator()(const f32x4 (&acc)[2][2][4][2], const Unit& u, int wr, int wc, int fr, int fq) const {
        const int row0 = u.pm * BM + wr * 64 + fr, col0 = u.pn * BM + wc * 32 + 8 * fq;
#pragma unroll
        for (int ai = 0; ai < 2; ++ai)
#pragma unroll
            for (int m = 0; m < 4; ++m) { const int row = row0 + ai * HALF + m * 16; const float rs = rstd_of(rowsq, row); bf16_t* rowp = O + (size_t)row * ldc + col0;
#pragma unroll
                for (int bj = 0; bj < 2; ++bj) { const f32x4 v0 = acc[ai][bj][m][0] * rs, v1 = acc[ai][bj][m][1] * rs;
                    u32x4e w; w.x = cvt_pk_bf16(v0[0], v0[1]); w.y = cvt_pk_bf16(v0[2], v0[3]); w.z = cvt_pk_bf16(v1[0], v1[1]); w.w = cvt_pk_bf16(v1[2], v1[3]);
                    *(u32x4e*)(rowp + bj * HALF) = w; } asm volatile("" ::: "memory"); }
    }
};
struct EpiEraw {
    static constexpr bool PERM = true, AFTER_DRAIN = false;
    bf16_t* O; float* rowsq;
    __device__ __forceinline__ void operator()(const f32x4 (&acc)[2][2][4][2], const Unit& u, int wr, int wc, int fr, int fq) const {
        const int row0 = u.pm * BM + wr * 64 + fr, col0 = u.pn * BM + wc * 32 + 8 * fq;
#pragma unroll
        for (int ai = 0; ai < 2; ++ai)
#pragma unroll
            for (int m = 0; m < 4; ++m) { const int row = row0 + ai * HALF + m * 16; bf16_t* rowp = O + (size_t)row * 1024 + col0; float ss = 0.f;
#pragma unroll
                for (int bj = 0; bj < 2; ++bj) { const f32x4 v0 = acc[ai][bj][m][0], v1 = acc[ai][bj][m][1];
                    ss += (v0[0] * v0[0] + v0[1] * v0[1]) + (v0[2] * v0[2] + v0[3] * v0[3]) + (v1[0] * v1[0] + v1[1] * v1[1]) + (v1[2] * v1[2] + v1[3] * v1[3]);
                    u32x4e w; w.x = cvt_pk_bf16(v0[0], v0[1]); w.y = cvt_pk_bf16(v0[2], v0[3]); w.z = cvt_pk_bf16(v1[0], v1[1]); w.w = cvt_pk_bf16(v1[2], v1[3]);
                    *(u32x4e*)(rowp + bj * HALF) = w; }
                ss += __shfl_xor(ss, 16); ss += __shfl_xor(ss, 32);
                if (fq == 0) atomicAdd(rowsq + row, ss); asm volatile("" ::: "memory"); }
    }
};
struct EpiSwiGLU {
    static constexpr bool PERM = true, AFTER_DRAIN = false;
    bf16_t* O; const float* rowsq;
    __device__ __forceinline__ void operator()(const f32x4 (&acc)[2][2][4][2], const Unit& u, int wr, int wc, int fr, int fq) const {
        const int row0 = u.pm * BM + wr * 64 + fr, col0 = u.pn * HALF + wc * 32 + 8 * fq;
#pragma unroll
        for (int ai = 0; ai < 2; ++ai)
#pragma unroll
            for (int m = 0; m < 4; ++m) { const int row = row0 + ai * HALF + m * 16; const float rs = rstd_of(rowsq, row); float h[8];
#pragma unroll
                for (int n = 0; n < 2; ++n)
#pragma unroll
                    for (int e = 0; e < 4; ++e) { const float g = acc[ai][0][m][n][e] * rs, up = acc[ai][1][m][n][e] * rs;
                        h[4 * n + e] = g * __builtin_amdgcn_rcpf(1.0f + __builtin_amdgcn_exp2f(-1.4426950408889634f * g)) * up; }
                u32x4e w; w.x = cvt_pk_bf16(h[0], h[1]); w.y = cvt_pk_bf16(h[2], h[3]); w.z = cvt_pk_bf16(h[4], h[5]); w.w = cvt_pk_bf16(h[6], h[7]);
                *(u32x4e*)(O + (size_t)row * 2816 + col0) = w; asm volatile("" ::: "memory"); }
    }
};
struct EpiRes {
    static constexpr bool PERM = false, AFTER_DRAIN = false;
    const float* base; float* out; bf16_t* hb; float* rowsq;
    __device__ __forceinline__ void operator()(const f32x4 (&acc)[2][2][4][2], const Unit& u, int wr, int wc, int fr, int fq) const {
        const int row0 = u.pm * BM + wr * 64 + fr, col0 = u.pn * BM + wc * 32 + 4 * fq;
#pragma unroll
        for (int ai = 0; ai < 2; ++ai)
#pragma unroll
            for (int m = 0; m < 4; ++m) { const int row = row0 + ai * HALF + m * 16; const size_t off = (size_t)row * 1024 + col0; float ss = 0.f;
#pragma unroll
                for (int bj = 0; bj < 2; ++bj)
#pragma unroll
                    for (int n = 0; n < 2; ++n) { const size_t o2 = off + bj * HALF + n * 16; const f32x4 o = *(const f32x4*)(base + o2) + acc[ai][bj][m][n];
                        *(f32x4*)(out + o2) = o; u32x2e w; w.x = cvt_pk_bf16(o[0], o[1]); w.y = cvt_pk_bf16(o[2], o[3]); *(u32x2e*)(hb + o2) = w;
                        ss += (o[0] * o[0] + o[1] * o[1]) + (o[2] * o[2] + o[3] * o[3]); }
                ss += __shfl_xor(ss, 16); ss += __shfl_xor(ss, 32);
                if (fq == 0) atomicAdd(rowsq + row, ss); asm volatile("" ::: "memory"); }
    }
};
struct EpiPle {
    static constexpr bool PERM = false, AFTER_DRAIN = false;
    const float* base; float* out; bf16_t* hb; float* rowsq_out; const bf16_t* eraw; const float* rowsqE; const float* rowsqH; const float* postg;
    __device__ __forceinline__ void operator()(const f32x4 (&acc)[2][2][4][2], const Unit& u, int wr, int wc, int fr, int fq) const {
        const int row0 = u.pm * BM + wr * 64 + fr, col0 = u.pn * BM + wc * 32 + 4 * fq;
#pragma unroll
        for (int ai = 0; ai < 2; ++ai)
#pragma unroll
            for (int m = 0; m < 4; ++m) { const int row = row0 + ai * HALF + m * 16; const size_t off = (size_t)row * 1024 + col0; float ss = 0.f;
                const float rsE = rstd_of(rowsqE, row), rsH = rstd_of(rowsqH, row);
#pragma unroll
                for (int bj = 0; bj < 2; ++bj)
#pragma unroll
                    for (int n = 0; n < 2; ++n) { const size_t o2 = off + bj * HALF + n * 16; const int c2 = col0 + bj * HALF + n * 16;
                        const u32x2e ew = *(const u32x2e*)(eraw + o2); const f32x4 pg = *(const f32x4*)(postg + c2); const f32x4 b = *(const f32x4*)(base + o2);
                        float ev[4] = {__uint_as_float(ew.x << 16), __uint_as_float(ew.x & 0xffff0000u), __uint_as_float(ew.y << 16), __uint_as_float(ew.y & 0xffff0000u)};
                        f32x4 o;
#pragma unroll
                        for (int e = 0; e < 4; ++e) { const float gt = __builtin_amdgcn_rcpf(1.0f + __builtin_amdgcn_exp2f(-1.4426950408889634f * acc[ai][bj][m][n][e] * rsH)); o[e] = b[e] + ev[e] * rsE * pg[e] * gt; }
                        *(f32x4*)(out + o2) = o;
                        if (hb) { u32x2e w; w.x = cvt_pk_bf16(o[0], o[1]); w.y = cvt_pk_bf16(o[2], o[3]); *(u32x2e*)(hb + o2) = w; }
                        ss += (o[0] * o[0] + o[1] * o[1]) + (o[2] * o[2] + o[3] * o[3]); }
                if (rowsq_out) { ss += __shfl_xor(ss, 16); ss += __shfl_xor(ss, 32); if (fq == 0) atomicAdd(rowsq_out + row, ss); } asm volatile("" ::: "memory"); }
    }
};
template <class Epi, class Sched, bool ALIGN_EPI = false, bool SP2 = false>
__device__ __forceinline__ void gemm_phase(PG8_LAS unsigned char* lds, const Gemm g, const Sched& S, const Epi& E, int tid_in) {
    const int tid = tid_in, wid = __builtin_amdgcn_readfirstlane(tid >> 6), lane = tid & 63, wr = wid >> 2, wc = wid & 3, fr = lane & 15, fq = lane >> 4;
    const int K = g.K, nt = K / BK;
    unsigned voffA[2], voffB[2];
#pragma unroll
    for (int i = 0; i < 2; ++i) { int R, C; stage_rc(tid * 16 + i * 8192, R, C); const int Rb = Epi::PERM ? ((R & ~31) + perm32(R & 31)) : R;
        voffA[i] = (unsigned)(R * K + C) * 2u; voffB[i] = (unsigned)(Rb * K + C) * 2u; }
    const size_t kstep = (size_t)(BK * 2);
    const size_t hstep = (size_t)HALF * K * 2;
    const size_t tstep = 2 * hstep;
    const unsigned ldsw = (unsigned)wid * 1024u;
    const int aoff = lds_byte(wr * 64 + fr, fq * 8), boff = lds_byte(wc * 32 + fr, fq * 8);
#define PG8_SA(b, h) (((b) * 2 + (h)) * HTB)
#define PG8_SB(b, h) ((4 + (b) * 2 + (h)) * HTB)
#define PG8_STAGE(bufoff, gbase, voff) do { _Pragma("unroll") for (int _i = 0; _i < 2; ++_i) \
        __builtin_amdgcn_global_load_lds((const unsigned*)((const char*)(gbase) + (voff)[_i]), (PG8_LAS unsigned*)(lds + (bufoff) + ldsw + _i * 8192), 16, 0, 0); } while (0)
#define PG8_LDA(dst, b, h) do { _Pragma("unroll") for (int m = 0; m < 4; ++m) _Pragma("unroll") for (int k = 0; k < 2; ++k) dst[m][k] = *(const PG8_LAS bf16x8*)(lds + PG8_SA(b, h) + aoff + m * 2048 + k * 1024); } while (0)
#define PG8_LDB(dst, b, h) do { _Pragma("unroll") for (int n = 0; n < 2; ++n) _Pragma("unroll") for (int k = 0; k < 2; ++k) dst[n][k] = *(const PG8_LAS bf16x8*)(lds + PG8_SB(b, h) + boff + n * 2048 + k * 1024); } while (0)
#define PG8_MMA(ai, bj, At, Bt) do { __builtin_amdgcn_s_setprio(1); _Pragma("unroll") for (int m = 0; m < 4; ++m) _Pragma("unroll") for (int n = 0; n < 2; ++n) _Pragma("unroll") for (int k = 0; k < 2; ++k) \
        acc[ai][bj][m][n] = __builtin_amdgcn_mfma_f32_16x16x32_bf16(Bt[n][k], At[m][k], acc[ai][bj][m][n], 0, 0, 0); __builtin_amdgcn_s_setprio(0); } while (0)
#define PG8_WAIT_V(n) asm volatile("s_waitcnt vmcnt(" #n ")" ::: "memory")
#define PG8_WAIT_L(n) asm volatile("s_waitcnt lgkmcnt(" #n ")" ::: "memory")
#define PG8_BAR __builtin_amdgcn_s_barrier()
#define PG8_SCHED __builtin_amdgcn_sched_barrier(0)
    Unit cur, nxt; int ui = 0;
    if (!S.next(0, cur)) return;
    f32x4 acc[2][2][4][2];
#pragma unroll
    for (int a = 0; a < 2; ++a)
#pragma unroll
        for (int b = 0; b < 2; ++b)
#pragma unroll
            for (int m = 0; m < 4; ++m)
#pragma unroll
                for (int n = 0; n < 2; ++n) acc[a][b][m][n] = (f32x4){0.f, 0.f, 0.f, 0.f};
    bf16x8 At[4][2], B0[2][2], B1[2][2];
    const char* cA = (const char*)g.A + (size_t)cur.pm * tstep; const char* cB = (const char*)g.Bt + (size_t)cur.pn * tstep;
    S.a_ready(cur);
    if constexpr (SP2) {
        PG8_STAGE(PG8_SB(0, 0), cB, voffB); PG8_STAGE(PG8_SB(0, 1), cB + hstep, voffB); PG8_STAGE(PG8_SA(0, 0), cA, voffA); PG8_STAGE(PG8_SA(0, 1), cA + hstep, voffA);
        if (wr == 1) PG8_BAR;
        PG8_WAIT_V(2); PG8_BAR;
        PG8_STAGE(PG8_SB(1, 0), cB + kstep, voffB); PG8_STAGE(PG8_SA(1, 0), cA + kstep, voffA); PG8_STAGE(PG8_SB(1, 1), cB + hstep + kstep, voffB);
        PG8_WAIT_V(6); PG8_BAR;
    } else {
        PG8_STAGE(PG8_SB(0, 0), cB, voffB); PG8_STAGE(PG8_SA(0, 0), cA, voffA); PG8_STAGE(PG8_SB(0, 1), cB + hstep, voffB); PG8_STAGE(PG8_SA(0, 1), cA + hstep, voffA);
        if (wr == 1) PG8_BAR;
        PG8_WAIT_V(4); PG8_BAR;
        PG8_STAGE(PG8_SB(1, 0), cB + kstep, voffB); PG8_STAGE(PG8_SA(1, 0), cA + kstep, voffA); PG8_STAGE(PG8_SB(1, 1), cB + hstep + kstep, voffB);
        PG8_WAIT_V(6); PG8_BAR;
    }
    for (;;) {
        const bool has_next = S.next(ui + 1, nxt);
        const char* nA = has_next ? (const char*)g.A + (size_t)nxt.pm * tstep : cA; const char* nB = has_next ? (const char*)g.Bt + (size_t)nxt.pn * tstep : cB;
        for (int t = 0; t < nt; t += 2) {
            const bool last = (t == nt - 2);
            const char* a1 = cA + (size_t)(t + 1) * kstep;
            const char* a2 = last ? nA : cA + (size_t)(t + 2) * kstep; const char* b2 = last ? nB : cB + (size_t)(t + 2) * kstep;
            const char* a3 = a2 + kstep; const char* b3 = b2 + kstep;
            if (last && has_next) S.a_ready(nxt);
            if constexpr (SP2) {
            PG8_LDB(B0, 0, 0); PG8_LDB(B1, 0, 1); PG8_SCHED; PG8_LDA(At, 0, 0); PG8_STAGE(PG8_SA(1, 1), a1 + hstep, voffA);
            PG8_WAIT_V(8); PG8_WAIT_L(0); PG8_BAR; PG8_MMA(0, 0, At, B0); PG8_MMA(0, 1, At, B1); PG8_BAR; PG8_SCHED;
            PG8_LDA(At, 0, 1); PG8_STAGE(PG8_SB(0, 0), b2, voffB); PG8_STAGE(PG8_SB(0, 1), b2 + hstep, voffB); PG8_STAGE(PG8_SA(0, 0), a2, voffA);
            PG8_WAIT_V(8); PG8_WAIT_L(0); PG8_BAR; PG8_MMA(1, 0, At, B0); PG8_MMA(1, 1, At, B1); PG8_BAR; PG8_SCHED;
            PG8_LDB(B0, 1, 0); PG8_LDB(B1, 1, 1); PG8_SCHED; PG8_LDA(At, 1, 0); PG8_STAGE(PG8_SA(0, 1), a2 + hstep, voffA);
            PG8_WAIT_V(8); PG8_WAIT_L(0); PG8_BAR; PG8_MMA(0, 0, At, B0); PG8_MMA(0, 1, At, B1); PG8_BAR; PG8_SCHED;
            PG8_LDA(At, 1, 1); PG8_STAGE(PG8_SB(1, 0), b3, voffB); PG8_STAGE(PG8_SB(1, 1), b3 + hstep, voffB); PG8_STAGE(PG8_SA(1, 0), a3, voffA);
            PG8_WAIT_V(8); PG8_WAIT_L(0); PG8_BAR; PG8_MMA(1, 0, At, B0); PG8_MMA(1, 1, At, B1); PG8_BAR; PG8_SCHED;
            } else {
            PG8_LDB(B0, 0, 0); PG8_SCHED; PG8_LDA(At, 0, 0); PG8_STAGE(PG8_SA(1, 1), a1 + hstep, voffA);
            PG8_WAIT_L(8); PG8_BAR; PG8_WAIT_L(0); PG8_MMA(0, 0, At, B0); PG8_BAR; PG8_SCHED;
            PG8_LDB(B1, 0, 1); PG8_STAGE(PG8_SB(0, 0), b2, voffB);
            PG8_BAR; PG8_WAIT_L(0); PG8_MMA(0, 1, At, B1); PG8_BAR;
            PG8_LDA(At, 0, 1); PG8_STAGE(PG8_SA(0, 0), a2, voffA);
            PG8_BAR; PG8_WAIT_L(0); PG8_MMA(1, 0, At, B0); PG8_BAR; PG8_SCHED;
            PG8_STAGE(PG8_SB(0, 1), b2 + hstep, voffB);
            PG8_WAIT_V(6); PG8_BAR; PG8_MMA(1, 1, At, B1); PG8_BAR;
            PG8_LDB(B0, 1, 0); PG8_SCHED; PG8_LDA(At, 1, 0); PG8_STAGE(PG8_SA(0, 1), a2 + hstep, voffA);
            PG8_WAIT_L(8); PG8_BAR; PG8_WAIT_L(0); PG8_MMA(0, 0, At, B0); PG8_BAR; PG8_SCHED;
            PG8_LDB(B1, 1, 1); PG8_STAGE(PG8_SB(1, 0), b3, voffB);
            PG8_BAR; PG8_WAIT_L(0); PG8_MMA(0, 1, At, B1); PG8_BAR;
            PG8_LDA(At, 1, 1); PG8_STAGE(PG8_SA(1, 0), a3, voffA);
            PG8_BAR; PG8_WAIT_L(0); PG8_MMA(1, 0, At, B0); PG8_BAR; PG8_SCHED;
            PG8_STAGE(PG8_SB(1, 1), b3 + hstep, voffB);
            PG8_WAIT_V(6); PG8_BAR; PG8_MMA(1, 1, At, B1); PG8_BAR;
            }
        }
        if constexpr (ALIGN_EPI) { if (wr == 0) PG8_BAR; }
        if constexpr (!Epi::AFTER_DRAIN) { E(acc, cur, wr, wc, fr, fq); S.done(cur); }
        if (!has_next) break;
#pragma unroll
        for (int a = 0; a < 2; ++a)
#pragma unroll
            for (int b = 0; b < 2; ++b)
#pragma unroll
                for (int m = 0; m < 4; ++m)
#pragma unroll
                    for (int n = 0; n < 2; ++n) acc[a][b][m][n] = (f32x4){0.f, 0.f, 0.f, 0.f};
        cur = nxt; cA = nA; cB = nB; ++ui;
        if constexpr (ALIGN_EPI) { if (wr == 1) PG8_BAR; }
    }
    PG8_WAIT_V(0);
    if constexpr (!ALIGN_EPI) { if (wr == 0) PG8_BAR; }
    PG8_BAR;
    if constexpr (Epi::AFTER_DRAIN) { E.fused(acc, cur, wr, wc, fr, fq, lds, wid, lane); S.done(cur); }
#undef PG8_SA
#undef PG8_SB
#undef PG8_STAGE
#undef PG8_LDA
#undef PG8_LDB
#undef PG8_MMA
#undef PG8_WAIT_V
#undef PG8_WAIT_L
#undef PG8_BAR
#undef PG8_SCHED
}
}
#define LAS __attribute__((address_space(3)))
typedef unsigned short bf16;
typedef short bf16x8 __attribute__((ext_vector_type(8)));
typedef float f32x4 __attribute__((ext_vector_type(4)));
typedef float f32x16 __attribute__((ext_vector_type(16)));
typedef unsigned u32x4 __attribute__((ext_vector_type(4)));
typedef unsigned long long u64;
constexpr int NB = 32, SEQ = 2048, DM = 1024, M = NB * SEQ;
constexpr int EV_N = 3656, EV_NP = 3840, OD_N = 4112, OD_NP = 4352, DFF = 2816;
constexpr float EPS = 1e-6f;
constexpr size_t MiB = (size_t)1 << 20;
constexpr size_t WS_RSQ = 0;
constexpr size_t WS_BAR = 3 * MiB;
constexpr size_t WS_W = 4 * MiB;
constexpr size_t W_EVIN = WS_W, W_EVOUT = W_EVIN + (size_t)EV_NP * 1024 * 2, W_ODIN = W_EVOUT + 2 * MiB, W_ODOUT = W_ODIN + (size_t)OD_NP * 1024 * 2;
constexpr size_t W_GU = W_ODOUT + 2 * MiB, W_DN = W_GU + 2 * (size_t)2 * DFF * 1024 * 2, W_PJ = W_DN + 2 * (size_t)DFF * 1024 * 2, W_PG = W_PJ + 2 * (size_t)256 * 1024 * 2, W_END = W_PG + 4 * MiB;
static_assert(W_END <= 62 * MiB, "weights");
constexpr size_t WS_HBA = 62 * MiB, WS_HBB = 190 * MiB, WS_Y = 318 * MiB, WS_Z = 446 * MiB, WS_TAIL = 990 * MiB, WS_END = 1024 * MiB;
constexpr size_t WS_QP = WS_HBA, WS_KP = WS_HBA + 64 * MiB;
constexpr size_t WS_QI = 926 * MiB, WS_KI = WS_TAIL, WS_WI = WS_TAIL + 8 * MiB, WS_MASK = WS_TAIL + 10 * MiB;
constexpr size_t WS_HID = WS_Z, WS_ERAW = WS_Z + 352 * MiB, WS_PB = WS_TAIL;
constexpr size_t WS_TG = WS_HBA, WS_KPD = WS_HBB, WS_VBD = WS_Y, WS_GCUM = WS_TAIL, WS_BETA = WS_TAIL + 2 * MiB;
constexpr int LDS_BYTES = 160 * 1024;
constexpr int NPH = 16;

__device__ __forceinline__ float bf2f(unsigned short b) { return __uint_as_float((unsigned)b << 16); }
__device__ __forceinline__ unsigned pk2(float lo, float hi) { return pg8::cvt_pk_bf16(lo, hi); }
__device__ __forceinline__ unsigned short f2bf(float f) { return (unsigned short)(pk2(f, 0.f) & 0xffffu); }
__device__ __forceinline__ void unpack8(const u32x4 w, float* v) {
    v[0] = __uint_as_float(w.x << 16); v[1] = __uint_as_float(w.x & 0xffff0000u); v[2] = __uint_as_float(w.y << 16); v[3] = __uint_as_float(w.y & 0xffff0000u);
    v[4] = __uint_as_float(w.z << 16); v[5] = __uint_as_float(w.z & 0xffff0000u); v[6] = __uint_as_float(w.w << 16); v[7] = __uint_as_float(w.w & 0xffff0000u); }
__device__ __forceinline__ void ld8(const bf16* p, float* v) { unpack8(*(const u32x4*)p, v); }
__device__ __forceinline__ u32x4 pack8(const float* v) { u32x4 w; w.x = pk2(v[0], v[1]); w.y = pk2(v[2], v[3]); w.z = pk2(v[4], v[5]); w.w = pk2(v[6], v[7]); return w; }
__device__ __forceinline__ void st8(bf16* p, const float* v) { *(u32x4*)p = pack8(v); }
__device__ __forceinline__ float sigmoidf_(float x) { return __builtin_amdgcn_rcpf(1.0f + __builtin_amdgcn_exp2f(-1.4426950408889634f * x)); }
__device__ __forceinline__ float siluf_(float x) { return x * sigmoidf_(x); }
#define MFMA16(a, b, c) __builtin_amdgcn_mfma_f32_16x16x32_bf16((a), (b), (c), 0, 0, 0)
#define MFMA32(a, b, c) __builtin_amdgcn_mfma_f32_32x32x16_bf16((a), (b), (c), 0, 0, 0)

struct Args { const void* in[25]; float* out; unsigned char* ws; int ph_lo, ph_hi, coop, pad; };
typedef const __attribute__((address_space(4))) Args CArgs;
__device__ __forceinline__ CArgs* launder_args(CArgs* p) { asm volatile("" : "+s"(p)); return p; }

__device__ __forceinline__ void transpose_item(const float* W, int K, int N, int NP, bf16* WT, const float* gain, int mode, LAS float* scr, int item, int lane) {
    const int nnb = NP / 32, kb = item / nnb, nb = item % nnb, k0 = 64 * kb, n0 = 32 * nb;
    const int n = n0 + (lane & 31);
#pragma unroll 8
    for (int i = 0; i < 32; ++i) { const int kk = 2 * i + (lane >> 5); float v = 0.f; if (n < N) { v = W[(size_t)(k0 + kk) * N + n]; if (gain) v *= gain[k0 + kk]; } scr[kk * 33 + (lane & 31)] = v; }
    asm volatile("s_waitcnt lgkmcnt(0)" ::: "memory");
    const int c = lane & 7;
    const int r0 = (mode == 0) ? n0 : ((n0 >> 7) * 256 + (mode == 2 ? 128 : 0) + (n0 & 127));
#pragma unroll
    for (int j = 0; j < 4; ++j) { const int nn = (lane >> 3) + 8 * j; const LAS float* s = scr + (8 * c) * 33 + nn;
        u32x4 o; o.x = pk2(s[0 * 33], s[1 * 33]); o.y = pk2(s[2 * 33], s[3 * 33]); o.z = pk2(s[4 * 33], s[5 * 33]); o.w = pk2(s[6 * 33], s[7 * 33]);
        *(u32x4*)(WT + (size_t)(r0 + nn) * K + k0 + 8 * c) = o; }
    asm volatile("s_waitcnt lgkmcnt(0)" ::: "memory");
}
__device__ __forceinline__ float wave_sum(float v) {
#pragma unroll
    for (int o = 1; o < 64; o <<= 1) v += __shfl_xor(v, o);
    return v;
}
__device__ __forceinline__ void prologue(CArgs& a, LAS unsigned char* lds, int tid) {
    const int lane = tid & 63, wave = tid >> 6, gw = blockIdx.x * 8 + wave, NGW = gridDim.x * 8;
    LAS float* scr = (LAS float*)(lds + wave * 16384);
    unsigned char* ws = a.ws;
    int it = gw;
#define DO_MAT(Wp, K_, N_, NP_, dst, gain, mode) { const int cnt = ((K_) / 64) * ((NP_) / 32); for (; it < cnt; it += NGW) transpose_item((Wp), (K_), (N_), (NP_), (bf16*)(dst), (gain), (mode), scr, it, lane); it -= cnt; }
    const float* nmg = (const float*)a.in[3]; const float* nfg = (const float*)a.in[4]; const float* png = (const float*)a.in[23];
    DO_MAT((const float*)a.in[5], 1024, EV_N, EV_NP, ws + W_EVIN, nmg, 0)
    DO_MAT((const float*)a.in[11], 1024, 1024, 1024, ws + W_EVOUT, (const float*)nullptr, 0)
    DO_MAT((const float*)a.in[12], 1024, OD_N, OD_NP, ws + W_ODIN, nmg + 1024, 0)
    DO_MAT((const float*)a.in[17], 1024, 1024, 1024, ws + W_ODOUT, (const float*)nullptr, 0)
    for (int l = 0; l < 2; ++l) {
        DO_MAT((const float*)a.in[18] + (size_t)l * 1024 * DFF, 1024, DFF, DFF, ws + W_GU + (size_t)l * 2 * DFF * 1024 * 2, nfg + l * 1024, 1)
        DO_MAT((const float*)a.in[19] + (size_t)l * 1024 * DFF, 1024, DFF, DFF, ws + W_GU + (size_t)l * 2 * DFF * 1024 * 2, nfg + l * 1024, 2)
        DO_MAT((const float*)a.in[20] + (size_t)l * 1024 * DFF, DFF, 1024, 1024, ws + W_DN + (size_t)l * DFF * 1024 * 2, (const float*)nullptr, 0)
        DO_MAT((const float*)a.in[21] + (size_t)l * 256 * 1024, 256, 1024, 1024, ws + W_PJ + (size_t)l * 256 * 1024 * 2, (const float*)nullptr, 0)
        DO_MAT((const float*)a.in[24] + (size_t)l * 1024 * 1024, 1024, 1024, 1024, ws + W_PG + (size_t)l * 1024 * 1024 * 2, png + l * 1024, 0)
    }
#undef DO_MAT
    const float* x = (const float*)a.in[0]; bf16* xb = (bf16*)(ws + WS_HBB); float* rsq = (float*)(ws + WS_RSQ);
    for (int m = gw; m < M; m += NGW) {
        const f32x4* xr = (const f32x4*)(x + (size_t)m * DM) + lane; unsigned long long* o8 = (unsigned long long*)(xb + (size_t)m * DM) + lane; float s = 0.f;
#pragma unroll
        for (int j = 0; j < 4; ++j) { const f32x4 v = xr[64 * j]; s += (v.x * v.x + v.y * v.y) + (v.z * v.z + v.w * v.w); o8[64 * j] = (unsigned long long)pk2(v.x, v.y) | ((unsigned long long)pk2(v.z, v.w) << 32); }
        s = wave_sum(s); if (lane == 0) rsq[m] = s;
    }
    for (int i = blockIdx.x * 512 + tid; i < 7 * M; i += gridDim.x * 512) rsq[M + i] = 0.f;
}
__device__ __forceinline__ void convert_p(const float* p, bf16* pb, int tid) {
    for (size_t i = (size_t)blockIdx.x * 512 + tid; i < (size_t)M * 256 / 8; i += (size_t)gridDim.x * 512) {
        const f32x4 v0 = *(const f32x4*)(p + i * 8), v1 = *(const f32x4*)(p + i * 8 + 4);
        u32x4 w; w.x = pk2(v0.x, v0.y); w.y = pk2(v0.z, v0.w); w.z = pk2(v1.x, v1.y); w.w = pk2(v1.z, v1.w); *(u32x4*)(pb + i * 8) = w; }
}

__device__ __forceinline__ void rope8(float* x, const LAS float* cs, const LAS float* sn, int i0, int xorm, bool first, bool active) {
#pragma unroll
    for (int e = 0; e < 8; ++e) { const float p = __shfl_xor(x[e], xorm); const float c = cs[i0 + e], s = sn[i0 + e]; const float r = first ? x[e] * c - p * s : p * s + x[e] * c; if (active) x[e] = r; }
}
__device__ __forceinline__ void even_post(CArgs& a, LAS unsigned char* lds, int tid) {
    const int lane = tid & 63, wave = tid >> 6, gw = blockIdx.x * 8 + wave, NGW = gridDim.x * 8, j = lane & 7, col = 8 * lane;
    LAS float* rs = (LAS float*)(lds + wave * 512);
    unsigned char* ws = a.ws;
    const bf16* Z = (const bf16*)(ws + WS_Z); bf16* Y = (bf16*)(ws + WS_Y); bf16* QP = (bf16*)(ws + WS_QP); bf16* KP = (bf16*)(ws + WS_KP);
    bf16* QI = (bf16*)(ws + WS_QI); bf16* KI = (bf16*)(ws + WS_KI); float* WI = (float*)(ws + WS_WI);
    const int* positions = (const int*)a.in[2]; const float* cw = (const float*)a.in[6];
    const float* qg = (const float*)a.in[7]; const float* kg = (const float*)a.in[8]; const float* lng = (const float*)a.in[9]; const float* lnb = (const float*)a.in[10];
    float cw0[8], cw1[8], cw2[8], qgv[8], kgv[8];
#pragma unroll
    for (int e = 0; e < 8; ++e) { cw0[e] = cw[col + e]; cw1[e] = cw[512 + col + e]; cw2[e] = cw[1024 + col + e]; qgv[e] = qg[(col & 63) + e]; kgv[e] = kg[(col & 63) + e]; }
    const float inva = 1.0f / powf(10000.f, (float)(2 * (lane & 31)) / 64.f), invi = 1.0f / powf(10000.f, (float)(2 * (lane & 15)) / 32.f);
    for (int row = gw; row < M; row += NGW) {
        const int t = row & (SEQ - 1); const float pos = (float)positions[row];
        if (lane < 32) { const float ang = pos * inva; rs[lane] = cosf(ang); rs[32 + lane] = sinf(ang); }
        else if (lane < 48) { const float ang = pos * invi; rs[64 + lane - 32] = cosf(ang); rs[80 + lane - 32] = sinf(ang); }
        const bf16* z = Z + (size_t)row * EV_NP;
        float v[8], u0[8], u1[8], u2[8], tmp[8];
        ld8(z + 512 + col, u0); ld8(z + 1024 + col, tmp);
#pragma unroll
        for (int e = 0; e < 8; ++e) { u0[e] *= tmp[e]; u1[e] = 0.f; u2[e] = 0.f; }
        if (t >= 1) { ld8(z - EV_NP + 512 + col, u1); ld8(z - EV_NP + 1024 + col, tmp);
#pragma unroll
            for (int e = 0; e < 8; ++e) u1[e] *= tmp[e]; }
        if (t >= 2) { ld8(z - 2 * EV_NP + 512 + col, u2); ld8(z - 2 * EV_NP + 1024 + col, tmp);
#pragma unroll
            for (int e = 0; e < 8; ++e) u2[e] *= tmp[e]; }
        ld8(z + col, v);
#pragma unroll
        for (int e = 0; e < 8; ++e) v[e] = v[e] * (cw0[e] * u2[e] + cw1[e] * u1[e] + cw2[e] * u0[e]);
        st8(Y + (size_t)row * 1024 + col, v);
#pragma unroll
        for (int which = 0; which < 2; ++which) {
            ld8(z + 1536 + which * 512 + col, v); float ss = 0.f;
#pragma unroll
            for (int e = 0; e < 8; ++e) ss += v[e] * v[e];
            ss += __shfl_xor(ss, 1); ss += __shfl_xor(ss, 2); ss += __shfl_xor(ss, 4);
            const float r = __builtin_amdgcn_rsqf(ss * (1.0f / 64.0f) + EPS);
#pragma unroll
            for (int e = 0; e < 8; ++e) v[e] = v[e] * r * (which ? kgv[e] : qgv[e]);
            rope8(v, rs, rs + 32, 8 * (j & 3), 4, j < 4, true);
            if (which == 0) {
#pragma unroll
                for (int e = 0; e < 8; ++e) v[e] *= 0.125f * 1.4426950408889634f;
                st8(QP + (size_t)row * 512 + col, v);
            } else st8(KP + (size_t)row * 512 + col, v);
        }
        ld8(z + 3072 + col, v);
        rope8(v, rs + 64, rs + 80, 8 * (j & 1), 2, j < 2, j < 4);
        st8(QI + (size_t)row * 512 + col, v);
        ld8(z + 3584 + 8 * j, v);
        { float s = 0.f;
#pragma unroll
            for (int e = 0; e < 8; ++e) s += v[e];
            s += __shfl_xor(s, 1); s += __shfl_xor(s, 2); s += __shfl_xor(s, 4);
            const float mu = s * (1.0f / 64.0f); float q = 0.f;
#pragma unroll
            for (int e = 0; e < 8; ++e) { v[e] -= mu; q += v[e] * v[e]; }
            q += __shfl_xor(q, 1); q += __shfl_xor(q, 2); q += __shfl_xor(q, 4);
            const float r = __builtin_amdgcn_rsqf(q * (1.0f / 64.0f) + EPS);
#pragma unroll
            for (int e = 0; e < 8; ++e) v[e] = v[e] * r * lng[8 * j + e] + lnb[8 * j + e];
            rope8(v, rs + 64, rs + 80, 8 * (j & 1), 2, j < 2, j < 4);
            if (lane < 8) st8(KI + (size_t)row * 64 + 8 * j, v);
        }
        if (lane == 8) { ld8(z + 3648, v); float* wo = WI + (size_t)row * 8;
#pragma unroll
            for (int e = 0; e < 8; ++e) wo[e] = v[e] * 0.044194173824159216f; }
    }
}
#define XB_TMO      128
#define XB_XCNT(j)  (256  + 64 * (j))
#define XB_XSUB(j)  (1280 + 64 * (j))
#define XB_XGEN(j)  (2304 + 64 * (j))
#define XB_TOP      3328
#define XB_TOPGEN   3392
#define XCD_BAR_WORDS 3456
#define XB_SPIN_CAP (1u << 18)

__device__ __forceinline__ unsigned xb_ld(unsigned* p)              { return __hip_atomic_load(p, __ATOMIC_RELAXED, __HIP_MEMORY_SCOPE_AGENT); }
__device__ __forceinline__ unsigned xb_add(unsigned* p, unsigned v) { return __hip_atomic_fetch_add(p, v, __ATOMIC_RELAXED, __HIP_MEMORY_SCOPE_AGENT); }
__device__ __forceinline__ unsigned xb_xcc_id() { return (unsigned)__builtin_amdgcn_s_getreg((3 << 11) | 20) & 0xFu; }
#define XB_SPIN(cond, bar) do { unsigned _sp = 0; while (cond) { __builtin_amdgcn_s_sleep(1); \
    if ((++_sp & 255u) == 0u) { if (xb_ld(&(bar)[XB_TMO])) break; if (_sp > XB_SPIN_CAP) { atomicAdd(&(bar)[XB_TMO], 1u); break; } } } } while (0)

struct XcdBarrier {
    unsigned* bar; unsigned x;
    volatile LAS unsigned* st;
};

__device__ __forceinline__ XcdBarrier xcd_barrier_post(unsigned* bar, volatile LAS unsigned* st) {
    XcdBarrier b; b.bar = bar; b.x = xb_xcc_id(); b.st = st;
    if (threadIdx.x == 0) (void)xb_add(&bar[XB_XCNT(b.x)], 1u);
    return b;
}
__device__ __forceinline__ void xcd_barrier_complete(unsigned* bar, unsigned x, unsigned& nloc, unsigned& nx) {
    const unsigned G = gridDim.x * gridDim.y * gridDim.z;
    unsigned sum, cnt, mine, sp = 0u;
    for (;;) {
        sum = 0u; cnt = 0u; mine = 0u;
#pragma unroll
        for (unsigned j = 0; j < 16; ++j) { const unsigned c = xb_ld(&bar[XB_XCNT(j)]); sum += c; cnt += (c > 0u) ? 1u : 0u; mine = (j == x) ? c : mine; }
        if (sum == G) break;
        __builtin_amdgcn_s_sleep(1);
        if ((++sp & 255u) == 0u) { if (xb_ld(&bar[XB_TMO])) break; if (sp > XB_SPIN_CAP) { atomicAdd(&bar[XB_TMO], 1u); break; } }
    }
    nloc = mine > 0u ? mine : 1u; nx = cnt > 0u ? cnt : 1u;
}

__device__ __forceinline__ void xcd_barrier(const XcdBarrier& b) {
    asm volatile("s_waitcnt vmcnt(0)" ::: "memory");
    __syncthreads();
    if (threadIdx.x == 0) {
        unsigned* bar = b.bar;
        __builtin_amdgcn_s_waitcnt(0);
        unsigned nloc = b.st[0], nx = b.st[1];
        if (nloc == 0u) { xcd_barrier_complete(bar, b.x, nloc, nx); b.st[0] = nloc; b.st[1] = nx; }
        const unsigned old = xb_add(&bar[XB_XSUB(b.x)], 1u);
        const unsigned gen = old / nloc;
        if (old + 1u == (gen + 1u) * nloc) {
            __builtin_amdgcn_fence(__ATOMIC_RELEASE, "agent");
            asm volatile("s_waitcnt vmcnt(0)" ::: "memory");
            const unsigned og = xb_add(&bar[XB_TOP], 1u);
            const unsigned tg = og / nx;
            if (og + 1u == (tg + 1u) * nx) xb_add(&bar[XB_TOPGEN], 1u);
            else XB_SPIN(xb_ld(&bar[XB_TOPGEN]) == tg, bar);
            __builtin_amdgcn_fence(__ATOMIC_ACQUIRE, "agent");
            xb_add(&bar[XB_XGEN(b.x)], 1u);
            asm volatile("s_waitcnt vmcnt(0)" ::: "memory");
        } else {
            XB_SPIN(xb_ld(&bar[XB_XGEN(b.x)]) == gen, bar);
            __builtin_amdgcn_fence(__ATOMIC_ACQUIRE, "agent");
            asm volatile("s_waitcnt vmcnt(0)" ::: "memory");
        }
    }
    __syncthreads();
}
__device__ __forceinline__ void idx_phase(LAS unsigned char* lds, const bf16* QI, const bf16* KI, const float* WI, u64* MASK, int tid) {
    const int lane = tid & 63, wave = __builtin_amdgcn_readfirstlane(tid >> 6), l15 = lane & 15, kq = lane >> 4;
    LAS float* sc = (LAS float*)lds; constexpr int SCP = 2052;
    for (int u = blockIdx.x; u < 4096; u += gridDim.x) {
        const int b = u & 31, r = u >> 5, rnd = r >> 3, sub = r & 7; const int qt = rnd * 8 + ((rnd & 1) ? 7 - sub : sub);
        const int q0 = qt * 16; const size_t rb = (size_t)b * SEQ;
        if (q0 < 256) {
            for (int qq = 2 * wave; qq < 2 * wave + 2; ++qq) { const int t = q0 + qq; if (lane < 32) { const int n = t + 1 - 64 * lane; const u64 w = n <= 0 ? 0ull : (n >= 64 ? ~0ull : ((1ull << n) - 1ull)); MASK[(rb + t) * 32 + lane] = w; } }
            continue;
        }
        bf16x8 Bq[8][2]; float wv[8];
        { const bf16* qp = QI + (rb + q0 + l15) * 512 + kq * 8; const float* wp = WI + (rb + q0 + l15) * 8;
#pragma unroll
            for (int h = 0; h < 8; ++h) { Bq[h][0] = *(const bf16x8*)(qp + h * 64); Bq[h][1] = *(const bf16x8*)(qp + h * 64 + 32); wv[h] = wp[h]; } }
        bf16x8 A0n, A1n; { const int kt0 = wave <= qt ? wave : qt; const bf16* kp = KI + (rb + 16 * kt0 + l15) * 64 + kq * 8; A0n = *(const bf16x8*)kp; A1n = *(const bf16x8*)(kp + 32); }
        for (int kt = wave; kt <= qt; kt += 8) {
            const bf16x8 A0 = A0n, A1 = A1n;
            { const int ktn = kt + 8 <= qt ? kt + 8 : qt; const bf16* kp = KI + (rb + 16 * ktn + l15) * 64 + kq * 8; A0n = *(const bf16x8*)kp; A1n = *(const bf16x8*)(kp + 32); }
            f32x4 s = {0.f, 0.f, 0.f, 0.f};
#pragma unroll
            for (int h = 0; h < 8; ++h) { f32x4 D = {0.f, 0.f, 0.f, 0.f}; D = MFMA16(A0, Bq[h][0], D); D = MFMA16(A1, Bq[h][1], D);
#pragma unroll
                for (int e = 0; e < 4; ++e) s[e] = fmaf(wv[h], fmaxf(D[e], 0.f), s[e]); }
            *(LAS f32x4*)(sc + l15 * SCP + 16 * kt + 4 * kq) = s;
        }
        __syncthreads();
        for (int qq = 2 * wave; qq < 2 * wave + 2; ++qq) {
            const int t = q0 + qq, nrows = (t >> 6) + 1;
            unsigned kv[32];
#pragma unroll
            for (int i = 0; i < 32; ++i) { const int idx = 64 * i + lane; unsigned k = 0u;
                if (idx <= t) { const float f = sc[qq * SCP + idx]; unsigned ub = __float_as_uint(f); if (f == 0.f) ub = 0u; k = (ub & 0x80000000u) ? ~ub : (ub | 0x80000000u); }
                kv[i] = k; }
            unsigned T = 0u;
            for (int bit = 31; bit >= 0; --bit) {
                const unsigned cand = T | (1u << bit); int cnt = 0;
#pragma unroll
                for (int i = 0; i < 32; ++i) if (i < nrows) cnt += __popcll(__ballot(kv[i] >= cand));
                if (cnt >= 256) { T = cand; if (cnt == 256) break; }
            }
            int cgt = 0;
#pragma unroll
            for (int i = 0; i < 32; ++i) if (i < nrows) cgt += __popcll(__ballot(kv[i] > T));
            const int need = 256 - cgt; int tb = 0; u64 word = 0ull; const u64 ltm = (1ull << lane) - 1ull;
#pragma unroll
            for (int i = 0; i < 32; ++i) if (i < nrows) {
                const u64 eqm = __ballot(kv[i] == T); const int rank = tb + __popcll(eqm & ltm);
                const u64 selm = __ballot(kv[i] > T || (kv[i] == T && rank < need)); tb += __popcll(eqm);
                if (lane == i) word = selm; }
            if (lane < 32) MASK[(rb + t) * 32 + lane] = word;
        }
        __syncthreads();
    }
}

__device__ __forceinline__ int crow(int r, int hi) { return (r & 3) + 8 * (r >> 2) + 4 * hi; }
__device__ __forceinline__ void attn_phase(LAS unsigned char* lds, const bf16* QP, const bf16* KP, const bf16* Z0, const u64* MASK, bf16* Y, int tid) {
    const int lane = tid & 63, wave = __builtin_amdgcn_readfirstlane(tid >> 6), l31 = lane & 31, hi = lane >> 5;
    LAS bf16* Kb = (LAS bf16*)lds; LAS bf16* Vt = (LAS bf16*)(lds + 18432); LAS float* lsc = (LAS float*)(lds + 36864) + wave * 32;
    const int lk = tid >> 3, lc = tid & 7;
    for (int u = blockIdx.x; u < 256; u += gridDim.x) {
        const int b = u >> 3, h = u & 7; const size_t rb = (size_t)b * SEQ;
        for (int qb = 7; qb >= 0; --qb) {
            const int q0 = qb * 256, NT = 4 * (qb + 1), qw0 = q0 + 32 * wave, q = qw0 + l31;
            bf16x8 qr[4];
#pragma unroll
            for (int d0 = 0; d0 < 4; ++d0) qr[d0] = *(const bf16x8*)(QP + (rb + q) * 512 + h * 64 + 16 * d0 + 8 * hi);
            f32x16 O0, O1;
#pragma unroll
            for (int r = 0; r < 16; ++r) { O0[r] = 0.f; O1[r] = 0.f; }
            float l = 0.f;
            u32x4 kreg = *(const u32x4*)(KP + (rb + lk) * 512 + h * 64 + 8 * lc), vreg = *(const u32x4*)(Z0 + (rb + lk) * EV_NP + 2560 + h * 64 + 8 * lc);
#define ATT_STORE(buf) do { *(LAS u32x4*)(Kb + (buf) * 4608 + lk * 72 + 8 * lc) = kreg; LAS bf16* vt_ = Vt + (buf) * 4608 + (8 * lc) * 72 + lk; \
            vt_[0] = (bf16)(vreg.x & 0xffffu); vt_[72] = (bf16)(vreg.x >> 16); vt_[144] = (bf16)(vreg.y & 0xffffu); vt_[216] = (bf16)(vreg.y >> 16); \
            vt_[288] = (bf16)(vreg.z & 0xffffu); vt_[360] = (bf16)(vreg.z >> 16); vt_[432] = (bf16)(vreg.w & 0xffffu); vt_[504] = (bf16)(vreg.w >> 16); } while (0)
            ATT_STORE(0);
            u64 mwn = MASK[(rb + q) * 32];
            __syncthreads();
            for (int t = 0; t < NT; ++t) {
                const int cur = t & 1; const u64 mw = mwn;
                if (t + 1 < NT) { kreg = *(const u32x4*)(KP + (rb + 64 * (t + 1) + lk) * 512 + h * 64 + 8 * lc); vreg = *(const u32x4*)(Z0 + (rb + 64 * (t + 1) + lk) * EV_NP + 2560 + h * 64 + 8 * lc); mwn = MASK[(rb + q) * 32 + t + 1]; }
                if (64 * t <= qw0 + 31) {
                    f32x16 S0, S1;
#pragma unroll
                    for (int r = 0; r < 16; ++r) { S0[r] = 0.f; S1[r] = 0.f; }
                    const LAS bf16* kb = Kb + cur * 4608 + l31 * 72 + 8 * hi;
#pragma unroll
                    for (int d0 = 0; d0 < 4; ++d0) { const bf16x8 a0 = *(const LAS bf16x8*)(kb + 16 * d0), a1 = *(const LAS bf16x8*)(kb + 32 * 72 + 16 * d0);
                        S0 = MFMA32(a0, qr[d0], S0); S1 = MFMA32(a1, qr[d0], S1); }
                    const unsigned mlo = (unsigned)mw >> (4 * hi), mhi = (unsigned)(mw >> 32) >> (4 * hi);
                    float ps = 0.f;
#pragma unroll
                    for (int r = 0; r < 16; ++r) { const int cb = (r & 3) + 8 * (r >> 2);
                        const unsigned b0 = (unsigned)__builtin_amdgcn_sbfe(mlo, cb, 1), b1 = (unsigned)__builtin_amdgcn_sbfe(mhi, cb, 1);
                        const float p0 = __uint_as_float(__float_as_uint(__builtin_amdgcn_exp2f(S0[r])) & b0), p1 = __uint_as_float(__float_as_uint(__builtin_amdgcn_exp2f(S1[r])) & b1);
                        ps += p0 + p1; S0[r] = p0; S1[r] = p1; }
                    l += ps;
                    u32x4 pw[4];
                    pw[0] = (u32x4){pk2(S0[0], S0[1]), pk2(S0[2], S0[3]), pk2(S0[4], S0[5]), pk2(S0[6], S0[7])};
                    pw[1] = (u32x4){pk2(S0[8], S0[9]), pk2(S0[10], S0[11]), pk2(S0[12], S0[13]), pk2(S0[14], S0[15])};
                    pw[2] = (u32x4){pk2(S1[0], S1[1]), pk2(S1[2], S1[3]), pk2(S1[4], S1[5]), pk2(S1[6], S1[7])};
                    pw[3] = (u32x4){pk2(S1[8], S1[9]), pk2(S1[10], S1[11]), pk2(S1[12], S1[13]), pk2(S1[14], S1[15])};
                    const LAS bf16* vt = Vt + cur * 4608 + l31 * 72 + 4 * hi;
#pragma unroll
                    for (int m = 0; m < 4; ++m) { const int base = 16 * (m & 1) + 32 * (m >> 1);
                        const u64 lo0 = *(const LAS u64*)(vt + base), hi0 = *(const LAS u64*)(vt + base + 8), lo1 = *(const LAS u64*)(vt + 32 * 72 + base), hi1 = *(const LAS u64*)(vt + 32 * 72 + base + 8);
                        const u32x4 v0 = {(unsigned)lo0, (unsigned)(lo0 >> 32), (unsigned)hi0, (unsigned)(hi0 >> 32)}, v1 = {(unsigned)lo1, (unsigned)(lo1 >> 32), (unsigned)hi1, (unsigned)(hi1 >> 32)};
                        O0 = MFMA32(__builtin_bit_cast(bf16x8, pw[m]), __builtin_bit_cast(bf16x8, v0), O0);
                        O1 = MFMA32(__builtin_bit_cast(bf16x8, pw[m]), __builtin_bit_cast(bf16x8, v1), O1); }
                }
                if (t + 1 < NT) ATT_STORE(cur ^ 1);
                __syncthreads();
            }
#undef ATT_STORE
            l += __shfl_xor(l, 32);
            if (hi == 0) lsc[l31] = l;
            asm volatile("s_waitcnt lgkmcnt(0)" ::: "memory");
#pragma unroll
            for (int r = 0; r < 16; ++r) { const int qr_ = crow(r, hi); const float rl = __builtin_amdgcn_rcpf(lsc[qr_]);
                bf16* yp = Y + (rb + qw0 + qr_) * 1024 + 512 + h * 64 + l31; yp[0] = f2bf(O0[r] * rl); yp[32] = f2bf(O1[r] * rl); }
        }
    }
}
__device__ __forceinline__ void conv16(const bf16* zbase, int t, const float* cwp, float* out) {
    float acc[16];
#pragma unroll
    for (int e = 0; e < 16; ++e) acc[e] = 0.f;
#pragma unroll
    for (int jt = 0; jt < 4; ++jt) { if (t - 3 + jt >= 0) { float x[16]; ld8(zbase + (ptrdiff_t)(jt - 3) * OD_NP, x); ld8(zbase + (ptrdiff_t)(jt - 3) * OD_NP + 8, x + 8);
            const float* w = cwp + jt * 3072;
#pragma unroll
            for (int e = 0; e < 16; ++e) acc[e] = fmaf(w[e], x[e], acc[e]); } }
#pragma unroll
    for (int e = 0; e < 16; ++e) out[e] = siluf_(acc[e]);
}
__device__ __forceinline__ void conv16_ld(const bf16* zbase, int t, u32x4* raw) {
#pragma unroll
    for (int jt = 0; jt < 4; ++jt) { const int back = (t - 3 + jt >= 0) ? (3 - jt) : 0; const bf16* p = zbase - (ptrdiff_t)back * OD_NP; raw[2 * jt] = *(const u32x4*)p; raw[2 * jt + 1] = *(const u32x4*)(p + 8); }
}
__device__ __forceinline__ void conv16_fin(const u32x4* raw, int t, const LAS float* wl, int c16, float* out) {
    float acc[16];
#pragma unroll
    for (int e = 0; e < 16; ++e) acc[e] = 0.f;
#pragma unroll
    for (int jt = 0; jt < 4; ++jt) { float x[16]; unpack8(raw[2 * jt], x); unpack8(raw[2 * jt + 1], x + 8); const float msk = (t - 3 + jt >= 0) ? 1.f : 0.f;
#pragma unroll
        for (int q4 = 0; q4 < 4; ++q4) { const f32x4 w = *(const LAS f32x4*)(wl + jt * 128 + c16 + 4 * q4);
#pragma unroll
            for (int e = 0; e < 4; ++e) acc[4 * q4 + e] = fmaf(w[e] * msk, x[4 * q4 + e], acc[4 * q4 + e]); } }
#pragma unroll
    for (int e = 0; e < 16; ++e) out[e] = siluf_(acc[e]);
}
__device__ __forceinline__ void dn_prep(CArgs& a, LAS unsigned char* lds, int tid) {
    const int lane = tid & 63, wave = __builtin_amdgcn_readfirstlane(tid >> 6), l15 = lane & 15, kq = lane >> 4;
    unsigned char* ws = a.ws;
    const bf16* Z1 = (const bf16*)(ws + WS_Z); bf16* KPD = (bf16*)(ws + WS_KPD); bf16* VBD = (bf16*)(ws + WS_VBD); bf16* TG = (bf16*)(ws + WS_TG);
    float* GCUM = (float*)(ws + WS_GCUM); float* BETA = (float*)(ws + WS_BETA);
    const float* cw = (const float*)a.in[13]; const float* a_log = (const float*)a.in[14]; const float* dt_bias = (const float*)a.in[15];
    LAS bf16* KN = (LAS bf16*)lds; LAS float* AM = (LAS float*)(lds + 17408); LAS float* GC = (LAS float*)(lds + 17408 + 131072); LAS float* BT = GC + 64; LAS float* CWK = GC + 128; LAS float* CWV = CWK + 512;
    const int row = tid >> 3, c8 = tid & 7;
    for (int grp = blockIdx.x; grp < 1024; grp += gridDim.x) {
        const int bh = grp >> 2, ng = grp & 3, b = bh >> 3, h = bh & 7; const size_t rb = (size_t)b * SEQ;
        { const int jt_ = tid >> 7, cc_ = tid & 127; CWK[jt_ * 128 + cc_] = cw[jt_ * 3072 + 1024 + h * 128 + cc_]; CWV[jt_ * 128 + cc_] = cw[jt_ * 3072 + 2048 + h * 128 + cc_]; }
        __syncthreads();
#ifndef NO_PREPA
        for (int ci = 0; ci < 8; ++ci) {
            const int n = ng * 8 + ci, t0 = 64 * n, t = t0 + row;
            if (tid < 64) { const int tt = t0 + tid; const bf16* zr = Z1 + (rb + tt) * OD_NP;
                const float av = bf2f(zr[4096 + h]), bv = bf2f(zr[4104 + h]); const float xx = av + dt_bias[h];
                const float sp = xx > 20.f ? xx : log1pf(expf(xx)); float g = -expf(a_log[h]) * sp; const float beta = sigmoidf_(bv);
#pragma unroll
                for (int o = 1; o < 64; o <<= 1) { const float up = __shfl_up(g, o); if (lane >= o) g += up; }
                GC[tid] = g; BT[tid] = beta; GCUM[(size_t)bh * SEQ + tt] = g; BETA[(size_t)bh * SEQ + tt] = beta; }
            const bf16* zr = Z1 + (rb + t) * OD_NP;
            u32x4 rawk[8], rawv[8]; conv16_ld(zr + 1024 + h * 128 + 16 * c8, t, rawk); conv16_ld(zr + 2048 + h * 128 + 16 * c8, t, rawv);
            const float betar = sigmoidf_(bf2f(zr[4104 + h]));
            float x[16];
            conv16_fin(rawk, t, CWK, 16 * c8, x);
            float ss = 0.f;
#pragma unroll
            for (int e = 0; e < 16; ++e) ss += x[e] * x[e];
            ss += __shfl_xor(ss, 1); ss += __shfl_xor(ss, 2); ss += __shfl_xor(ss, 4);
            const float rn = __builtin_amdgcn_rsqf(ss + EPS);
#pragma unroll
            for (int e = 0; e < 16; ++e) x[e] *= rn;
            { const u32x4 w0 = pack8(x), w1 = pack8(x + 8); bf16* kp = KPD + (rb + t) * 1024 + h * 128 + 16 * c8; *(u32x4*)kp = w0; *(u32x4*)(kp + 8) = w1;
              LAS bf16* kl = KN + row * 136 + 16 * c8; *(LAS u32x4*)kl = w0; *(LAS u32x4*)(kl + 8) = w1; }
            conv16_fin(rawv, t, CWV, 16 * c8, x);
            {
#pragma unroll
              for (int e = 0; e < 16; ++e) x[e] *= betar;
              bf16* vp = VBD + (rb + t) * 1024 + h * 128 + 16 * c8; *(u32x4*)vp = pack8(x); *(u32x4*)(vp + 8) = pack8(x + 8); }
            __syncthreads();
#pragma unroll
            for (int ti = 0; ti < 2; ++ti) { const int id = 2 * wave + ti, ct = id >> 2, st = id & 3; LAS float* am = AM + ci * 4096;
                f32x4 D = {0.f, 0.f, 0.f, 0.f};
                if (st <= ct) {
#pragma unroll
                    for (int ks = 0; ks < 4; ++ks) { const bf16x8 A = *(const LAS bf16x8*)(KN + (16 * ct + l15) * 136 + 32 * ks + 8 * kq), B = *(const LAS bf16x8*)(KN + (16 * st + l15) * 136 + 32 * ks + 8 * kq); D = MFMA16(A, B, D); }
                }
                const int s = 16 * st + l15; const float gs = GC[s];
#pragma unroll
                for (int e = 0; e < 4; ++e) { const int c = 16 * ct + 4 * kq + e; am[c * 64 + s] = (c > s) ? BT[c] * __expf(GC[c] - gs) * D[e] : 0.f; } }
            __syncthreads();
        }
#endif
#ifndef NO_FSUB
        {
            const LAS float* am = AM + wave * 4096; const int n = ng * 8 + wave; bf16* tg = TG + ((size_t)bh * 32 + n) * 4096;
            for (int i = 0; i < 64; ++i) { float acc0 = (i == lane) ? 1.f : 0.f, acc1 = 0.f, acc2 = 0.f, acc3 = 0.f;
                const int nj4 = (i + 15) >> 4;
                for (int jg = 0; jg < nj4; ++jg) {
                    const f32x4 a0 = *(const LAS f32x4*)(am + i * 64 + 16 * jg), a1 = *(const LAS f32x4*)(am + i * 64 + 16 * jg + 4), a2 = *(const LAS f32x4*)(am + i * 64 + 16 * jg + 8), a3 = *(const LAS f32x4*)(am + i * 64 + 16 * jg + 12);
                    const LAS float* tp = am + (16 * jg) * 64 + lane;
#pragma unroll
                    for (int e = 0; e < 4; ++e) { acc0 = fmaf(-a0[e], tp[e * 64], acc0); acc1 = fmaf(-a1[e], tp[(4 + e) * 64], acc1); acc2 = fmaf(-a2[e], tp[(8 + e) * 64], acc2); acc3 = fmaf(-a3[e], tp[(12 + e) * 64], acc3); } }
                const float acc = (acc0 + acc1) + (acc2 + acc3);
                ((LAS float*)am)[i * 64 + lane] = acc; tg[i * 64 + lane] = f2bf(acc); }
        }
#endif
        __syncthreads();
    }
}

__device__ __forceinline__ void dn_scan(CArgs& a, LAS unsigned char* lds, int tid) {
    const int lane = tid & 63, wave = __builtin_amdgcn_readfirstlane(tid >> 6); int l15 = lane & 15, kq = lane >> 4;
    unsigned char* ws = a.ws;
    const bf16* Z1 = (const bf16*)(ws + WS_Z); const bf16* KPD = (const bf16*)(ws + WS_KPD); const bf16* VBD = (const bf16*)(ws + WS_VBD); const bf16* TG = (const bf16*)(ws + WS_TG);
    const float* GCUM = (const float*)(ws + WS_GCUM); const float* BETA = (const float*)(ws + WS_BETA); bf16* Y = (bf16*)(ws + WS_Y);
    const float* cw = (const float*)a.in[13]; const float* ong = (const float*)a.in[16];
    LAS bf16* TM = (LAS bf16*)lds; LAS bf16* KN = (LAS bf16*)(lds + 9216); LAS bf16* KT = (LAS bf16*)(lds + 26624); LAS bf16* QN = (LAS bf16*)(lds + 45056);
    LAS bf16* VB = (LAS bf16*)(lds + 62464); LAS bf16* STB = (LAS bf16*)(lds + 80896); LAS bf16* RT = (LAS bf16*)(lds + 115712); LAS bf16* VNT = (LAS bf16*)(lds + 134144);
    LAS float* GC = (LAS float*)(lds + 152576); LAS float* COEF = GC + 64; LAS float* EGL = GC + 128; LAS float* EG = GC + 192; LAS float* ONP = GC + 256;
    LAS bf16* QK = TM; LAS bf16* VNS = VB; LAS float* CWQ = ONP + 512;
    LAS bf16* ZL = RT;
    int row = tid >> 3, c8 = tid & 7;
#define RELAUNDER() asm volatile("" : "+v"(l15), "+v"(kq), "+v"(row), "+v"(c8))
    for (int bh = blockIdx.x; bh < 256; bh += gridDim.x) {
        const int b = bh >> 3, h = bh & 7; const size_t rb = (size_t)b * SEQ;
        f32x4 St[8];
#pragma unroll
        for (int i = 0; i < 8; ++i) St[i] = (f32x4){0.f, 0.f, 0.f, 0.f};
        for (int i = tid; i < 128 * 136 / 8; i += 512) *(LAS u32x4*)(STB + 8 * i) = (u32x4){0u, 0u, 0u, 0u};
        float ongv = ong[16 * wave + l15];
        { const int jt_ = tid >> 7, cc_ = tid & 127; CWQ[jt_ * 128 + cc_] = cw[jt_ * 3072 + h * 128 + cc_]; }
        __syncthreads();
#ifndef DBG_NCH
#define DBG_NCH 32
#endif
        for (int n = 0; n < DBG_NCH; ++n) {
            RELAUNDER();
            const int t0 = 64 * n, t = t0 + row;
            u32x4 rawq[8]; conv16_ld(Z1 + (rb + t) * OD_NP + h * 128 + 16 * c8, t, rawq);
            const u32x4 tgv = *(const u32x4*)(TG + ((size_t)bh * 32 + n) * 4096 + tid * 8);
            const bf16* kp = KPD + (rb + t) * 1024 + h * 128 + 16 * c8; const u32x4 kw0 = *(const u32x4*)kp, kw1 = *(const u32x4*)(kp + 8);
            const bf16* vp = VBD + (rb + t) * 1024 + h * 128 + 16 * c8; const u32x4 vw0 = *(const u32x4*)vp, vw1 = *(const u32x4*)(vp + 8);
            const bf16* zp = Z1 + (rb + t) * OD_NP + 3072 + h * 128 + 16 * c8; const u32x4 zw0 = *(const u32x4*)zp, zw1 = *(const u32x4*)(zp + 8);
            const float gl = GCUM[(size_t)bh * SEQ + t0 + 63];
            float gcv = 0.f, betav = 0.f; if (tid < 64) { gcv = GCUM[(size_t)bh * SEQ + t0 + tid]; betav = BETA[(size_t)bh * SEQ + t0 + tid]; }
            *(LAS u32x4*)(TM + row * 72 + 8 * c8) = tgv;
            { LAS bf16* kl = KN + row * 136 + 16 * c8; *(LAS u32x4*)kl = kw0; *(LAS u32x4*)(kl + 8) = kw1;
              LAS bf16* ktp = KT + (16 * c8) * 72 + row; const unsigned ww[8] = {kw0.x, kw0.y, kw0.z, kw0.w, kw1.x, kw1.y, kw1.z, kw1.w};
#pragma unroll
              for (int e = 0; e < 8; ++e) { ktp[(2 * e) * 72] = (bf16)(ww[e] & 0xffffu); ktp[(2 * e + 1) * 72] = (bf16)(ww[e] >> 16); } }
            { LAS bf16* vl = VB + row * 136 + 16 * c8; *(LAS u32x4*)vl = vw0; *(LAS u32x4*)(vl + 8) = vw1; }
            { float x[16]; conv16_fin(rawq, t, CWQ, 16 * c8, x); float ss = 0.f;
#pragma unroll
              for (int e = 0; e < 16; ++e) ss += x[e] * x[e];
              ss += __shfl_xor(ss, 1); ss += __shfl_xor(ss, 2); ss += __shfl_xor(ss, 4);
              const float rn = __builtin_amdgcn_rsqf(ss + EPS) * 0.08838834764831845f;
#pragma unroll
              for (int e = 0; e < 16; ++e) x[e] *= rn;
              LAS bf16* ql = QN + row * 136 + 16 * c8; *(LAS u32x4*)ql = pack8(x); *(LAS u32x4*)(ql + 8) = pack8(x + 8); }
            if (tid < 64) { GC[tid] = gcv; COEF[tid] = betav * __expf(gcv); EGL[tid] = __expf(gl - gcv); EG[tid] = __expf(gcv); }
            const float egl_last = __expf(gl);
            __syncthreads(); RELAUNDER();
#pragma nounroll
            for (int st = 0; st < 4; ++st) { f32x4 D = {0.f, 0.f, 0.f, 0.f};
#pragma unroll
                for (int ks = 0; ks < 4; ++ks) { const bf16x8 A = *(const LAS bf16x8*)(STB + (16 * wave + l15) * 136 + 32 * ks + 8 * kq), B = *(const LAS bf16x8*)(KN + (16 * st + l15) * 136 + 32 * ks + 8 * kq); D = MFMA16(A, B, D); }
                const int s = 16 * st + l15; const float coef = COEF[s];
#pragma unroll
                for (int e = 0; e < 4; ++e) { const int dv = 16 * wave + 4 * kq + e; RT[dv * 72 + s] = f2bf(bf2f(VB[s * 136 + dv]) - coef * D[e]); } __builtin_amdgcn_sched_barrier(0); }
            __syncthreads(); RELAUNDER();
#pragma nounroll
            for (int ct = 0; ct < 4; ++ct) { f32x4 D = {0.f, 0.f, 0.f, 0.f};
#pragma unroll
                for (int ks = 0; ks < 2; ++ks) { const bf16x8 A = *(const LAS bf16x8*)(RT + (16 * wave + l15) * 72 + 32 * ks + 8 * kq), B = *(const LAS bf16x8*)(TM + (16 * ct + l15) * 72 + 32 * ks + 8 * kq); D = MFMA16(A, B, D); }
                const int c = 16 * ct + l15; const float egl = EGL[c];
#pragma unroll
                for (int e = 0; e < 4; ++e) { const int dv = 16 * wave + 4 * kq + e; VNT[dv * 72 + c] = f2bf(D[e]); VNS[dv * 72 + c] = f2bf(D[e] * egl); } __builtin_amdgcn_sched_barrier(0); }
            __syncthreads(); RELAUNDER();
            { LAS bf16* zl = ZL + row * 136 + 16 * c8; *(LAS u32x4*)zl = zw0; *(LAS u32x4*)(zl + 8) = zw1; }
#pragma unroll
            for (int ti = 0; ti < 2; ++ti) { const int id = 2 * wave + ti, ct = id >> 2, st = id & 3; f32x4 D = {0.f, 0.f, 0.f, 0.f};
                if (st <= ct) {
#pragma unroll
                    for (int ks = 0; ks < 4; ++ks) { const bf16x8 A = *(const LAS bf16x8*)(QN + (16 * ct + l15) * 136 + 32 * ks + 8 * kq), B = *(const LAS bf16x8*)(KN + (16 * st + l15) * 136 + 32 * ks + 8 * kq); D = MFMA16(A, B, D); }
                }
                const int s = 16 * st + l15; const float gs = GC[s];
#pragma unroll
                for (int e = 0; e < 4; ++e) { const int c = 16 * ct + 4 * kq + e; QK[c * 72 + s] = (c >= s) ? f2bf(D[e] * __expf(GC[c] - gs)) : (bf16)0; } __builtin_amdgcn_sched_barrier(0); }
            f32x4 Oa[4];
#pragma unroll
            for (int ct = 0; ct < 4; ++ct) { f32x4 D = {0.f, 0.f, 0.f, 0.f};
#pragma unroll
                for (int ks = 0; ks < 4; ++ks) { const bf16x8 A = *(const LAS bf16x8*)(QN + (16 * ct + l15) * 136 + 32 * ks + 8 * kq), B = *(const LAS bf16x8*)(STB + (16 * wave + l15) * 136 + 32 * ks + 8 * kq); D = MFMA16(A, B, D); }
#pragma unroll
                for (int e = 0; e < 4; ++e) D[e] *= EG[16 * ct + 4 * kq + e];
                Oa[ct] = D; __builtin_amdgcn_sched_barrier(0); }
            __syncthreads(); RELAUNDER();
#pragma unroll
            for (int ct = 0; ct < 4; ++ct) {
#pragma unroll
                for (int ks = 0; ks < 2; ++ks) { const bf16x8 A = *(const LAS bf16x8*)(QK + (16 * ct + l15) * 72 + 32 * ks + 8 * kq), B = *(const LAS bf16x8*)(VNT + (16 * wave + l15) * 72 + 32 * ks + 8 * kq); Oa[ct] = MFMA16(A, B, Oa[ct]); }
#pragma unroll
                for (int e = 0; e < 4; ++e) { float q2 = Oa[ct][e] * Oa[ct][e]; q2 += __shfl_xor(q2, 1); q2 += __shfl_xor(q2, 2); q2 += __shfl_xor(q2, 4); q2 += __shfl_xor(q2, 8);
                    if (l15 == 0) ONP[(16 * ct + 4 * kq + e) * 8 + wave] = q2; } __builtin_amdgcn_sched_barrier(0); }
#pragma unroll
            for (int dkt = 0; dkt < 8; ++dkt) { f32x4 D = St[dkt] * egl_last;
#pragma unroll
                for (int ks = 0; ks < 2; ++ks) { const bf16x8 A = *(const LAS bf16x8*)(VNS + (16 * wave + l15) * 72 + 32 * ks + 8 * kq), B = *(const LAS bf16x8*)(KT + (16 * dkt + l15) * 72 + 32 * ks + 8 * kq); D = MFMA16(A, B, D); }
                St[dkt] = D;
#pragma unroll
                for (int e = 0; e < 4; ++e) STB[(16 * wave + 4 * kq + e) * 136 + 16 * dkt + l15] = f2bf(D[e]); __builtin_amdgcn_sched_barrier(0); }
            __syncthreads(); RELAUNDER();
#pragma unroll
            for (int ct = 0; ct < 4; ++ct) {
#pragma unroll
                for (int e = 0; e < 4; ++e) { const int c = 16 * ct + 4 * kq + e;
                    const f32x4 pa = *(const LAS f32x4*)(ONP + c * 8), pb = *(const LAS f32x4*)(ONP + c * 8 + 4);
                    const float tot = ((pa[0] + pa[1]) + (pa[2] + pa[3])) + ((pb[0] + pb[1]) + (pb[2] + pb[3]));
                    const float rstd = __builtin_amdgcn_rsqf(tot * (1.0f / 128.0f) + EPS); const int dv = 16 * wave + l15;
                    const float z = bf2f(ZL[c * 136 + dv]);
#if defined(DBG_Q) && DBG_Q == 1
                    Y[(rb + t0 + c) * 1024 + h * 128 + dv] = f2bf(Oa[ct][e] * 64.f + 0.f * rstd * z); }
#elif defined(DBG_Q) && DBG_Q == 2
                    Y[(rb + t0 + c) * 1024 + h * 128 + dv] = f2bf(bf2f(VNT[dv * 72 + c]) * 64.f + 0.f * rstd * z); }
#elif defined(DBG_Q) && DBG_Q == 5
                    Y[(rb + t0 + c) * 1024 + h * 128 + dv] = f2bf(bf2f(RT[dv * 72 + c]) * 64.f + 0.f * rstd * z); }
#elif defined(DBG_Q) && DBG_Q == 3
                    Y[(rb + t0 + c) * 1024 + h * 128 + dv] = f2bf(bf2f(QK[c * 72 + (dv & 63)]) * 64.f + 0.f * rstd * z); }
#elif defined(DBG_Q) && DBG_Q == 4
                    Y[(rb + t0 + c) * 1024 + h * 128 + dv] = f2bf(bf2f(TM[c * 72 + (dv & 63)]) * 64.f + 0.f * rstd * z); }
#else
                    Y[(rb + t0 + c) * 1024 + h * 128 + dv] = f2bf(Oa[ct][e] * rstd * ongv * siluf_(z)); }
#endif
                __builtin_amdgcn_sched_barrier(0); }
            __syncthreads(); RELAUNDER();
        }
    }
}
#undef RELAUNDER

#ifndef REP1
#define REP1 1
#endif
#ifndef REP0
#define REP0 1
#endif
#ifndef REP2
#define REP2 1
#endif
#ifndef REP3
#define REP3 1
#endif
#ifndef REP4
#define REP4 1
#endif
#ifndef REP10
#define REP10 1
#endif
#if defined(DBG_CUT)
#define DBGCUT(k, ptr, pitch, coloff) do { if ((k) == DBG_CUT) { asm volatile("s_waitcnt vmcnt(0) lgkmcnt(0)" ::: "memory"); cg::this_grid().sync(); \
        const bf16* src_ = (const bf16*)(ptr); float* dst_ = a.out; \
        for (size_t i_ = (size_t)blockIdx.x * 512 + tid; i_ < (size_t)M * 1024; i_ += (size_t)gridDim.x * 512) { const size_t r_ = i_ >> 10, c_ = i_ & 1023; dst_[i_] = bf2f(src_[r_ * (pitch) + (coloff) + c_]); } \
        return; } } while (0)
#else
#define DBGCUT(k, ptr, pitch, coloff) do {} while (0)
#endif
__global__ void __launch_bounds__(512, 2) mega(Args a_unused) {
    extern __shared__ __attribute__((aligned(16))) unsigned char lds_raw[];
    LAS unsigned char* lds = (LAS unsigned char*)lds_raw;
    int tid = threadIdx.x;
    volatile LAS unsigned* xb_st = (volatile LAS unsigned*)(lds + LDS_BYTES - 64);
    if (tid < 16) xb_st[tid] = 0u;
    __syncthreads();
    XcdBarrier bar = xcd_barrier_post((unsigned*)(((CArgs*)__builtin_amdgcn_kernarg_segment_ptr())->ws + WS_BAR), xb_st);
    CArgs* ap = (CArgs*)__builtin_amdgcn_kernarg_segment_ptr();
#define a (*launder_args(ap))
#define ws (a.ws)
#define rsq ((float*)(ws + WS_RSQ))
    const int lo = a.ph_lo, hi = a.ph_hi;
#ifndef PHMASK
#define PHMASK 0xFFFFFFFFu
#endif
#define IN(k) (((PHMASK >> ((k) > 11 ? (k) - 7 : (k))) & 1u) && lo <= (k) && (k) < hi)
#define SEAM(k) do { if (IN(k) && IN((k) + 1)) { if ((k) == 0) { asm volatile("s_waitcnt vmcnt(0) lgkmcnt(0)" ::: "memory"); cg::this_grid().sync(); \
        if (tid == 0) { __builtin_amdgcn_fence(__ATOMIC_ACQUIRE, "agent"); asm volatile("s_waitcnt vmcnt(0)" ::: "memory"); } __syncthreads(); } else { xcd_barrier(bar); } } } while (0)
#define GEMM(EpiT, Aptr, Bptr, N_, K_, ...) do { int k_ = (K_); asm volatile("" : "+s"(k_)); pg8::Gemm g{(const pg8::bf16_t*)(Aptr), (const pg8::bf16_t*)(Bptr), M, (N_), k_}; pg8::StaticOrder S; S.init(M, (N_), (int)gridDim.x, (int)blockIdx.x); \
        pg8::EpiT E{__VA_ARGS__}; pg8::gemm_phase<pg8::EpiT, pg8::StaticOrder, true, true>(lds, g, S, E, tid); } while (0)
    asm volatile("; ==== PHASE 0" : "+v"(tid)); if (IN(0)) { for (int rep_ = 0; rep_ < REP0; ++rep_) prologue(a, lds, tid); } SEAM(0);
    asm volatile("; ==== PHASE 1" : "+v"(tid)); if (IN(1)) { for (int rep_ = 0; rep_ < REP1; ++rep_) GEMM(EpiZ, ws + WS_HBB, ws + W_EVIN, EV_NP, 1024, (pg8::bf16_t*)(ws + WS_Z), EV_NP, rsq); } SEAM(1); DBGCUT(1, ws + WS_Z, EV_NP, DBG_COL);
    asm volatile("; ==== PHASE 2" : "+v"(tid)); if (IN(2)) { for (int rep_ = 0; rep_ < REP2; ++rep_) even_post(a, lds, tid); } SEAM(2); DBGCUT(2, ws + WS_QI, 512, 0);
    asm volatile("; ==== PHASE 3" : "+v"(tid)); if (IN(3)) { for (int rep_ = 0; rep_ < REP3; ++rep_) idx_phase(lds, (const bf16*)(ws + WS_QI), (const bf16*)(ws + WS_KI), (const float*)(ws + WS_WI), (u64*)(ws + WS_MASK), tid); } SEAM(3);
    asm volatile("; ==== PHASE 4" : "+v"(tid)); if (IN(4)) { for (int rep_ = 0; rep_ < REP4; ++rep_) attn_phase(lds, (const bf16*)(ws + WS_QP), (const bf16*)(ws + WS_KP), (const bf16*)(ws + WS_Z), (const u64*)(ws + WS_MASK), (bf16*)(ws + WS_Y), tid); } SEAM(4); DBGCUT(4, ws + WS_Y, 1024, 0);
    for (int l = 0; l < 2; ++l) {
        const int pb = 5 + 7 * l;
        const float* base0 = l == 0 ? (const float*)a.in[0] : a.out;
        bf16* hb1 = (bf16*)(ws + (l == 0 ? WS_HBA : WS_HBB)); bf16* hb2 = (bf16*)(ws + (l == 0 ? WS_HBB : WS_HBA));
        float* rs1 = rsq + (size_t)(1 + 3 * l) * M; float* rs2 = rs1 + M; float* rs3 = rs2 + M; float* rsE = rsq + (size_t)(6 + l) * M;
        asm volatile("; ==== PHASE pb" : "+v"(tid)); if (IN(pb)) { convert_p((const float*)a.in[1] + (size_t)l * M * 256, (bf16*)(ws + WS_PB), tid);
            GEMM(EpiRes, ws + WS_Y, ws + (l == 0 ? W_EVOUT : W_ODOUT), 1024, 1024, base0, a.out, (pg8::bf16_t*)hb1, rs1); } SEAM(pb);
        asm volatile("; ==== PHASE pb1" : "+v"(tid)); if (IN(pb + 1)) {
#ifndef NO_SWIGLU
 GEMM(EpiSwiGLU, hb1, ws + W_GU + (size_t)l * 2 * DFF * 1024 * 2, 2 * DFF, 1024, (pg8::bf16_t*)(ws + WS_HID), rs1);
#endif
#ifndef NO_ERAW
            GEMM(EpiEraw, ws + WS_PB, ws + W_PJ + (size_t)l * 256 * 1024 * 2, 1024, 256, (pg8::bf16_t*)(ws + WS_ERAW), rsE);
#endif
 } SEAM(pb + 1);
        asm volatile("; ==== PHASE pb2" : "+v"(tid)); if (IN(pb + 2)) { GEMM(EpiRes, ws + WS_HID, ws + W_DN + (size_t)l * DFF * 1024 * 2, 1024, DFF, (const float*)a.out, a.out, (pg8::bf16_t*)hb2, rs2); } SEAM(pb + 2);
        asm volatile("; ==== PHASE pb3" : "+v"(tid)); if (IN(pb + 3)) { GEMM(EpiPle, hb2, ws + W_PG + (size_t)l * 1024 * 1024 * 2, 1024, 1024, (const float*)a.out, a.out, (pg8::bf16_t*)(l == 0 ? hb1 : nullptr), (l == 0 ? rs3 : nullptr),
                               (const pg8::bf16_t*)(ws + WS_ERAW), rsE, rs2, (const float*)a.in[22] + l * 1024); } SEAM(pb + 3);
        if (l == 0) {
            asm volatile("; ==== PHASE 9" : "+v"(tid)); if (IN(9)) { GEMM(EpiZ, hb1, ws + W_ODIN, OD_NP, 1024, (pg8::bf16_t*)(ws + WS_Z), OD_NP, rs3); } SEAM(9); DBGCUT(9, ws + WS_Z, OD_NP, DBG_COL);
            asm volatile("; ==== PHASE 10" : "+v"(tid)); if (IN(10)) { for (int rep_ = 0; rep_ < REP10; ++rep_) dn_prep(a, lds, tid); } SEAM(10);
#if defined(DBG_CUT) && DBG_CUT == 10
            { asm volatile("s_waitcnt vmcnt(0) lgkmcnt(0)" ::: "memory"); cg::this_grid().sync();
              const bf16* s1_ = (const bf16*)(ws + WS_KPD); const bf16* s2_ = (const bf16*)(ws + WS_VBD); const float* s3_ = (const float*)(ws + WS_GCUM); float* dst_ = a.out;
              for (size_t i_ = (size_t)blockIdx.x * 512 + tid; i_ < (size_t)M * 1024; i_ += (size_t)gridDim.x * 512) dst_[i_] = bf2f(s1_[i_]) + 3.f * bf2f(s2_[i_]) + (i_ < (size_t)M * 16 ? s3_[i_] : 0.f);
              return; }
#endif
            asm volatile("; ==== PHASE 11" : "+v"(tid)); if (IN(11)) { dn_scan(a, lds, tid); } SEAM(11); DBGCUT(11, ws + WS_Y, 1024, 0);
        }
    }
#undef IN
#undef SEAM
#undef GEMM
#undef a
#undef ws
#undef rsq
}

extern "C" void kernel_launch(void* const* d_in, const int* in_sizes, int n_in, void* d_out, int out_size, void* d_ws, size_t ws_size, hipStream_t stream) {
    static int grid = 0;
    if (grid == 0) {
        if (n_in != 25 || out_size != M * DM || ws_size < WS_END) { fprintf(stderr, "kernel_launch: unexpected problem (n_in %d, out %d, ws %zu)\n", n_in, out_size, ws_size); grid = -1; return; }
        int dev = 0, cus = 0, per_cu = 0;
        hipGetDevice(&dev); hipDeviceGetAttribute(&cus, hipDeviceAttributeMultiprocessorCount, dev);
        hipFuncSetAttribute((const void*)mega, hipFuncAttributeMaxDynamicSharedMemorySize, LDS_BYTES);
        hipOccupancyMaxActiveBlocksPerMultiprocessor(&per_cu, (const void*)mega, 512, LDS_BYTES);
        (void)hipGetLastError();
        if (per_cu < 1) { fprintf(stderr, "kernel_launch: occupancy query says %d blocks per CU\n", per_cu); per_cu = 1; }
        grid = cus;
        if (grid > 256) grid = 256;
    }
    if (grid < 0) return;
    Args a{};
    for (int i = 0; i < 25; ++i) a.in[i] = d_in[i];
    a.out = (float*)d_out; a.ws = (unsigned char*)d_ws; a.ph_lo = 0; a.ph_hi = NPH; a.coop = 1; a.pad = 0;
    if (hipMemsetAsync((char*)d_ws + WS_BAR, 0, 16384, stream) != hipSuccess) { fprintf(stderr, "kernel_launch: memset failed\n"); return; }
#if defined(MK_MULTI)
    for (int p = 0; p < NPH; ++p) { a.ph_lo = p; a.ph_hi = p + 1; hipLaunchKernelGGL(mega, dim3(grid), dim3(512), LDS_BYTES, stream, a); }
#else
    void* args[] = {&a};
    hipError_t e = hipLaunchCooperativeKernel((const void*)mega, dim3(grid), dim3(512), args, LDS_BYTES, stream);
    if (e != hipSuccess) fprintf(stderr, "kernel_launch: cooperative launch failed: %s (grid %d)\n", hipGetErrorString(e), grid);
#endif
}
```

```cpp
#include <hip/hip_runtime.h>
#include <hip/hip_cooperative_groups.h>
#include <cstdio>
#include <cstdint>
#include <cstddef>
namespace cg = cooperative_groups;
namespace pg8 {
#define PG8_LAS __attribute__((address_space(3)))
typedef unsigned short bf16_t;
typedef short bf16x8 __attribute__((ext_vector_type(8)));
typedef float f32x4 __attribute__((ext_vector_type(4)));
typedef unsigned u32x4 __attribute__((ext_vector_type(4)));
constexpr int BM = 256, BK = 64, HALF = 128, HTB = HALF * BK * 2  , STAGE_BYTES = 8 * HTB, NXCD = 8, WGM = 8;

__host__ __device__ __forceinline__ int lds_byte(int r, int c) { const int st = (r >> 4) * 2 + (c >> 5), rr = r & 15, cc = c & 31, ob = rr * 64 + cc * 2; return st * 1024 + (ob ^ (((ob >> 9) & 1) << 5)); }
__host__ __device__ __forceinline__ void stage_rc(int b, int& R, int& C) { const int st = b / 1024, sb = b % 1024, swz = sb ^ (((sb >> 9) & 1) << 5); R = (st >> 1) * 16 + swz / 64; C = (st & 1) * 32 + (swz % 64) / 2; }
__host__ __device__ __forceinline__ int perm32(int rho) { const int n = rho >> 4, i = rho & 15; return 8 * (i >> 2) + 4 * n + (i & 3); }

struct Unit { int pm, pn; };
struct Gemm { const bf16_t* A; const bf16_t* Bt; int M, N, K; };

struct StaticOrder {
    int nM, nN, nwg, G, c;
    __host__ __device__ void init(int M, int N, int G_, int c_) { nM = M / BM; nN = N / BM; nwg = nM * nN; G = G_; c = c_; }
    __host__ __device__ bool next(int i, Unit& u) const {
        const long L = (long)i * G + c; if (L >= nwg) return false;
        int wgid = (int)L; { const int q = nwg / NXCD, r = nwg % NXCD, xcd = wgid % NXCD, off = wgid / NXCD; wgid = (xcd < r ? xcd * (q + 1) : r * (q + 1) + (xcd - r) * q) + off; }
        const int nig = WGM * nN, gid = wgid / nig, fm = gid * WGM, gsz = (nM - fm) < WGM ? (nM - fm) : WGM;
        u.pm = fm + ((wgid % nig) % gsz); u.pn = (wgid % nig) / gsz; return true;
    }
    __device__ __forceinline__ void a_ready(const Unit&) const {}
    __device__ __forceinline__ void done(const Unit&) const {}
};
typedef float f32x2cv __attribute__((ext_vector_type(2))); typedef __bf16 bf16x2cv __attribute__((ext_vector_type(2)));
__device__ __forceinline__ unsigned cvt_pk_bf16(float lo, float hi) { const f32x2cv v = {lo, hi}; const bf16x2cv b = __builtin_convertvector(v, bf16x2cv); return __builtin_bit_cast(unsigned, b); }
typedef unsigned u32x4e __attribute__((ext_vector_type(4)));
typedef unsigned u32x2e __attribute__((ext_vector_type(2)));
constexpr float NORM_EPS = 1e-6f;
__device__ __forceinline__ float rstd_of(const float* rowsq, int row) { return __builtin_amdgcn_rsqf(rowsq[row] * (1.0f / 1024.0f) + NORM_EPS); }
struct EpiZ {
    static constexpr bool PERM = true, AFTER_DRAIN = false, ALIGN = true;
    bf16_t* O; int ldc; const float* rowsq;
    __device__ __forceinline__ void operator()(const f32x4 (&acc)[2][2][4][2], const Unit& u, int wr, int wc, int fr, int fq) const {
        const int row0 = u.pm * BM + wr * 64 + fr, col0 = u.pn * BM + wc * 32 + 8 * fq;
#pragma unroll
        for (int ai = 0; ai < 2; ++ai)
#pragma unroll
            for (int m = 0; m < 4; ++m) { const int row = row0 + ai * HALF + m * 16; const float rs = rstd_of(rowsq, row); bf16_t* rowp = O + (size_t)row * ldc + col0;
#pragma unroll
                for (int bj = 0; bj < 2; ++bj) { const f32x4 v0 = acc[ai][bj][m][0] * rs, v1 = acc[ai][bj][m][1] * rs;
                    u32x4e w; w.x = cvt_pk_bf16(v0[0], v0[1]); w.y = cvt_pk_bf16(v0[2], v0[3]); w.z = cvt_pk_bf16(v1[0], v1[1]); w.w = cvt_pk_bf16(v1[2], v1[3]);
                    *(u32x4e*)(rowp + bj * HALF) = w; } asm volatile("" ::: "memory"); }
    }
};
struct EpiEraw {
    static constexpr bool PERM = true, AFTER_DRAIN = false, ALIGN = true;
    bf16_t* O; float* rowsq;
    __device__ __forceinline__ void operator()(const f32x4 (&acc)[2][2][4][2], const Unit& u, int wr, int wc, int fr, int fq) const {
        const int row0 = u.pm * BM + wr * 64 + fr, col0 = u.pn * BM + wc * 32 + 8 * fq;
#pragma unroll
        for (int ai = 0; ai < 2; ++ai)
#pragma unroll
            for (int m = 0; m < 4; ++m) { const int row = row0 + ai * HALF + m * 16; bf16_t* rowp = O + (size_t)row * 1024 + col0; float ss = 0.f;
#pragma unroll
                for (int bj = 0; bj < 2; ++bj) { const f32x4 v0 = acc[ai][bj][m][0], v1 = acc[ai][bj][m][1];
                    ss += (v0[0] * v0[0] + v0[1] * v0[1]) + (v0[2] * v0[2] + v0[3] * v0[3]) + (v1[0] * v1[0] + v1[1] * v1[1]) + (v1[2] * v1[2] + v1[3] * v1[3]);
                    u32x4e w; w.x = cvt_pk_bf16(v0[0], v0[1]); w.y = cvt_pk_bf16(v0[2], v0[3]); w.z = cvt_pk_bf16(v1[0], v1[1]); w.w = cvt_pk_bf16(v1[2], v1[3]);
                    *(u32x4e*)(rowp + bj * HALF) = w; }
                ss += __shfl_xor(ss, 16); ss += __shfl_xor(ss, 32);
                if (fq == 0) atomicAdd(rowsq + row, ss); asm volatile("" ::: "memory"); }
    }
};
struct EpiSwiGLU {
    static constexpr bool PERM = true, AFTER_DRAIN = false, ALIGN = true;
    bf16_t* O; const float* rowsq;
    __device__ __forceinline__ void operator()(const f32x4 (&acc)[2][2][4][2], const Unit& u, int wr, int wc, int fr, int fq) const {
        const int row0 = u.pm * BM + wr * 64 + fr, col0 = u.pn * HALF + wc * 32 + 8 * fq;
#pragma unroll
        for (int ai = 0; ai < 2; ++ai)
#pragma unroll
            for (int m = 0; m < 4; ++m) { const int row = row0 + ai * HALF + m * 16; const float rs = rstd_of(rowsq, row); float h[8];
#pragma unroll
                for (int n = 0; n < 2; ++n)
#pragma unroll
                    for (int e = 0; e < 4; ++e) { const float g = acc[ai][0][m][n][e] * rs, up = acc[ai][1][m][n][e] * rs;
                        h[4 * n + e] = g * __builtin_amdgcn_rcpf(1.0f + __builtin_amdgcn_exp2f(-1.4426950408889634f * g)) * up; }
                u32x4e w; w.x = cvt_pk_bf16(h[0], h[1]); w.y = cvt_pk_bf16(h[2], h[3]); w.z = cvt_pk_bf16(h[4], h[5]); w.w = cvt_pk_bf16(h[6], h[7]);
                *(u32x4e*)(O + (size_t)row * 2816 + col0) = w; asm volatile("" ::: "memory"); }
    }
};
struct EpiRes {
    static constexpr bool PERM = false, AFTER_DRAIN = false, ALIGN = true;
    const float* base; float* out; bf16_t* hb; float* rowsq;
    __device__ __forceinline__ void operator()(const f32x4 (&acc)[2][2][4][2], const Unit& u, int wr, int wc, int fr, int fq) const {
        const int row0 = u.pm * BM + wr * 64 + fr, col0 = u.pn * BM + wc * 32 + 4 * fq;
#pragma unroll
        for (int ai = 0; ai < 2; ++ai)
#pragma unroll
            for (int m = 0; m < 4; ++m) { const int row = row0 + ai * HALF + m * 16; const size_t off = (size_t)row * 1024 + col0; float ss = 0.f;
#pragma unroll
                for (int bj = 0; bj < 2; ++bj)
#pragma unroll
                    for (int n = 0; n < 2; ++n) { const size_t o2 = off + bj * HALF + n * 16; const f32x4 o = *(const f32x4*)(base + o2) + acc[ai][bj][m][n];
                        *(f32x4*)(out + o2) = o; u32x2e w; w.x = cvt_pk_bf16(o[0], o[1]); w.y = cvt_pk_bf16(o[2], o[3]); *(u32x2e*)(hb + o2) = w;
                        ss += (o[0] * o[0] + o[1] * o[1]) + (o[2] * o[2] + o[3] * o[3]); }
                ss += __shfl_xor(ss, 16); ss += __shfl_xor(ss, 32);
                if (fq == 0) atomicAdd(rowsq + row, ss); asm volatile("" ::: "memory"); }
    }
};
struct EpiPle {
    static constexpr bool PERM = false, AFTER_DRAIN = false, ALIGN = true;
    const float* base; float* out; bf16_t* hb; float* rowsq_out; const bf16_t* eraw; const float* rowsqE; const float* rowsqH; const float* postg;
    __device__ __forceinline__ void operator()(const f32x4 (&acc)[2][2][4][2], const Unit& u, int wr, int wc, int fr, int fq) const {
        const int row0 = u.pm * BM + wr * 64 + fr, col0 = u.pn * BM + wc * 32 + 4 * fq;
#pragma unroll
        for (int ai = 0; ai < 2; ++ai)
#pragma unroll
            for (int m = 0; m < 4; ++m) { const int row = row0 + ai * HALF + m * 16; const size_t off = (size_t)row * 1024 + col0; float ss = 0.f;
                const float rsE = rstd_of(rowsqE, row), rsH = rstd_of(rowsqH, row);
#pragma unroll
                for (int bj = 0; bj < 2; ++bj)
#pragma unroll
                    for (int n = 0; n < 2; ++n) { const size_t o2 = off + bj * HALF + n * 16; const int c2 = col0 + bj * HALF + n * 16;
                        const u32x2e ew = *(const u32x2e*)(eraw + o2); const f32x4 pg = *(const f32x4*)(postg + c2); const f32x4 b = *(const f32x4*)(base + o2);
                        float ev[4] = {__uint_as_float(ew.x << 16), __uint_as_float(ew.x & 0xffff0000u), __uint_as_float(ew.y << 16), __uint_as_float(ew.y & 0xffff0000u)};
                        f32x4 o;
#pragma unroll
                        for (int e = 0; e < 4; ++e) { const float gt = __builtin_amdgcn_rcpf(1.0f + __builtin_amdgcn_exp2f(-1.4426950408889634f * acc[ai][bj][m][n][e] * rsH)); o[e] = b[e] + ev[e] * rsE * pg[e] * gt; }
                        *(f32x4*)(out + o2) = o;
                        if (hb) { u32x2e w; w.x = cvt_pk_bf16(o[0], o[1]); w.y = cvt_pk_bf16(o[2], o[3]); *(u32x2e*)(hb + o2) = w; }
                        ss += (o[0] * o[0] + o[1] * o[1]) + (o[2] * o[2] + o[3] * o[3]); }
                if (rowsq_out) { ss += __shfl_xor(ss, 16); ss += __shfl_xor(ss, 32); if (fq == 0) atomicAdd(rowsq_out + row, ss); } asm volatile("" ::: "memory"); }
    }
};

__device__ __forceinline__ void unpack8e(const u32x4e w, float* v) {
    v[0] = __uint_as_float(w.x << 16); v[1] = __uint_as_float(w.x & 0xffff0000u); v[2] = __uint_as_float(w.y << 16); v[3] = __uint_as_float(w.y & 0xffff0000u);
    v[4] = __uint_as_float(w.z << 16); v[5] = __uint_as_float(w.z & 0xffff0000u); v[6] = __uint_as_float(w.w << 16); v[7] = __uint_as_float(w.w & 0xffff0000u); }
struct EpiResB {
    static constexpr bool PERM = true, AFTER_DRAIN = false, ALIGN = true;
    const float* basef; const bf16_t* baseb; bf16_t* hb; float* rowsq;
    __device__ __forceinline__ void operator()(const f32x4 (&acc)[2][2][4][2], const Unit& u, int wr, int wc, int fr, int fq) const {
        const int row0 = u.pm * BM + wr * 64 + fr, col0 = u.pn * BM + wc * 32 + 8 * fq;
#pragma unroll
        for (int ai = 0; ai < 2; ++ai)
#pragma unroll
            for (int m = 0; m < 4; ++m) { const int row = row0 + ai * HALF + m * 16; const size_t off = (size_t)row * 1024 + col0; float ss = 0.f;
#pragma unroll
                for (int bj = 0; bj < 2; ++bj) { const size_t o2 = off + bj * HALF; float b[8];
                    if (basef) { const f32x4 b0 = *(const f32x4*)(basef + o2), b1 = *(const f32x4*)(basef + o2 + 4); b[0] = b0[0]; b[1] = b0[1]; b[2] = b0[2]; b[3] = b0[3]; b[4] = b1[0]; b[5] = b1[1]; b[6] = b1[2]; b[7] = b1[3]; }
                    else unpack8e(*(const u32x4e*)(baseb + o2), b);
#pragma unroll
                    for (int n = 0; n < 2; ++n)
#pragma unroll
                        for (int e2 = 0; e2 < 4; ++e2) { b[4 * n + e2] += acc[ai][bj][m][n][e2]; ss += b[4 * n + e2] * b[4 * n + e2]; }
                    u32x4e w; w.x = cvt_pk_bf16(b[0], b[1]); w.y = cvt_pk_bf16(b[2], b[3]); w.z = cvt_pk_bf16(b[4], b[5]); w.w = cvt_pk_bf16(b[6], b[7]);
                    *(u32x4e*)(hb + o2) = w; }
                ss += __shfl_xor(ss, 16); ss += __shfl_xor(ss, 32);
                if (fq == 0) atomicAdd(rowsq + row, ss); asm volatile("" ::: "memory"); }
    }
};
struct EpiPleB {
    static constexpr bool PERM = true, AFTER_DRAIN = false, ALIGN = true;
    const bf16_t* baseb; float* outf; bf16_t* hb; float* rowsq_out; const bf16_t* eraw; const float* rowsqE; const float* rowsqH; const float* postg;
    __device__ __forceinline__ void operator()(const f32x4 (&acc)[2][2][4][2], const Unit& u, int wr, int wc, int fr, int fq) const {
        const int row0 = u.pm * BM + wr * 64 + fr, col0 = u.pn * BM + wc * 32 + 8 * fq;
#pragma unroll
        for (int ai = 0; ai < 2; ++ai)
#pragma unroll
            for (int m = 0; m < 4; ++m) { const int row = row0 + ai * HALF + m * 16; const size_t off = (size_t)row * 1024 + col0; float ss = 0.f;
                const float rsE = rstd_of(rowsqE, row), rsH = rstd_of(rowsqH, row);
#pragma unroll
                for (int bj = 0; bj < 2; ++bj) { const size_t o2 = off + bj * HALF; const int c2 = col0 + bj * HALF; float b[8], ev[8];
                    unpack8e(*(const u32x4e*)(baseb + o2), b); unpack8e(*(const u32x4e*)(eraw + o2), ev);
                    const f32x4 pg0 = *(const f32x4*)(postg + c2), pg1 = *(const f32x4*)(postg + c2 + 4);
#pragma unroll
                    for (int n = 0; n < 2; ++n)
#pragma unroll
                        for (int e2 = 0; e2 < 4; ++e2) { const int i8 = 4 * n + e2; const float gt = __builtin_amdgcn_rcpf(1.0f + __builtin_amdgcn_exp2f(-1.4426950408889634f * acc[ai][bj][m][n][e2] * rsH));
                            b[i8] += ev[i8] * rsE * (n ? pg1[e2] : pg0[e2]) * gt; ss += b[i8] * b[i8]; }
                    if (outf) { *(f32x4*)(outf + o2) = (f32x4){b[0], b[1], b[2], b[3]}; *(f32x4*)(outf + o2 + 4) = (f32x4){b[4], b[5], b[6], b[7]}; }
                    if (hb) { u32x4e w; w.x = cvt_pk_bf16(b[0], b[1]); w.y = cvt_pk_bf16(b[2], b[3]); w.z = cvt_pk_bf16(b[4], b[5]); w.w = cvt_pk_bf16(b[6], b[7]); *(u32x4e*)(hb + o2) = w; } }
                if (rowsq_out) { ss += __shfl_xor(ss, 16); ss += __shfl_xor(ss, 32); if (fq == 0) atomicAdd(rowsq_out + row, ss); } asm volatile("" ::: "memory"); }
    }
};
template <class Epi, class Sched, bool ALIGN_EPI = false, bool SP2 = false>
__device__ __forceinline__ void gemm_phase(PG8_LAS unsigned char* lds, const Gemm g, const Sched& S, const Epi& E, int tid_in) {
    const int tid = tid_in, wid = __builtin_amdgcn_readfirstlane(tid >> 6), lane = tid & 63, wr = wid >> 2, wc = wid & 3, fr = lane & 15, fq = lane >> 4;
    const int K = g.K, nt = K / BK;
    unsigned voffA[2], voffB[2];
#pragma unroll
    for (int i = 0; i < 2; ++i) { int R, C; stage_rc(tid * 16 + i * 8192, R, C); const int Rb = Epi::PERM ? ((R & ~31) + perm32(R & 31)) : R;
        voffA[i] = (unsigned)(R * K + C) * 2u; voffB[i] = (unsigned)(Rb * K + C) * 2u; }
    const size_t kstep = (size_t)(BK * 2);
    const size_t hstep = (size_t)HALF * K * 2;
    const size_t tstep = 2 * hstep;
    const unsigned ldsw = (unsigned)wid * 1024u;
    const int aoff = lds_byte(wr * 64 + fr, fq * 8), boff = lds_byte(wc * 32 + fr, fq * 8);
#define PG8_SA(b, h) (((b) * 2 + (h)) * HTB)
#define PG8_SB(b, h) ((4 + (b) * 2 + (h)) * HTB)
#define PG8_STAGE(bufoff, gbase, voff) do { _Pragma("unroll") for (int _i = 0; _i < 2; ++_i) \
        __builtin_amdgcn_global_load_lds((const unsigned*)((const char*)(gbase) + (voff)[_i]), (PG8_LAS unsigned*)(lds + (bufoff) + ldsw + _i * 8192), 16, 0, 0); } while (0)
#define PG8_LDA(dst, b, h) do { _Pragma("unroll") for (int m = 0; m < 4; ++m) _Pragma("unroll") for (int k = 0; k < 2; ++k) dst[m][k] = *(const PG8_LAS bf16x8*)(lds + PG8_SA(b, h) + aoff + m * 2048 + k * 1024); } while (0)
#define PG8_LDB(dst, b, h) do { _Pragma("unroll") for (int n = 0; n < 2; ++n) _Pragma("unroll") for (int k = 0; k < 2; ++k) dst[n][k] = *(const PG8_LAS bf16x8*)(lds + PG8_SB(b, h) + boff + n * 2048 + k * 1024); } while (0)
#define PG8_MMA(ai, bj, At, Bt) do { __builtin_amdgcn_s_setprio(1); _Pragma("unroll") for (int m = 0; m < 4; ++m) _Pragma("unroll") for (int n = 0; n < 2; ++n) _Pragma("unroll") for (int k = 0; k < 2; ++k) \
        acc[ai][bj][m][n] = __builtin_amdgcn_mfma_f32_16x16x32_bf16(Bt[n][k], At[m][k], acc[ai][bj][m][n], 0, 0, 0); __builtin_amdgcn_s_setprio(0); } while (0)
#define PG8_WAIT_V(n) asm volatile("s_waitcnt vmcnt(" #n ")" ::: "memory")
#define PG8_WAIT_L(n) asm volatile("s_waitcnt lgkmcnt(" #n ")" ::: "memory")
#define PG8_BAR __builtin_amdgcn_s_barrier()
#define PG8_SCHED __builtin_amdgcn_sched_barrier(0)
    Unit cur, nxt; int ui = 0;
    if (!S.next(0, cur)) return;
    f32x4 acc[2][2][4][2];
#pragma unroll
    for (int a = 0; a < 2; ++a)
#pragma unroll
        for (int b = 0; b < 2; ++b)
#pragma unroll
            for (int m = 0; m < 4; ++m)
#pragma unroll
                for (int n = 0; n < 2; ++n) acc[a][b][m][n] = (f32x4){0.f, 0.f, 0.f, 0.f};
    bf16x8 At[4][2], B0[2][2], B1[2][2];
    const char* cA = (const char*)g.A + (size_t)cur.pm * tstep; const char* cB = (const char*)g.Bt + (size_t)cur.pn * tstep;
    S.a_ready(cur);
    if constexpr (SP2) {
        PG8_STAGE(PG8_SB(0, 0), cB, voffB); PG8_STAGE(PG8_SB(0, 1), cB + hstep, voffB); PG8_STAGE(PG8_SA(0, 0), cA, voffA); PG8_STAGE(PG8_SA(0, 1), cA + hstep, voffA);
        if (wr == 1) PG8_BAR;
        PG8_WAIT_V(2); PG8_BAR;
        PG8_STAGE(PG8_SB(1, 0), cB + kstep, voffB); PG8_STAGE(PG8_SA(1, 0), cA + kstep, voffA); PG8_STAGE(PG8_SB(1, 1), cB + hstep + kstep, voffB);
        PG8_WAIT_V(6); PG8_BAR;
    } else {
        PG8_STAGE(PG8_SB(0, 0), cB, voffB); PG8_STAGE(PG8_SA(0, 0), cA, voffA); PG8_STAGE(PG8_SB(0, 1), cB + hstep, voffB); PG8_STAGE(PG8_SA(0, 1), cA + hstep, voffA);
        if (wr == 1) PG8_BAR;
        PG8_WAIT_V(4); PG8_BAR;
        PG8_STAGE(PG8_SB(1, 0), cB + kstep, voffB); PG8_STAGE(PG8_SA(1, 0), cA + kstep, voffA); PG8_STAGE(PG8_SB(1, 1), cB + hstep + kstep, voffB);
        PG8_WAIT_V(6); PG8_BAR;
    }
    for (;;) {
        const bool has_next = S.next(ui + 1, nxt);
        const char* nA = has_next ? (const char*)g.A + (size_t)nxt.pm * tstep : cA; const char* nB = has_next ? (const char*)g.Bt + (size_t)nxt.pn * tstep : cB;
        for (int t = 0; t < nt; t += 2) {
            const bool last = (t == nt - 2);
            const char* a1 = cA + (size_t)(t + 1) * kstep;
            const char* a2 = last ? nA : cA + (size_t)(t + 2) * kstep; const char* b2 = last ? nB : cB + (size_t)(t + 2) * kstep;
            const char* a3 = a2 + kstep; const char* b3 = b2 + kstep;
            if (last && has_next) S.a_ready(nxt);
            if constexpr (SP2) {
            PG8_LDB(B0, 0, 0); PG8_LDB(B1, 0, 1); PG8_SCHED; PG8_LDA(At, 0, 0); PG8_STAGE(PG8_SA(1, 1), a1 + hstep, voffA);
            PG8_WAIT_V(8); PG8_WAIT_L(0); PG8_BAR; PG8_MMA(0, 0, At, B0); PG8_MMA(0, 1, At, B1); PG8_BAR; PG8_SCHED;
            PG8_LDA(At, 0, 1); PG8_STAGE(PG8_SB(0, 0), b2, voffB); PG8_STAGE(PG8_SB(0, 1), b2 + hstep, voffB); PG8_STAGE(PG8_SA(0, 0), a2, voffA);
            PG8_WAIT_V(8); PG8_WAIT_L(0); PG8_BAR; PG8_MMA(1, 0, At, B0); PG8_MMA(1, 1, At, B1); PG8_BAR; PG8_SCHED;
            PG8_LDB(B0, 1, 0); PG8_LDB(B1, 1, 1); PG8_SCHED; PG8_LDA(At, 1, 0); PG8_STAGE(PG8_SA(0, 1), a2 + hstep, voffA);
            PG8_WAIT_V(8); PG8_WAIT_L(0); PG8_BAR; PG8_MMA(0, 0, At, B0); PG8_MMA(0, 1, At, B1); PG8_BAR; PG8_SCHED;
            PG8_LDA(At, 1, 1); PG8_STAGE(PG8_SB(1, 0), b3, voffB); PG8_STAGE(PG8_SB(1, 1), b3 + hstep, voffB); PG8_STAGE(PG8_SA(1, 0), a3, voffA);
            PG8_WAIT_V(8); PG8_WAIT_L(0); PG8_BAR; PG8_MMA(1, 0, At, B0); PG8_MMA(1, 1, At, B1); PG8_BAR; PG8_SCHED;
            } else {
            PG8_LDB(B0, 0, 0); PG8_SCHED; PG8_LDA(At, 0, 0); PG8_STAGE(PG8_SA(1, 1), a1 + hstep, voffA);
            PG8_WAIT_L(8); PG8_BAR; PG8_WAIT_L(0); PG8_MMA(0, 0, At, B0); PG8_BAR; PG8_SCHED;
            PG8_LDB(B1, 0, 1); PG8_STAGE(PG8_SB(0, 0), b2, voffB);
            PG8_BAR; PG8_WAIT_L(0); PG8_MMA(0, 1, At, B1); PG8_BAR;
            PG8_LDA(At, 0, 1); PG8_STAGE(PG8_SA(0, 0), a2, voffA);
            PG8_BAR; PG8_WAIT_L(0); PG8_MMA(1, 0, At, B0); PG8_BAR; PG8_SCHED;
            PG8_STAGE(PG8_SB(0, 1), b2 + hstep, voffB);
            PG8_WAIT_V(6); PG8_BAR; PG8_MMA(1, 1, At, B1); PG8_BAR;
            PG8_LDB(B0, 1, 0); PG8_SCHED; PG8_LDA(At, 1, 0); PG8_STAGE(PG8_SA(0, 1), a2 + hstep, voffA);
            PG8_WAIT_L(8); PG8_BAR; PG8_WAIT_L(0); PG8_MMA(0, 0, At, B0); PG8_BAR; PG8_SCHED;
            PG8_LDB(B1, 1, 1); PG8_STAGE(PG8_SB(1, 0), b3, voffB);
            PG8_BAR; PG8_WAIT_L(0); PG8_MMA(0, 1, At, B1); PG8_BAR;
            PG8_LDA(At, 1, 1); PG8_STAGE(PG8_SA(1, 0), a3, voffA);
            PG8_BAR; PG8_WAIT_L(0); PG8_MMA(1, 0, At, B0); PG8_BAR; PG8_SCHED;
            PG8_STAGE(PG8_SB(1, 1), b3 + hstep, voffB);
            PG8_WAIT_V(6); PG8_BAR; PG8_MMA(1, 1, At, B1); PG8_BAR;
            }
        }
        if constexpr (ALIGN_EPI) { if (wr == 0) PG8_BAR; }
        if constexpr (!Epi::AFTER_DRAIN) { E(acc, cur, wr, wc, fr, fq); S.done(cur); }
        if (!has_next) break;
#pragma unroll
        for (int a = 0; a < 2; ++a)
#pragma unroll
            for (int b = 0; b < 2; ++b)
#pragma unroll
                for (int m = 0; m < 4; ++m)
#pragma unroll
                    for (int n = 0; n < 2; ++n) acc[a][b][m][n] = (f32x4){0.f, 0.f, 0.f, 0.f};
        cur = nxt; cA = nA; cB = nB; ++ui;
        if constexpr (ALIGN_EPI) { if (wr == 1) PG8_BAR; }
    }
    PG8_WAIT_V(0);
    if constexpr (!ALIGN_EPI) { if (wr == 0) PG8_BAR; }
    PG8_BAR;
    if constexpr (Epi::AFTER_DRAIN) { E.fused(acc, cur, wr, wc, fr, fq, lds, wid, lane); S.done(cur); }
#undef PG8_SA
#undef PG8_SB
#undef PG8_STAGE
#undef PG8_LDA
#undef PG8_LDB
#undef PG8_MMA
#undef PG8_WAIT_V
#undef PG8_WAIT_L
#undef PG8_BAR
#undef PG8_SCHED
}
}
#define LAS __attribute__((address_space(3)))
typedef unsigned short bf16;
typedef short bf16x8 __attribute__((ext_vector_type(8)));
typedef float f32x4 __attribute__((ext_vector_type(4)));
typedef float f32x16 __attribute__((ext_vector_type(16)));
typedef unsigned u32x4 __attribute__((ext_vector_type(4)));
typedef unsigned long long u64;
constexpr int NB = 32, SEQ = 2048, DM = 1024, M = NB * SEQ;
constexpr int EV_N = 3656, EV_NP = 3840, OD_N = 4112, OD_NP = 4352, DFF = 2816;
constexpr float EPS = 1e-6f;
constexpr size_t MiB = (size_t)1 << 20;
constexpr size_t WS_RSQ = 0;
constexpr size_t WS_BAR = 3 * MiB;
constexpr size_t WS_W = 4 * MiB;
constexpr size_t W_EVIN = WS_W, W_EVOUT = W_EVIN + (size_t)EV_NP * 1024 * 2, W_ODIN = W_EVOUT + 2 * MiB, W_ODOUT = W_ODIN + (size_t)OD_NP * 1024 * 2;
constexpr size_t W_GU = W_ODOUT + 2 * MiB, W_DN = W_GU + 2 * (size_t)2 * DFF * 1024 * 2, W_PJ = W_DN + 2 * (size_t)DFF * 1024 * 2, W_PG = W_PJ + 2 * (size_t)256 * 1024 * 2, W_END = W_PG + 4 * MiB;
static_assert(W_END <= 62 * MiB, "weights");
constexpr size_t WS_HBA = 62 * MiB, WS_HBB = 190 * MiB, WS_Y = 318 * MiB, WS_Z = 446 * MiB, WS_TAIL = 990 * MiB, WS_END = 1024 * MiB;
constexpr size_t WS_QP = WS_HBA, WS_KP = WS_HBA + 64 * MiB;
constexpr size_t WS_QI = 926 * MiB, WS_KI = WS_TAIL, WS_WI = WS_TAIL + 8 * MiB, WS_MASK = WS_TAIL + 10 * MiB;
constexpr size_t WS_HID = WS_Z, WS_ERAW = WS_Z + 352 * MiB, WS_PB = WS_TAIL;
constexpr size_t WS_TG = WS_HBA, WS_KPD = WS_HBB, WS_VBD = WS_Y, WS_GCUM = WS_TAIL, WS_BETA = WS_TAIL + 2 * MiB;
constexpr int LDS_BYTES = 160 * 1024;
constexpr int NPH = 16;

__device__ __forceinline__ float bf2f(unsigned short b) { return __uint_as_float((unsigned)b << 16); }
__device__ __forceinline__ unsigned pk2(float lo, float hi) { return pg8::cvt_pk_bf16(lo, hi); }
__device__ __forceinline__ unsigned short f2bf(float f) { return (unsigned short)(pk2(f, 0.f) & 0xffffu); }
__device__ __forceinline__ void unpack8(const u32x4 w, float* v) {
    v[0] = __uint_as_float(w.x << 16); v[1] = __uint_as_float(w.x & 0xffff0000u); v[2] = __uint_as_float(w.y << 16); v[3] = __uint_as_float(w.y & 0xffff0000u);
    v[4] = __uint_as_float(w.z << 16); v[5] = __uint_as_float(w.z & 0xffff0000u); v[6] = __uint_as_float(w.w << 16); v[7] = __uint_as_float(w.w & 0xffff0000u); }
__device__ __forceinline__ void ld8(const bf16* p, float* v) { unpack8(*(const u32x4*)p, v); }
__device__ __forceinline__ u32x4 pack8(const float* v) { u32x4 w; w.x = pk2(v[0], v[1]); w.y = pk2(v[2], v[3]); w.z = pk2(v[4], v[5]); w.w = pk2(v[6], v[7]); return w; }
__device__ __forceinline__ void st8(bf16* p, const float* v) { *(u32x4*)p = pack8(v); }
__device__ __forceinline__ float sigmoidf_(float x) { return __builtin_amdgcn_rcpf(1.0f + __builtin_amdgcn_exp2f(-1.4426950408889634f * x)); }
__device__ __forceinline__ float siluf_(float x) { return x * sigmoidf_(x); }
#define MFMA16(a, b, c) __builtin_amdgcn_mfma_f32_16x16x32_bf16((a), (b), (c), 0, 0, 0)
#define MFMA32(a, b, c) __builtin_amdgcn_mfma_f32_32x32x16_bf16((a), (b), (c), 0, 0, 0)

struct Args { const void* in[25]; float* out; unsigned char* ws; int ph_lo, ph_hi, coop, pad; };
typedef const __attribute__((address_space(4))) Args CArgs;
__device__ __forceinline__ CArgs* launder_args(CArgs* p) { asm volatile("" : "+s"(p)); return p; }

__device__ __forceinline__ void transpose_item(const float* W, int K, int N, int NP, bf16* WT, const float* gain, int mode, LAS float* scr, int item, int lane) {
    const int nnb = NP / 32, kb = item / nnb, nb = item % nnb, k0 = 64 * kb, n0 = 32 * nb;
    const int n = n0 + (lane & 31);
#pragma unroll
    for (int i = 0; i < 32; ++i) { const int kk = 2 * i + (lane >> 5); float v = 0.f; if (n < N) { v = W[(size_t)(k0 + kk) * N + n]; if (gain) v *= gain[k0 + kk]; } scr[kk * 33 + (lane & 31)] = v; }
    asm volatile("s_waitcnt lgkmcnt(0)" ::: "memory");
    const int c = lane & 7;
    const int r0 = (mode == 0) ? n0 : ((n0 >> 7) * 256 + (mode == 2 ? 128 : 0) + (n0 & 127));
#pragma unroll
    for (int j = 0; j < 4; ++j) { const int nn = (lane >> 3) + 8 * j; const LAS float* s = scr + (8 * c) * 33 + nn;
        u32x4 o; o.x = pk2(s[0 * 33], s[1 * 33]); o.y = pk2(s[2 * 33], s[3 * 33]); o.z = pk2(s[4 * 33], s[5 * 33]); o.w = pk2(s[6 * 33], s[7 * 33]);
        *(u32x4*)(WT + (size_t)(r0 + nn) * K + k0 + 8 * c) = o; }
    asm volatile("s_waitcnt lgkmcnt(0)" ::: "memory");
}
__device__ __forceinline__ float wave_sum(float v) {
#pragma unroll
    for (int o = 1; o < 64; o <<= 1) v += __shfl_xor(v, o);
    return v;
}
__device__ __forceinline__ void prologue(CArgs& a, LAS unsigned char* lds, int tid) {
    const int lane = tid & 63, wave = tid >> 6, gw = blockIdx.x * 8 + wave, NGW = gridDim.x * 8;
    LAS float* scr = (LAS float*)(lds + wave * 16384);
    unsigned char* ws = a.ws;
    int it = gw;
#define DO_MAT(Wp, K_, N_, NP_, dst, gain, mode) { const int cnt = ((K_) / 64) * ((NP_) / 32); for (; it < cnt; it += NGW) transpose_item((Wp), (K_), (N_), (NP_), (bf16*)(dst), (gain), (mode), scr, it, lane); it -= cnt; }
    const float* nmg = (const float*)a.in[3]; const float* nfg = (const float*)a.in[4]; const float* png = (const float*)a.in[23];
    DO_MAT((const float*)a.in[5], 1024, EV_N, EV_NP, ws + W_EVIN, nmg, 0)
    DO_MAT((const float*)a.in[11], 1024, 1024, 1024, ws + W_EVOUT, (const float*)nullptr, 0)
    DO_MAT((const float*)a.in[12], 1024, OD_N, OD_NP, ws + W_ODIN, nmg + 1024, 0)
    DO_MAT((const float*)a.in[17], 1024, 1024, 1024, ws + W_ODOUT, (const float*)nullptr, 0)
    for (int l = 0; l < 2; ++l) {
        DO_MAT((const float*)a.in[18] + (size_t)l * 1024 * DFF, 1024, DFF, DFF, ws + W_GU + (size_t)l * 2 * DFF * 1024 * 2, nfg + l * 1024, 1)
        DO_MAT((const float*)a.in[19] + (size_t)l * 1024 * DFF, 1024, DFF, DFF, ws + W_GU + (size_t)l * 2 * DFF * 1024 * 2, nfg + l * 1024, 2)
        DO_MAT((const float*)a.in[20] + (size_t)l * 1024 * DFF, DFF, 1024, 1024, ws + W_DN + (size_t)l * DFF * 1024 * 2, (const float*)nullptr, 0)
        DO_MAT((const float*)a.in[21] + (size_t)l * 256 * 1024, 256, 1024, 1024, ws + W_PJ + (size_t)l * 256 * 1024 * 2, (const float*)nullptr, 0)
        DO_MAT((const float*)a.in[24] + (size_t)l * 1024 * 1024, 1024, 1024, 1024, ws + W_PG + (size_t)l * 1024 * 1024 * 2, png + l * 1024, 0)
    }
#undef DO_MAT
    const float* x = (const float*)a.in[0]; bf16* xb = (bf16*)(ws + WS_HBB); float* rsq = (float*)(ws + WS_RSQ);
    for (int m0 = gw; m0 < M; m0 += 4 * NGW) {
        f32x4 v[4][4];
#pragma unroll
        for (int r = 0; r < 4; ++r) { const int m = m0 + r * NGW; if (m < M) { const f32x4* xr = (const f32x4*)(x + (size_t)m * DM) + lane;
#pragma unroll
            for (int j = 0; j < 4; ++j) v[r][j] = xr[64 * j]; } }
#pragma unroll
        for (int r = 0; r < 4; ++r) { const int m = m0 + r * NGW; if (m < M) { unsigned long long* o8 = (unsigned long long*)(xb + (size_t)m * DM) + lane; float s = 0.f;
#pragma unroll
            for (int j = 0; j < 4; ++j) { const f32x4 w = v[r][j]; s += (w.x * w.x + w.y * w.y) + (w.z * w.z + w.w * w.w); o8[64 * j] = (unsigned long long)pk2(w.x, w.y) | ((unsigned long long)pk2(w.z, w.w) << 32); }
            s = wave_sum(s); if (lane == 0) rsq[m] = s; } }
    }
    for (int i = blockIdx.x * 512 + tid; i < 7 * M; i += gridDim.x * 512) rsq[M + i] = 0.f;
}
__device__ __forceinline__ void convert_p(const float* p, bf16* pb, int tid) {
    for (size_t i = (size_t)blockIdx.x * 512 + tid; i < (size_t)M * 256 / 8; i += (size_t)gridDim.x * 512) {
        const f32x4 v0 = *(const f32x4*)(p + i * 8), v1 = *(const f32x4*)(p + i * 8 + 4);
        u32x4 w; w.x = pk2(v0.x, v0.y); w.y = pk2(v0.z, v0.w); w.z = pk2(v1.x, v1.y); w.w = pk2(v1.z, v1.w); *(u32x4*)(pb + i * 8) = w; }
}

__device__ __forceinline__ void rope8(float* x, const LAS float* cs, const LAS float* sn, int i0, int xorm, bool first, bool active) {
#pragma unroll
    for (int e = 0; e < 8; ++e) { const float p = __shfl_xor(x[e], xorm); const float c = cs[i0 + e], s = sn[i0 + e]; const float r = first ? x[e] * c - p * s : p * s + x[e] * c; if (active) x[e] = r; }
}
__device__ __forceinline__ void even_post(CArgs& a, LAS unsigned char* lds, int tid) {
    const int lane = tid & 63, wave = tid >> 6, gw = blockIdx.x * 8 + wave, NGW = gridDim.x * 8, j = lane & 7, col = 8 * lane;
    LAS float* rs = (LAS float*)(lds + wave * 512);
    unsigned char* ws = a.ws;
    const bf16* Z = (const bf16*)(ws + WS_Z); bf16* Y = (bf16*)(ws + WS_Y); bf16* QP = (bf16*)(ws + WS_QP); bf16* KP = (bf16*)(ws + WS_KP);
    bf16* QI = (bf16*)(ws + WS_QI); bf16* KI = (bf16*)(ws + WS_KI); float* WI = (float*)(ws + WS_WI);
    const int* positions = (const int*)a.in[2]; const float* cw = (const float*)a.in[6];
    const float* qg = (const float*)a.in[7]; const float* kg = (const float*)a.in[8]; const float* lng = (const float*)a.in[9]; const float* lnb = (const float*)a.in[10];
    float cw0[8], cw1[8], cw2[8], qgv[8], kgv[8];
#pragma unroll
    for (int e = 0; e < 8; ++e) { cw0[e] = cw[col + e]; cw1[e] = cw[512 + col + e]; cw2[e] = cw[1024 + col + e]; qgv[e] = qg[(col & 63) + e]; kgv[e] = kg[(col & 63) + e]; }
    const float inva = 1.0f / powf(10000.f, (float)(2 * (lane & 31)) / 64.f), invi = 1.0f / powf(10000.f, (float)(2 * (lane & 15)) / 32.f);
    for (int row = gw; row < M; row += NGW) {
        const int t = row & (SEQ - 1); const float pos = (float)positions[row];
        if (lane < 32) { const float ang = pos * inva; rs[lane] = cosf(ang); rs[32 + lane] = sinf(ang); }
        else if (lane < 48) { const float ang = pos * invi; rs[64 + lane - 32] = cosf(ang); rs[80 + lane - 32] = sinf(ang); }
        const bf16* z = Z + (size_t)row * EV_NP;
        float v[8], u0[8], u1[8], u2[8], tmp[8];
        const bf16* z1 = z - (t >= 1 ? EV_NP : 0); const bf16* z2 = z - (t >= 2 ? 2 * EV_NP : 0); const float m1 = t >= 1 ? 1.f : 0.f, m2 = t >= 2 ? 1.f : 0.f;
        const u32x4 r_zb = *(const u32x4*)(z + col), r_c0 = *(const u32x4*)(z + 512 + col), r_h0 = *(const u32x4*)(z + 1024 + col);
        const u32x4 r_c1 = *(const u32x4*)(z1 + 512 + col), r_h1 = *(const u32x4*)(z1 + 1024 + col), r_c2 = *(const u32x4*)(z2 + 512 + col), r_h2 = *(const u32x4*)(z2 + 1024 + col);
        const u32x4 r_q = *(const u32x4*)(z + 1536 + col), r_k = *(const u32x4*)(z + 2048 + col), r_qi = *(const u32x4*)(z + 3072 + col), r_ki = *(const u32x4*)(z + 3584 + 8 * j), r_wi = *(const u32x4*)(z + 3648);
        unpack8(r_c0, u0); unpack8(r_h0, tmp);
#pragma unroll
        for (int e = 0; e < 8; ++e) u0[e] *= tmp[e];
        unpack8(r_c1, u1); unpack8(r_h1, tmp);
#pragma unroll
        for (int e = 0; e < 8; ++e) u1[e] *= tmp[e] * m1;
        unpack8(r_c2, u2); unpack8(r_h2, tmp);
#pragma unroll
        for (int e = 0; e < 8; ++e) u2[e] *= tmp[e] * m2;
        unpack8(r_zb, v);
#pragma unroll
        for (int e = 0; e < 8; ++e) v[e] = v[e] * (cw0[e] * u2[e] + cw1[e] * u1[e] + cw2[e] * u0[e]);
        st8(Y + (size_t)row * 1024 + col, v);
#pragma unroll
        for (int which = 0; which < 2; ++which) {
            unpack8(which ? r_k : r_q, v); float ss = 0.f;
#pragma unroll
            for (int e = 0; e < 8; ++e) ss += v[e] * v[e];
            ss += __shfl_xor(ss, 1); ss += __shfl_xor(ss, 2); ss += __shfl_xor(ss, 4);
            const float r = __builtin_amdgcn_rsqf(ss * (1.0f / 64.0f) + EPS);
#pragma unroll
            for (int e = 0; e < 8; ++e) v[e] = v[e] * r * (which ? kgv[e] : qgv[e]);
            rope8(v, rs, rs + 32, 8 * (j & 3), 4, j < 4, true);
            if (which == 0) {
#pragma unroll
                for (int e = 0; e < 8; ++e) v[e] *= 0.125f * 1.4426950408889634f;
                st8(QP + (size_t)row * 512 + col, v);
            } else st8(KP + (size_t)row * 512 + col, v);
        }
        unpack8(r_qi, v);
        rope8(v, rs + 64, rs + 80, 8 * (j & 1), 2, j < 2, j < 4);
        st8(QI + (size_t)row * 512 + col, v);
        unpack8(r_ki, v);
        { float s = 0.f;
#pragma unroll
            for (int e = 0; e < 8; ++e) s += v[e];
            s += __shfl_xor(s, 1); s += __shfl_xor(s, 2); s += __shfl_xor(s, 4);
            const float mu = s * (1.0f / 64.0f); float q = 0.f;
#pragma unroll
            for (int e = 0; e < 8; ++e) { v[e] -= mu; q += v[e] * v[e]; }
            q += __shfl_xor(q, 1); q += __shfl_xor(q, 2); q += __shfl_xor(q, 4);
            const float r = __builtin_amdgcn_rsqf(q * (1.0f / 64.0f) + EPS);
#pragma unroll
            for (int e = 0; e < 8; ++e) v[e] = v[e] * r * lng[8 * j + e] + lnb[8 * j + e];
            rope8(v, rs + 64, rs + 80, 8 * (j & 1), 2, j < 2, j < 4);
            if (lane < 8) st8(KI + (size_t)row * 64 + 8 * j, v);
        }
        if (lane == 8) { unpack8(r_wi, v); float* wo = WI + (size_t)row * 8;
#pragma unroll
            for (int e = 0; e < 8; ++e) wo[e] = v[e] * 0.044194173824159216f; }
    }
}
#define XB_TMO      128
#define XB_XCNT(j)  (256  + 64 * (j))
#define XB_XSUB(j)  (1280 + 64 * (j))
#define XB_XGEN(j)  (2304 + 64 * (j))
#define XB_TOP      3328
#define XB_TOPGEN   3392
#define XCD_BAR_WORDS 3456
#define XB_SPIN_CAP (1u << 18)

__device__ __forceinline__ unsigned xb_ld(unsigned* p)              { return __hip_atomic_load(p, __ATOMIC_RELAXED, __HIP_MEMORY_SCOPE_AGENT); }
__device__ __forceinline__ unsigned xb_add(unsigned* p, unsigned v) { return __hip_atomic_fetch_add(p, v, __ATOMIC_RELAXED, __HIP_MEMORY_SCOPE_AGENT); }
__device__ __forceinline__ unsigned xb_xcc_id() { return (unsigned)__builtin_amdgcn_s_getreg((3 << 11) | 20) & 0xFu; }
#define XB_SPIN(cond, bar) do { unsigned _sp = 0; while (cond) { __builtin_amdgcn_s_sleep(1); \
    if ((++_sp & 255u) == 0u) { if (xb_ld(&(bar)[XB_TMO])) break; if (_sp > XB_SPIN_CAP) { atomicAdd(&(bar)[XB_TMO], 1u); break; } } } } while (0)

struct XcdBarrier {
    unsigned* bar; unsigned x;
    volatile LAS unsigned* st;
};

__device__ __forceinline__ XcdBarrier xcd_barrier_post(unsigned* bar, volatile LAS unsigned* st) {
    XcdBarrier b; b.bar = bar; b.x = xb_xcc_id(); b.st = st;
    if (threadIdx.x == 0) (void)xb_add(&bar[XB_XCNT(b.x)], 1u);
    return b;
}
__device__ __forceinline__ void xcd_barrier_complete(unsigned* bar, unsigned x, unsigned& nloc, unsigned& nx) {
    const unsigned G = gridDim.x * gridDim.y * gridDim.z;
    unsigned sum, cnt, mine, sp = 0u;
    for (;;) {
        sum = 0u; cnt = 0u; mine = 0u;
#pragma unroll
        for (unsigned j = 0; j < 16; ++j) { const unsigned c = xb_ld(&bar[XB_XCNT(j)]); sum += c; cnt += (c > 0u) ? 1u : 0u; mine = (j == x) ? c : mine; }
        if (sum == G) break;
        __builtin_amdgcn_s_sleep(1);
        if ((++sp & 255u) == 0u) { if (xb_ld(&bar[XB_TMO])) break; if (sp > XB_SPIN_CAP) { atomicAdd(&bar[XB_TMO], 1u); break; } }
    }
    nloc = mine > 0u ? mine : 1u; nx = cnt > 0u ? cnt : 1u;
}

__device__ __forceinline__ void xcd_barrier(const XcdBarrier& b) {
    asm volatile("s_waitcnt vmcnt(0)" ::: "memory");
    __syncthreads();
    if (threadIdx.x == 0) {
        unsigned* bar = b.bar;
        __builtin_amdgcn_s_waitcnt(0);
        unsigned nloc = b.st[0], nx = b.st[1];
        if (nloc == 0u) { xcd_barrier_complete(bar, b.x, nloc, nx); b.st[0] = nloc; b.st[1] = nx; }
        const unsigned old = xb_add(&bar[XB_XSUB(b.x)], 1u);
        const unsigned gen = old / nloc;
        if (old + 1u == (gen + 1u) * nloc) {
            __builtin_amdgcn_fence(__ATOMIC_RELEASE, "agent");
            asm volatile("s_waitcnt vmcnt(0)" ::: "memory");
            const unsigned og = xb_add(&bar[XB_TOP], 1u);
            const unsigned tg = og / nx;
            if (og + 1u == (tg + 1u) * nx) xb_add(&bar[XB_TOPGEN], 1u);
            else XB_SPIN(xb_ld(&bar[XB_TOPGEN]) == tg, bar);
            __builtin_amdgcn_fence(__ATOMIC_ACQUIRE, "agent");
            xb_add(&bar[XB_XGEN(b.x)], 1u);
            asm volatile("s_waitcnt vmcnt(0)" ::: "memory");
        } else {
            XB_SPIN(xb_ld(&bar[XB_XGEN(b.x)]) == gen, bar);
            __builtin_amdgcn_fence(__ATOMIC_ACQUIRE, "agent");
            asm volatile("s_waitcnt vmcnt(0)" ::: "memory");
        }
    }
    __syncthreads();
}
__device__ __forceinline__ void idx_phase(LAS unsigned char* lds, const bf16* QI, const bf16* KI, const float* WI, u64* MASK, int tid) {
    const int lane = tid & 63, wave = __builtin_amdgcn_readfirstlane(tid >> 6), l15 = lane & 15, kq = lane >> 4;
    LAS float* sc = (LAS float*)lds; constexpr int SCP = 2052;
    for (int u = blockIdx.x; u < 4096; u += gridDim.x) {
        const int b = u & 31, r = u >> 5, rnd = r >> 3, sub = r & 7; const int qt = rnd * 8 + ((rnd & 1) ? 7 - sub : sub);
        const int q0 = qt * 16; const size_t rb = (size_t)b * SEQ;
        if (q0 < 256) {
            for (int qq = 2 * wave; qq < 2 * wave + 2; ++qq) { const int t = q0 + qq; if (lane < 32) { const int n = t + 1 - 64 * lane; const u64 w = n <= 0 ? 0ull : (n >= 64 ? ~0ull : ((1ull << n) - 1ull)); MASK[(rb + t) * 32 + lane] = w; } }
            continue;
        }
        bf16x8 Bq[8][2]; float wv[8];
        { const bf16* qp = QI + (rb + q0 + l15) * 512 + kq * 8; const float* wp = WI + (rb + q0 + l15) * 8;
#pragma unroll
            for (int h = 0; h < 8; ++h) { Bq[h][0] = *(const bf16x8*)(qp + h * 64); Bq[h][1] = *(const bf16x8*)(qp + h * 64 + 32); wv[h] = wp[h]; } }
        bf16x8 A0n, A1n, A0m, A1m;
        { const int kt0 = wave <= qt ? wave : qt; const bf16* kp = KI + (rb + 16 * kt0 + l15) * 64 + kq * 8; A0n = *(const bf16x8*)kp; A1n = *(const bf16x8*)(kp + 32);
          const int kt1 = wave + 8 <= qt ? wave + 8 : qt; const bf16* kp1 = KI + (rb + 16 * kt1 + l15) * 64 + kq * 8; A0m = *(const bf16x8*)kp1; A1m = *(const bf16x8*)(kp1 + 32); }
        for (int kt = wave; kt <= qt; kt += 8) {
            const bf16x8 A0 = A0n, A1 = A1n; A0n = A0m; A1n = A1m;
            { const int ktn = kt + 16 <= qt ? kt + 16 : qt; const bf16* kp = KI + (rb + 16 * ktn + l15) * 64 + kq * 8; A0m = *(const bf16x8*)kp; A1m = *(const bf16x8*)(kp + 32); }
            f32x4 s = {0.f, 0.f, 0.f, 0.f};
#pragma unroll
            for (int h = 0; h < 8; ++h) { f32x4 D = {0.f, 0.f, 0.f, 0.f}; D = MFMA16(A0, Bq[h][0], D); D = MFMA16(A1, Bq[h][1], D);
#pragma unroll
                for (int e = 0; e < 4; ++e) s[e] = fmaf(wv[h], fmaxf(D[e], 0.f), s[e]); }
            *(LAS f32x4*)(sc + l15 * SCP + 16 * kt + 4 * kq) = s;
        }
        __syncthreads();
        for (int qq = 2 * wave; qq < 2 * wave + 2; ++qq) {
            const int t = q0 + qq; const int nrows = __builtin_amdgcn_readfirstlane((t >> 6) + 1);
            unsigned kv[32];
#pragma unroll
            for (int i = 0; i < 32; ++i) { const int idx = 64 * i + lane; unsigned k = 0u;
                if (idx <= t) { const float f = sc[qq * SCP + idx]; unsigned ub = __float_as_uint(f); if (f == 0.f) ub = 0u; k = (ub & 0x80000000u) ? ~ub : (ub | 0x80000000u); }
                kv[i] = k; }
            unsigned T = 0u;
            for (int bit = 31; bit >= 0; --bit) {
                const unsigned cand = T | (1u << bit); int cnt = 0;
#pragma unroll
                for (int g = 0; g < 4; ++g) if (8 * g < nrows) {
                    u64 bm[8];
#pragma unroll
                    for (int i = 0; i < 8; ++i) bm[i] = __ballot(kv[8 * g + i] >= cand);
                    __builtin_amdgcn_sched_barrier(0);
#pragma unroll
                    for (int i = 0; i < 8; ++i) cnt += __popcll(bm[i]);
                    __builtin_amdgcn_sched_barrier(0); }
                if (cnt >= 256) { T = cand; if (cnt == 256) break; }
            }
            int cgt = 0;
#pragma unroll
            for (int g = 0; g < 4; ++g) if (8 * g < nrows) {
#pragma unroll
                for (int i = 8 * g; i < 8 * g + 8; ++i) cgt += __popcll(__ballot(kv[i] > T)); }
            const int need = 256 - cgt; int tb = 0; u64 word = 0ull; const u64 ltm = (1ull << lane) - 1ull;
#pragma unroll
            for (int g = 0; g < 4; ++g) if (8 * g < nrows) {
#pragma unroll
                for (int i = 8 * g; i < 8 * g + 8; ++i) {
                    const u64 eqm = __ballot(kv[i] == T); const int rank = tb + __popcll(eqm & ltm);
                    const u64 selm = __ballot(kv[i] > T || (kv[i] == T && rank < need)); tb += __popcll(eqm);
                    if (lane == i) word = selm; } }
            if (lane < 32) MASK[(rb + t) * 32 + lane] = word;
        }
        __syncthreads();
    }
}

__device__ __forceinline__ int crow(int r, int hi) { return (r & 3) + 8 * (r >> 2) + 4 * hi; }
__device__ __forceinline__ void attn_phase(LAS unsigned char* lds, const bf16* QP, const bf16* KP, const bf16* Z0, const u64* MASK, bf16* Y, int tid) {
    const int lane = tid & 63, wave = __builtin_amdgcn_readfirstlane(tid >> 6), l31 = lane & 31, hi = lane >> 5;
    LAS bf16* Kb = (LAS bf16*)lds; LAS bf16* Vt = (LAS bf16*)(lds + 18432); LAS float* lsc = (LAS float*)(lds + 36864) + wave * 32;
    const int lk = tid >> 3, lc = tid & 7;
    for (int u = blockIdx.x; u < 256; u += gridDim.x) {
        const int b = u >> 3, h = u & 7; const size_t rb = (size_t)b * SEQ;
        for (int qb = 7; qb >= 0; --qb) {
            const int q0 = qb * 256, NT = 4 * (qb + 1), qw0 = q0 + 32 * wave, q = qw0 + l31;
            bf16x8 qr[4];
#pragma unroll
            for (int d0 = 0; d0 < 4; ++d0) qr[d0] = *(const bf16x8*)(QP + (rb + q) * 512 + h * 64 + 16 * d0 + 8 * hi);
            f32x16 O0, O1;
#pragma unroll
            for (int r = 0; r < 16; ++r) { O0[r] = 0.f; O1[r] = 0.f; }
            float l = 0.f;
            u32x4 kreg = *(const u32x4*)(KP + (rb + lk) * 512 + h * 64 + 8 * lc), vreg = *(const u32x4*)(Z0 + (rb + lane) * EV_NP + 2560 + h * 64 + 8 * wave);
#define ATT_STORE(buf) do { *(LAS u32x4*)(Kb + (buf) * 4608 + lk * 72 + 8 * lc) = kreg; LAS bf16* vt_ = Vt + (buf) * 4608 + (8 * wave) * 72 + lane; \
            vt_[0] = (bf16)(vreg.x & 0xffffu); vt_[72] = (bf16)(vreg.x >> 16); vt_[144] = (bf16)(vreg.y & 0xffffu); vt_[216] = (bf16)(vreg.y >> 16); \
            vt_[288] = (bf16)(vreg.z & 0xffffu); vt_[360] = (bf16)(vreg.z >> 16); vt_[432] = (bf16)(vreg.w & 0xffffu); vt_[504] = (bf16)(vreg.w >> 16); } while (0)
            ATT_STORE(0);
            u64 mwn = MASK[(rb + q) * 32];
            __syncthreads();
            for (int t = 0; t < NT; ++t) {
                const int cur = t & 1; const u64 mw = mwn;
                if (t + 1 < NT) { kreg = *(const u32x4*)(KP + (rb + 64 * (t + 1) + lk) * 512 + h * 64 + 8 * lc); vreg = *(const u32x4*)(Z0 + (rb + 64 * (t + 1) + lane) * EV_NP + 2560 + h * 64 + 8 * wave); mwn = MASK[(rb + q) * 32 + t + 1]; }
                if (64 * t <= qw0 + 31) {
                    f32x16 S0, S1;
#pragma unroll
                    for (int r = 0; r < 16; ++r) { S0[r] = 0.f; S1[r] = 0.f; }
                    const LAS bf16* kb = Kb + cur * 4608 + l31 * 72 + 8 * hi;
#pragma unroll
                    for (int d0 = 0; d0 < 4; ++d0) { const bf16x8 a0 = *(const LAS bf16x8*)(kb + 16 * d0), a1 = *(const LAS bf16x8*)(kb + 32 * 72 + 16 * d0);
                        S0 = MFMA32(a0, qr[d0], S0); S1 = MFMA32(a1, qr[d0], S1); }
                    const unsigned mlo = (unsigned)mw >> (4 * hi), mhi = (unsigned)(mw >> 32) >> (4 * hi);
                    float ps = 0.f;
#pragma unroll
                    for (int r = 0; r < 16; ++r) { const int cb = (r & 3) + 8 * (r >> 2);
                        const unsigned b0 = (unsigned)__builtin_amdgcn_sbfe(mlo, cb, 1), b1 = (unsigned)__builtin_amdgcn_sbfe(mhi, cb, 1);
                        const float p0 = __uint_as_float(__float_as_uint(__builtin_amdgcn_exp2f(S0[r])) & b0), p1 = __uint_as_float(__float_as_uint(__builtin_amdgcn_exp2f(S1[r])) & b1);
                        ps += p0 + p1; S0[r] = p0; S1[r] = p1; }
                    l += ps;
                    u32x4 pw[4];
                    pw[0] = (u32x4){pk2(S0[0], S0[1]), pk2(S0[2], S0[3]), pk2(S0[4], S0[5]), pk2(S0[6], S0[7])};
                    pw[1] = (u32x4){pk2(S0[8], S0[9]), pk2(S0[10], S0[11]), pk2(S0[12], S0[13]), pk2(S0[14], S0[15])};
                    pw[2] = (u32x4){pk2(S1[0], S1[1]), pk2(S1[2], S1[3]), pk2(S1[4], S1[5]), pk2(S1[6], S1[7])};
                    pw[3] = (u32x4){pk2(S1[8], S1[9]), pk2(S1[10], S1[11]), pk2(S1[12], S1[13]), pk2(S1[14], S1[15])};
                    const LAS bf16* vt = Vt + cur * 4608 + l31 * 72 + 4 * hi;
#pragma unroll
                    for (int m = 0; m < 4; ++m) { const int base = 16 * (m & 1) + 32 * (m >> 1);
                        const u64 lo0 = *(const LAS u64*)(vt + base), hi0 = *(const LAS u64*)(vt + base + 8), lo1 = *(const LAS u64*)(vt + 32 * 72 + base), hi1 = *(const LAS u64*)(vt + 32 * 72 + base + 8);
                        const u32x4 v0 = {(unsigned)lo0, (unsigned)(lo0 >> 32), (unsigned)hi0, (unsigned)(hi0 >> 32)}, v1 = {(unsigned)lo1, (unsigned)(lo1 >> 32), (unsigned)hi1, (unsigned)(hi1 >> 32)};
                        O0 = MFMA32(__builtin_bit_cast(bf16x8, pw[m]), __builtin_bit_cast(bf16x8, v0), O0);
                        O1 = MFMA32(__builtin_bit_cast(bf16x8, pw[m]), __builtin_bit_cast(bf16x8, v1), O1); }
                }
                if (t + 1 < NT) ATT_STORE(cur ^ 1);
                __syncthreads();
            }
#undef ATT_STORE
            l += __shfl_xor(l, 32);
            if (hi == 0) lsc[l31] = l;
            asm volatile("s_waitcnt lgkmcnt(0)" ::: "memory");
#pragma unroll
            for (int r = 0; r < 16; ++r) { const int qr_ = crow(r, hi); const float rl = __builtin_amdgcn_rcpf(lsc[qr_]);
                bf16* yp = Y + (rb + qw0 + qr_) * 1024 + 512 + h * 64 + l31; yp[0] = f2bf(O0[r] * rl); yp[32] = f2bf(O1[r] * rl); }
        }
    }
}
__device__ __forceinline__ void conv16(const bf16* zbase, int t, const float* cwp, float* out) {
    float acc[16];
#pragma unroll
    for (int e = 0; e < 16; ++e) acc[e] = 0.f;
#pragma unroll
    for (int jt = 0; jt < 4; ++jt) { if (t - 3 + jt >= 0) { float x[16]; ld8(zbase + (ptrdiff_t)(jt - 3) * OD_NP, x); ld8(zbase + (ptrdiff_t)(jt - 3) * OD_NP + 8, x + 8);
            const float* w = cwp + jt * 3072;
#pragma unroll
            for (int e = 0; e < 16; ++e) acc[e] = fmaf(w[e], x[e], acc[e]); } }
#pragma unroll
    for (int e = 0; e < 16; ++e) out[e] = siluf_(acc[e]);
}
__device__ __forceinline__ void conv16_ld(const bf16* zbase, int t, u32x4* raw) {
#pragma unroll
    for (int jt = 0; jt < 4; ++jt) { const int back = (t - 3 + jt >= 0) ? (3 - jt) : 0; const bf16* p = zbase - (ptrdiff_t)back * OD_NP; raw[2 * jt] = *(const u32x4*)p; raw[2 * jt + 1] = *(const u32x4*)(p + 8); }
}
__device__ __forceinline__ void conv16_fin(const u32x4* raw, int t, const LAS float* wl, int c16, float* out) {
    float acc[16];
#pragma unroll
    for (int e = 0; e < 16; ++e) acc[e] = 0.f;
#pragma unroll
    for (int jt = 0; jt < 4; ++jt) { float x[16]; unpack8(raw[2 * jt], x); unpack8(raw[2 * jt + 1], x + 8); const float msk = (t - 3 + jt >= 0) ? 1.f : 0.f;
#pragma unroll
        for (int q4 = 0; q4 < 4; ++q4) { const f32x4 w = *(const LAS f32x4*)(wl + jt * 128 + c16 + 4 * q4);
#pragma unroll
            for (int e = 0; e < 4; ++e) acc[4 * q4 + e] = fmaf(w[e] * msk, x[4 * q4 + e], acc[4 * q4 + e]); } }
#pragma unroll
    for (int e = 0; e < 16; ++e) out[e] = siluf_(acc[e]);
}
__device__ __forceinline__ void dn_prep(CArgs& a, LAS unsigned char* lds, int tid) {
    const int lane = tid & 63, wave = __builtin_amdgcn_readfirstlane(tid >> 6), l15 = lane & 15, kq = lane >> 4;
    unsigned char* ws = a.ws;
    const bf16* Z1 = (const bf16*)(ws + WS_Z); bf16* KPD = (bf16*)(ws + WS_KPD); bf16* VBD = (bf16*)(ws + WS_VBD); bf16* TG = (bf16*)a.out;
    float* GCUM = (float*)(ws + WS_GCUM); float* BETA = (float*)(ws + WS_BETA);
    const float* cw = (const float*)a.in[13]; const float* a_log = (const float*)a.in[14]; const float* dt_bias = (const float*)a.in[15];
    LAS bf16* KN = (LAS bf16*)lds; LAS float* AM = (LAS float*)(lds + 17408); LAS float* GC = (LAS float*)(lds + 17408 + 131072); LAS float* BT = GC + 64; LAS float* CWK = GC + 128; LAS float* CWV = CWK + 512;
    const int row = tid >> 3, c8 = tid & 7;
    for (int grp = blockIdx.x; grp < 1024; grp += gridDim.x) {
        const int bh = grp >> 2, ng = grp & 3, b = bh >> 3, h = bh & 7; const size_t rb = (size_t)b * SEQ;
        { const int jt_ = tid >> 7, cc_ = tid & 127; CWK[jt_ * 128 + cc_] = cw[jt_ * 3072 + 1024 + h * 128 + cc_]; CWV[jt_ * 128 + cc_] = cw[jt_ * 3072 + 2048 + h * 128 + cc_]; }
        __syncthreads();
#ifndef NO_PREPA
        for (int ci = 0; ci < 8; ++ci) {
            const int n = ng * 8 + ci, t0 = 64 * n, t = t0 + row;
            if (tid < 64) { const int tt = t0 + tid; const bf16* zr = Z1 + (rb + tt) * OD_NP;
                const float av = bf2f(zr[4096 + h]), bv = bf2f(zr[4104 + h]); const float xx = av + dt_bias[h];
                const float sp = xx > 20.f ? xx : log1pf(expf(xx)); float g = -expf(a_log[h]) * sp; const float beta = sigmoidf_(bv);
#pragma unroll
                for (int o = 1; o < 64; o <<= 1) { const float up = __shfl_up(g, o); if (lane >= o) g += up; }
                GC[tid] = g; BT[tid] = beta; GCUM[(size_t)bh * SEQ + tt] = g; BETA[(size_t)bh * SEQ + tt] = beta; }
            const bf16* zr = Z1 + (rb + t) * OD_NP;
            u32x4 rawk[8], rawv[8]; conv16_ld(zr + 1024 + h * 128 + 16 * c8, t, rawk); conv16_ld(zr + 2048 + h * 128 + 16 * c8, t, rawv);
            const float betar = sigmoidf_(bf2f(zr[4104 + h]));
            float x[16];
            conv16_fin(rawk, t, CWK, 16 * c8, x);
            float ss = 0.f;
#pragma unroll
            for (int e = 0; e < 16; ++e) ss += x[e] * x[e];
            ss += __shfl_xor(ss, 1); ss += __shfl_xor(ss, 2); ss += __shfl_xor(ss, 4);
            const float rn = __builtin_amdgcn_rsqf(ss + EPS);
#pragma unroll
            for (int e = 0; e < 16; ++e) x[e] *= rn;
            { const u32x4 w0 = pack8(x), w1 = pack8(x + 8); bf16* kp = KPD + (rb + t) * 1024 + h * 128 + 16 * c8; *(u32x4*)kp = w0; *(u32x4*)(kp + 8) = w1;
              LAS bf16* kl = KN + row * 136 + 16 * c8; *(LAS u32x4*)kl = w0; *(LAS u32x4*)(kl + 8) = w1; }
            conv16_fin(rawv, t, CWV, 16 * c8, x);
            {
#pragma unroll
              for (int e = 0; e < 16; ++e) x[e] *= betar;
              bf16* vp = VBD + (rb + t) * 1024 + h * 128 + 16 * c8; *(u32x4*)vp = pack8(x); *(u32x4*)(vp + 8) = pack8(x + 8); }
            __syncthreads();
#pragma unroll
            for (int ti = 0; ti < 2; ++ti) { const int id = 2 * wave + ti, ct = id >> 2, st = id & 3; LAS float* am = AM + ci * 4096;
                f32x4 D = {0.f, 0.f, 0.f, 0.f};
                if (st <= ct) {
#pragma unroll
                    for (int ks = 0; ks < 4; ++ks) { const bf16x8 A = *(const LAS bf16x8*)(KN + (16 * ct + l15) * 136 + 32 * ks + 8 * kq), B = *(const LAS bf16x8*)(KN + (16 * st + l15) * 136 + 32 * ks + 8 * kq); D = MFMA16(A, B, D); }
                }
                const int s = 16 * st + l15; const float gs = GC[s];
#pragma unroll
                for (int e = 0; e < 4; ++e) { const int c = 16 * ct + 4 * kq + e; am[c * 64 + s] = (c > s) ? BT[c] * __expf(GC[c] - gs) * D[e] : 0.f; } }
            __syncthreads();
        }
#endif
#ifndef NO_FSUB
        {
            const LAS float* am = AM + wave * 4096; const int n = ng * 8 + wave; bf16* tg = TG + ((size_t)bh * 32 + n) * 4096;
            float xs[64];
#pragma unroll
            for (int i = 0; i < 64; ++i) { float acc0 = (i == lane) ? 1.f : 0.f, acc1 = 0.f;
#pragma unroll
                for (int jj = 0; jj < (i + 3) / 4; ++jj) { const f32x4 a4 = *(const LAS f32x4*)(am + i * 64 + 4 * jj);
#pragma unroll
                    for (int e = 0; e < 4; ++e) if (4 * jj + e < i) { if (jj & 1) acc1 = fmaf(-a4[e], xs[4 * jj + e], acc1); else acc0 = fmaf(-a4[e], xs[4 * jj + e], acc0); } }
                xs[i] = acc0 + acc1; tg[i * 64 + lane] = f2bf(xs[i]); __builtin_amdgcn_sched_barrier(0); }
        }
#endif
        __syncthreads();
    }
}

__device__ __forceinline__ void dn_scan(CArgs& a, LAS unsigned char* lds, int tid) {
    const int lane = tid & 63, wave = __builtin_amdgcn_readfirstlane(tid >> 6); int l15 = lane & 15, kq = lane >> 4;
    unsigned char* ws = a.ws;
    const bf16* Z1 = (const bf16*)(ws + WS_Z); const bf16* KPD = (const bf16*)(ws + WS_KPD); const bf16* VBD = (const bf16*)(ws + WS_VBD); const bf16* TG = (const bf16*)a.out;
    const float* GCUM = (const float*)(ws + WS_GCUM); const float* BETA = (const float*)(ws + WS_BETA); bf16* Y = (bf16*)(ws + WS_Y);
    const float* cw = (const float*)a.in[13]; const float* ong = (const float*)a.in[16];
    LAS bf16* TM = (LAS bf16*)lds; LAS bf16* KN = (LAS bf16*)(lds + 9216); LAS bf16* KT = (LAS bf16*)(lds + 26624); LAS bf16* QN = (LAS bf16*)(lds + 45056);
    LAS bf16* VB = (LAS bf16*)(lds + 62464); LAS bf16* STB = (LAS bf16*)(lds + 80896); LAS bf16* RT = (LAS bf16*)(lds + 115712); LAS bf16* VNT = (LAS bf16*)(lds + 134144);
    LAS float* GC = (LAS float*)(lds + 152576); LAS float* COEF = GC + 64; LAS float* EGL = GC + 128; LAS float* EG = GC + 192; LAS float* ONP = GC + 256;
    LAS bf16* QK = TM; LAS bf16* VNS = VB; LAS bf16* QKB = VB;     LAS float* CWQ = ONP + 512;
    LAS bf16* ZL = RT;
    int row = tid >> 3, c8 = tid & 7;
#define RELAUNDER() asm volatile("" : "+v"(l15), "+v"(kq), "+v"(row), "+v"(c8))
    for (int bh = blockIdx.x; bh < 256; bh += gridDim.x) {
        const int b = bh >> 3, h = bh & 7; const size_t rb = (size_t)b * SEQ;
        f32x4 St[8];
#pragma unroll
        for (int i = 0; i < 8; ++i) St[i] = (f32x4){0.f, 0.f, 0.f, 0.f};
        for (int i = tid; i < 128 * 136 / 8; i += 512) *(LAS u32x4*)(STB + 8 * i) = (u32x4){0u, 0u, 0u, 0u};
        float ongv = ong[16 * wave + l15];
        { const int jt_ = tid >> 7, cc_ = tid & 127; CWQ[jt_ * 128 + cc_] = cw[jt_ * 3072 + h * 128 + cc_]; }
        __syncthreads();
#ifndef DBG_NCH
#define DBG_NCH 32
#endif
        for (int n = 0; n < DBG_NCH; ++n) {
            RELAUNDER();
            const int t0 = 64 * n, t = t0 + row;
            u32x4 rawq[8]; conv16_ld(Z1 + (rb + t) * OD_NP + h * 128 + 16 * c8, t, rawq);
            const u32x4 tgv = *(const u32x4*)(TG + ((size_t)bh * 32 + n) * 4096 + tid * 8);
            const bf16* kp = KPD + (rb + t) * 1024 + h * 128 + 16 * c8; const u32x4 kw0 = *(const u32x4*)kp, kw1 = *(const u32x4*)(kp + 8);
            const bf16* vp = VBD + (rb + t) * 1024 + h * 128 + 16 * c8; const u32x4 vw0 = *(const u32x4*)vp, vw1 = *(const u32x4*)(vp + 8);
            const bf16* zp = Z1 + (rb + t) * OD_NP + 3072 + h * 128 + 16 * c8; const u32x4 zw0 = *(const u32x4*)zp, zw1 = *(const u32x4*)(zp + 8);
            const float gl = GCUM[(size_t)bh * SEQ + t0 + 63]; const float gcr = GCUM[(size_t)bh * SEQ + t0 + row];
            float gcv = 0.f, betav = 0.f; if (tid < 64) { gcv = GCUM[(size_t)bh * SEQ + t0 + tid]; betav = BETA[(size_t)bh * SEQ + t0 + tid]; }
            *(LAS u32x4*)(TM + row * 72 + 8 * c8) = tgv;
            { LAS bf16* kl = KN + row * 136 + 16 * c8; *(LAS u32x4*)kl = kw0; *(LAS u32x4*)(kl + 8) = kw1;
              LAS bf16* ktp = KT + (16 * c8) * 72 + row; float kx[16]; unpack8(kw0, kx); unpack8(kw1, kx + 8); const float eglr = __expf(gl - gcr);
#pragma unroll
              for (int e = 0; e < 16; ++e) ktp[e * 72] = f2bf(kx[e] * eglr); }
            { LAS bf16* vl = VB + row * 136 + 16 * c8; *(LAS u32x4*)vl = vw0; *(LAS u32x4*)(vl + 8) = vw1; }
            { float x[16]; conv16_fin(rawq, t, CWQ, 16 * c8, x); float ss = 0.f;
#pragma unroll
              for (int e = 0; e < 16; ++e) ss += x[e] * x[e];
              ss += __shfl_xor(ss, 1); ss += __shfl_xor(ss, 2); ss += __shfl_xor(ss, 4);
              const float rn = __builtin_amdgcn_rsqf(ss + EPS) * 0.08838834764831845f;
#pragma unroll
              for (int e = 0; e < 16; ++e) x[e] *= rn;
              LAS bf16* ql = QN + row * 136 + 16 * c8; *(LAS u32x4*)ql = pack8(x); *(LAS u32x4*)(ql + 8) = pack8(x + 8); }
            if (tid < 64) { GC[tid] = gcv; COEF[tid] = betav * __expf(gcv); EG[tid] = __expf(gcv); }
            const float egl_last = __expf(gl);
            __syncthreads(); RELAUNDER();
#pragma nounroll
            for (int st = 0; st < 4; ++st) { f32x4 D = {0.f, 0.f, 0.f, 0.f};
#pragma unroll
                for (int ks = 0; ks < 4; ++ks) { const bf16x8 A = *(const LAS bf16x8*)(STB + (16 * wave + l15) * 136 + 32 * ks + 8 * kq), B = *(const LAS bf16x8*)(KN + (16 * st + l15) * 136 + 32 * ks + 8 * kq); D = MFMA16(A, B, D); }
                const int s = 16 * st + l15; const float coef = COEF[s];
#pragma unroll
                for (int e = 0; e < 4; ++e) { const int dv = 16 * wave + 4 * kq + e; RT[dv * 72 + s] = f2bf(bf2f(VB[s * 136 + dv]) - coef * D[e]); } __builtin_amdgcn_sched_barrier(0); }
            f32x4 Oa[4];
#pragma unroll
            for (int ct = 0; ct < 4; ++ct) { f32x4 D = {0.f, 0.f, 0.f, 0.f};
#pragma unroll
                for (int ks = 0; ks < 4; ++ks) { const bf16x8 A = *(const LAS bf16x8*)(QN + (16 * ct + l15) * 136 + 32 * ks + 8 * kq), B = *(const LAS bf16x8*)(STB + (16 * wave + l15) * 136 + 32 * ks + 8 * kq); D = MFMA16(A, B, D); }
#pragma unroll
                for (int e = 0; e < 4; ++e) D[e] *= EG[16 * ct + 4 * kq + e];
                Oa[ct] = D; __builtin_amdgcn_sched_barrier(0); }
            __syncthreads(); RELAUNDER();
#pragma nounroll
            for (int ct = 0; ct < 4; ++ct) { f32x4 D = {0.f, 0.f, 0.f, 0.f};
#pragma unroll
                for (int ks = 0; ks < 2; ++ks) { const bf16x8 A = *(const LAS bf16x8*)(RT + (16 * wave + l15) * 72 + 32 * ks + 8 * kq), B = *(const LAS bf16x8*)(TM + (16 * ct + l15) * 72 + 32 * ks + 8 * kq); D = MFMA16(A, B, D); }
                const int c = 16 * ct + l15;
#pragma unroll
                for (int e = 0; e < 4; ++e) { const int dv = 16 * wave + 4 * kq + e; VNT[dv * 72 + c] = f2bf(D[e]); } __builtin_amdgcn_sched_barrier(0); }
#pragma unroll
            for (int ti = 0; ti < 2; ++ti) { const int id = 2 * wave + ti, ct = id >> 2, st = id & 3; f32x4 D = {0.f, 0.f, 0.f, 0.f};
                if (st <= ct) {
#pragma unroll
                    for (int ks = 0; ks < 4; ++ks) { const bf16x8 A = *(const LAS bf16x8*)(QN + (16 * ct + l15) * 136 + 32 * ks + 8 * kq), B = *(const LAS bf16x8*)(KN + (16 * st + l15) * 136 + 32 * ks + 8 * kq); D = MFMA16(A, B, D); }
                }
                const int s = 16 * st + l15; const float gs = GC[s];
#pragma unroll
                for (int e = 0; e < 4; ++e) { const int c = 16 * ct + 4 * kq + e; QKB[c * 72 + s] = (c >= s) ? f2bf(D[e] * __expf(GC[c] - gs)) : (bf16)0; } __builtin_amdgcn_sched_barrier(0); }
            __syncthreads(); RELAUNDER();
            { LAS bf16* zl = ZL + row * 136 + 16 * c8; *(LAS u32x4*)zl = zw0; *(LAS u32x4*)(zl + 8) = zw1; }
#pragma unroll
            for (int ct = 0; ct < 4; ++ct) {
#pragma unroll
                for (int ks = 0; ks < 2; ++ks) { const bf16x8 A = *(const LAS bf16x8*)(QKB + (16 * ct + l15) * 72 + 32 * ks + 8 * kq), B = *(const LAS bf16x8*)(VNT + (16 * wave + l15) * 72 + 32 * ks + 8 * kq); Oa[ct] = MFMA16(A, B, Oa[ct]); }
#pragma unroll
                for (int e = 0; e < 4; ++e) { float q2 = Oa[ct][e] * Oa[ct][e]; q2 += __shfl_xor(q2, 1); q2 += __shfl_xor(q2, 2); q2 += __shfl_xor(q2, 4); q2 += __shfl_xor(q2, 8);
                    if (l15 == 0) ONP[(16 * ct + 4 * kq + e) * 8 + wave] = q2; } __builtin_amdgcn_sched_barrier(0); }
#pragma unroll
            for (int dkt = 0; dkt < 8; ++dkt) { f32x4 D = St[dkt] * egl_last;
#pragma unroll
                for (int ks = 0; ks < 2; ++ks) { const bf16x8 A = *(const LAS bf16x8*)(VNT + (16 * wave + l15) * 72 + 32 * ks + 8 * kq), B = *(const LAS bf16x8*)(KT + (16 * dkt + l15) * 72 + 32 * ks + 8 * kq); D = MFMA16(A, B, D); }
                St[dkt] = D;
#pragma unroll
                for (int e = 0; e < 4; ++e) STB[(16 * wave + 4 * kq + e) * 136 + 16 * dkt + l15] = f2bf(D[e]); __builtin_amdgcn_sched_barrier(0); }
            __syncthreads(); RELAUNDER();
#pragma unroll
            for (int ct = 0; ct < 4; ++ct) {
#pragma unroll
                for (int e = 0; e < 4; ++e) { const int c = 16 * ct + 4 * kq + e;
                    const f32x4 pa = *(const LAS f32x4*)(ONP + c * 8), pb = *(const LAS f32x4*)(ONP + c * 8 + 4);
                    const float tot = ((pa[0] + pa[1]) + (pa[2] + pa[3])) + ((pb[0] + pb[1]) + (pb[2] + pb[3]));
                    const float rstd = __builtin_amdgcn_rsqf(tot * (1.0f / 128.0f) + EPS); const int dv = 16 * wave + l15;
                    const float z = bf2f(ZL[c * 136 + dv]);
#if defined(DBG_Q) && DBG_Q == 1
                    Y[(rb + t0 + c) * 1024 + h * 128 + dv] = f2bf(Oa[ct][e] * 64.f + 0.f * rstd * z); }
#elif defined(DBG_Q) && DBG_Q == 2
                    Y[(rb + t0 + c) * 1024 + h * 128 + dv] = f2bf(bf2f(VNT[dv * 72 + c]) * 64.f + 0.f * rstd * z); }
#elif defined(DBG_Q) && DBG_Q == 5
                    Y[(rb + t0 + c) * 1024 + h * 128 + dv] = f2bf(bf2f(RT[dv * 72 + c]) * 64.f + 0.f * rstd * z); }
#elif defined(DBG_Q) && DBG_Q == 3
                    Y[(rb + t0 + c) * 1024 + h * 128 + dv] = f2bf(bf2f(QK[c * 72 + (dv & 63)]) * 64.f + 0.f * rstd * z); }
#elif defined(DBG_Q) && DBG_Q == 4
                    Y[(rb + t0 + c) * 1024 + h * 128 + dv] = f2bf(bf2f(TM[c * 72 + (dv & 63)]) * 64.f + 0.f * rstd * z); }
#else
                    Y[(rb + t0 + c) * 1024 + h * 128 + dv] = f2bf(Oa[ct][e] * rstd * ongv * siluf_(z)); }
#endif
                __builtin_amdgcn_sched_barrier(0); }
            RELAUNDER();
        }
        __syncthreads();
    }
}
#undef RELAUNDER

#if defined(DBG_TS)
#define STAMP(k) do { if (blockIdx.x == 0 && tid == 0) ((volatile unsigned long long*)(ws + WS_BAR + 65536))[(k)] = __builtin_amdgcn_s_memrealtime(); } while (0)
#else
#define STAMP(k) do {} while (0)
#endif
#ifndef REP1
#define REP1 1
#endif
#ifndef REP0
#define REP0 1
#endif
#ifndef REP2
#define REP2 1
#endif
#ifndef REP3
#define REP3 1
#endif
#ifndef REP4
#define REP4 1
#endif
#ifndef REP10
#define REP10 1
#endif
#if defined(DBG_CUT)
#define DBGCUT(k, ptr, pitch, coloff) do { if ((k) == DBG_CUT) { asm volatile("s_waitcnt vmcnt(0) lgkmcnt(0)" ::: "memory"); cg::this_grid().sync(); \
        const bf16* src_ = (const bf16*)(ptr); float* dst_ = a.out; \
        for (size_t i_ = (size_t)blockIdx.x * 512 + tid; i_ < (size_t)M * 1024; i_ += (size_t)gridDim.x * 512) { const size_t r_ = i_ >> 10, c_ = i_ & 1023; dst_[i_] = bf2f(src_[r_ * (pitch) + (coloff) + c_]); } \
        return; } } while (0)
#else
#define DBGCUT(k, ptr, pitch, coloff) do {} while (0)
#endif
__global__ void __launch_bounds__(512, 2) mega(Args a_unused) {
    extern __shared__ __attribute__((aligned(16))) unsigned char lds_raw[];
    LAS unsigned char* lds = (LAS unsigned char*)lds_raw;
    int tid = threadIdx.x;
    volatile LAS unsigned* xb_st = (volatile LAS unsigned*)(lds + LDS_BYTES - 64);
    if (tid < 16) xb_st[tid] = 0u;
    __syncthreads();
    XcdBarrier bar = xcd_barrier_post((unsigned*)(((CArgs*)__builtin_amdgcn_kernarg_segment_ptr())->ws + WS_BAR), xb_st);
    CArgs* ap = (CArgs*)__builtin_amdgcn_kernarg_segment_ptr();
#define a (*launder_args(ap))
#define ws (a.ws)
#define rsq ((float*)(ws + WS_RSQ))
    const int lo = a.ph_lo, hi = a.ph_hi;
#ifndef PHMASK
#define PHMASK 0xFFFFFFFFu
#endif
#define IN(k) (((PHMASK >> ((k) > 11 ? (k) - 7 : (k))) & 1u) && lo <= (k) && (k) < hi)
#define SEAM(k) do { if (IN(k) && IN((k) + 1)) { if (a.pad == 0x5EED) { cg::this_grid().sync(); }     \
        xcd_barrier(bar); } } while (0)
#define GEMM(EpiT, Aptr, Bptr, N_, K_, ...) do { int k_ = (K_); asm volatile("" : "+s"(k_)); pg8::Gemm g{(const pg8::bf16_t*)(Aptr), (const pg8::bf16_t*)(Bptr), M, (N_), k_}; pg8::StaticOrder S; S.init(M, (N_), (int)gridDim.x, (int)blockIdx.x); \
        pg8::EpiT E{__VA_ARGS__}; pg8::gemm_phase<pg8::EpiT, pg8::StaticOrder, pg8::EpiT::ALIGN, true>(lds, g, S, E, tid); } while (0)
    asm volatile("; ==== PHASE 0" : "+v"(tid)); STAMP(0); if (IN(0)) { for (int rep_ = 0; rep_ < REP0; ++rep_) prologue(a, lds, tid); } SEAM(0);
    asm volatile("; ==== PHASE 1" : "+v"(tid)); STAMP(1); if (IN(1)) { for (int rep_ = 0; rep_ < REP1; ++rep_) GEMM(EpiZ, ws + WS_HBB, ws + W_EVIN, EV_NP, 1024, (pg8::bf16_t*)(ws + WS_Z), EV_NP, rsq); } SEAM(1); DBGCUT(1, ws + WS_Z, EV_NP, DBG_COL);
    asm volatile("; ==== PHASE 2" : "+v"(tid)); STAMP(2); if (IN(2)) { for (int rep_ = 0; rep_ < REP2; ++rep_) even_post(a, lds, tid); } SEAM(2); DBGCUT(2, ws + WS_QI, 512, 0);
    asm volatile("; ==== PHASE 3" : "+v"(tid)); STAMP(3); if (IN(3)) { for (int rep_ = 0; rep_ < REP3; ++rep_) idx_phase(lds, (const bf16*)(ws + WS_QI), (const bf16*)(ws + WS_KI), (const float*)(ws + WS_WI), (u64*)(ws + WS_MASK), tid); } SEAM(3);
    asm volatile("; ==== PHASE 4" : "+v"(tid)); STAMP(4); if (IN(4)) { for (int rep_ = 0; rep_ < REP4; ++rep_) attn_phase(lds, (const bf16*)(ws + WS_QP), (const bf16*)(ws + WS_KP), (const bf16*)(ws + WS_Z), (const u64*)(ws + WS_MASK), (bf16*)(ws + WS_Y), tid); } SEAM(4); DBGCUT(4, ws + WS_Y, 1024, 0);
    for (int l = 0; l < 2; ++l) {
        const int pb = 5 + 7 * l;
        bf16* hb1 = (bf16*)(ws + (l == 0 ? WS_HBA : WS_HBB)); bf16* hb2 = (bf16*)(ws + (l == 0 ? WS_HBB : WS_HBA));
        float* rs1 = rsq + (size_t)(1 + 3 * l) * M; float* rs2 = rs1 + M; float* rs3 = rs2 + M; float* rsE = rsq + (size_t)(6 + l) * M;
        asm volatile("; ==== PHASE pb" : "+v"(tid)); STAMP(pb); if (IN(pb)) { convert_p((const float*)a.in[1] + (size_t)l * M * 256, (bf16*)(ws + WS_PB), tid);
            GEMM(EpiResB, ws + WS_Y, ws + (l == 0 ? W_EVOUT : W_ODOUT), 1024, 1024, (l == 0 ? (const float*)a.in[0] : (const float*)nullptr), (const pg8::bf16_t*)(l == 0 ? nullptr : hb2), (pg8::bf16_t*)hb1, rs1); } SEAM(pb);
        asm volatile("; ==== PHASE pb1" : "+v"(tid)); STAMP(pb + 1); if (IN(pb + 1)) {
#ifndef NO_SWIGLU
 GEMM(EpiSwiGLU, hb1, ws + W_GU + (size_t)l * 2 * DFF * 1024 * 2, 2 * DFF, 1024, (pg8::bf16_t*)(ws + WS_HID), rs1);
#endif
#ifndef NO_ERAW
            GEMM(EpiEraw, ws + WS_PB, ws + W_PJ + (size_t)l * 256 * 1024 * 2, 1024, 256, (pg8::bf16_t*)(ws + WS_ERAW), rsE);
#endif
 } SEAM(pb + 1);
        asm volatile("; ==== PHASE pb2" : "+v"(tid)); STAMP(pb + 2); if (IN(pb + 2)) { GEMM(EpiResB, ws + WS_HID, ws + W_DN + (size_t)l * DFF * 1024 * 2, 1024, DFF, (const float*)nullptr, (const pg8::bf16_t*)hb1, (pg8::bf16_t*)hb2, rs2); } SEAM(pb + 2);
        asm volatile("; ==== PHASE pb3" : "+v"(tid)); STAMP(pb + 3); if (IN(pb + 3)) { GEMM(EpiPleB, hb2, ws + W_PG + (size_t)l * 1024 * 1024 * 2, 1024, 1024, (const pg8::bf16_t*)hb2, (l == 0 ? (float*)nullptr : a.out), (pg8::bf16_t*)(l == 0 ? hb1 : nullptr), (l == 0 ? rs3 : nullptr),
                               (const pg8::bf16_t*)(ws + WS_ERAW), rsE, rs2, (const float*)a.in[22] + l * 1024); } SEAM(pb + 3);
        if (l == 0) {
            asm volatile("; ==== PHASE 9" : "+v"(tid)); STAMP(9); if (IN(9)) { GEMM(EpiZ, hb1, ws + W_ODIN, OD_NP, 1024, (pg8::bf16_t*)(ws + WS_Z), OD_NP, rs3); } SEAM(9); DBGCUT(9, ws + WS_Z, OD_NP, DBG_COL);
            asm volatile("; ==== PHASE 10" : "+v"(tid)); STAMP(10); if (IN(10)) { for (int rep_ = 0; rep_ < REP10; ++rep_) dn_prep(a, lds, tid); } SEAM(10);
#if defined(DBG_CUT) && DBG_CUT == 10
            { asm volatile("s_waitcnt vmcnt(0) lgkmcnt(0)" ::: "memory"); cg::this_grid().sync();
              const bf16* s1_ = (const bf16*)(ws + WS_KPD); const bf16* s2_ = (const bf16*)(ws + WS_VBD); const float* s3_ = (const float*)(ws + WS_GCUM); float* dst_ = a.out;
              for (size_t i_ = (size_t)blockIdx.x * 512 + tid; i_ < (size_t)M * 1024; i_ += (size_t)gridDim.x * 512) dst_[i_] = bf2f(s1_[i_]) + 3.f * bf2f(s2_[i_]) + (i_ < (size_t)M * 16 ? s3_[i_] : 0.f);
              return; }
#endif
            asm volatile("; ==== PHASE 11" : "+v"(tid)); STAMP(11); if (IN(11)) { dn_scan(a, lds, tid); } SEAM(11); DBGCUT(11, ws + WS_Y, 1024, 0);
        }
    }
#if defined(DBG_TS)
    xcd_barrier(bar); STAMP(16);
    asm volatile("s_waitcnt vmcnt(0)" ::: "memory"); xcd_barrier(bar);
    { const volatile unsigned long long* ts_ = (const volatile unsigned long long*)(ws + WS_BAR + 65536);
      const float val_ = (float)(long long)(__hip_atomic_load((const unsigned long long*)ts_ + DBG_TS + 1, __ATOMIC_RELAXED, __HIP_MEMORY_SCOPE_AGENT) - __hip_atomic_load((const unsigned long long*)ts_ + DBG_TS, __ATOMIC_RELAXED, __HIP_MEMORY_SCOPE_AGENT)) * 0.01f;
      const float valq_ = 32.f * __builtin_rintf(val_ * (1.f / 32.f));
      float* dst_ = a.out; for (size_t i_ = (size_t)blockIdx.x * 512 + tid; i_ < (size_t)M * 1024; i_ += (size_t)gridDim.x * 512) dst_[i_] = valq_; }
#endif
#undef IN
#undef SEAM
#undef GEMM
#undef a
#undef ws
#undef rsq
}

extern "C" void kernel_launch(void* const* d_in, const int* in_sizes, int n_in, void* d_out, int out_size, void* d_ws, size_t ws_size, hipStream_t stream) {
    static int grid = 0;
    if (grid == 0) {
        if (n_in != 25 || out_size != M * DM || ws_size < WS_END) { fprintf(stderr, "kernel_launch: unexpected problem (n_in %d, out %d, ws %zu)\n", n_in, out_size, ws_size); grid = -1; return; }
        int dev = 0, cus = 0, per_cu = 0;
        hipGetDevice(&dev); hipDeviceGetAttribute(&cus, hipDeviceAttributeMultiprocessorCount, dev);
        hipFuncSetAttribute((const void*)mega, hipFuncAttributeMaxDynamicSharedMemorySize, LDS_BYTES);
        hipOccupancyMaxActiveBlocksPerMultiprocessor(&per_cu, (const void*)mega, 512, LDS_BYTES);
        (void)hipGetLastError();
        if (per_cu < 1) { fprintf(stderr, "kernel_launch: occupancy query says %d blocks per CU\n", per_cu); per_cu = 1; }
        grid = cus;
        if (grid > 256) grid = 256;
    }
    if (grid < 0) return;
    Args a{};
    for (int i = 0; i < 25; ++i) a.in[i] = d_in[i];
    a.out = (float*)d_out; a.ws = (unsigned char*)d_ws; a.ph_lo = 0; a.ph_hi = NPH; a.coop = 1; a.pad = 0;
    if (hipMemsetAsync((char*)d_ws + WS_BAR, 0, 16384, stream) != hipSuccess) { fprintf(stderr, "kernel_launch: memset failed\n"); return; }
#if defined(MK_MULTI)
    for (int p = 0; p < NPH; ++p) { a.ph_lo = p; a.ph_hi = p + 1; hipLaunchKernelGGL(mega, dim3(grid), dim3(512), LDS_BYTES, stream, a); }
#else
    void* args[] = {&a};
    hipError_t e = hipLaunchCooperativeKernel((const void*)mega, dim3(grid), dim3(512), args, LDS_BYTES, stream);
    if (e != hipSuccess) fprintf(stderr, "kernel_launch: cooperative launch failed: %s (grid %d)\n", hipGetErrorString(e), grid);
#endif
}
```

```cpp
#include <hip/hip_runtime.h>
#include <hip/hip_cooperative_groups.h>
#include <cstdio>
#include <cstdint>
#include <cstddef>
namespace cg = cooperative_groups;
namespace pg8 {
#define PG8_LAS __attribute__((address_space(3)))
typedef unsigned short bf16_t;
typedef short bf16x8 __attribute__((ext_vector_type(8)));
typedef float f32x4 __attribute__((ext_vector_type(4)));
typedef unsigned u32x4 __attribute__((ext_vector_type(4)));
constexpr int BM = 256, BK = 64, HALF = 128, HTB = HALF * BK * 2  , STAGE_BYTES = 8 * HTB, NXCD = 8, WGM = 8;

__host__ __device__ __forceinline__ int lds_byte(int r, int c) { const int st = (r >> 4) * 2 + (c >> 5), rr = r & 15, cc = c & 31, ob = rr * 64 + cc * 2; return st * 1024 + (ob ^ (((ob >> 9) & 1) << 5)); }
__host__ __device__ __forceinline__ void stage_rc(int b, int& R, int& C) { const int st = b / 1024, sb = b % 1024, swz = sb ^ (((sb >> 9) & 1) << 5); R = (st >> 1) * 16 + swz / 64; C = (st & 1) * 32 + (swz % 64) / 2; }
__host__ __device__ __forceinline__ int perm32(int rho) { const int n = rho >> 4, i = rho & 15; return 8 * (i >> 2) + 4 * n + (i & 3); }

struct Unit { int pm, pn; };
struct Gemm { const bf16_t* A; const bf16_t* Bt; int M, N, K; };

struct StaticOrder {
    int nM, nN, nwg, G, c;
    __host__ __device__ void init(int M, int N, int G_, int c_) { nM = M / BM; nN = N / BM; nwg = nM * nN; G = G_; c = c_; }
    __host__ __device__ bool next(int i, Unit& u) const {
        const long L = (long)i * G + c; if (L >= nwg) return false;
        int wgid = (int)L; { const int q = nwg / NXCD, r = nwg % NXCD, xcd = wgid % NXCD, off = wgid / NXCD; wgid = (xcd < r ? xcd * (q + 1) : r * (q + 1) + (xcd - r) * q) + off; }
        const int nig = WGM * nN, gid = wgid / nig, fm = gid * WGM, gsz = (nM - fm) < WGM ? (nM - fm) : WGM;
        u.pm = fm + ((wgid % nig) % gsz); u.pn = (wgid % nig) / gsz; return true;
    }
    __device__ __forceinline__ void a_ready(const Unit&) const {}
    __device__ __forceinline__ void done(const Unit&) const {}
};
typedef float f32x2cv __attribute__((ext_vector_type(2))); typedef __bf16 bf16x2cv __attribute__((ext_vector_type(2)));
__device__ __forceinline__ unsigned cvt_pk_bf16(float lo, float hi) { const f32x2cv v = {lo, hi}; const bf16x2cv b = __builtin_convertvector(v, bf16x2cv); return __builtin_bit_cast(unsigned, b); }
typedef unsigned u32x4e __attribute__((ext_vector_type(4)));
typedef unsigned u32x2e __attribute__((ext_vector_type(2)));
constexpr float NORM_EPS = 1e-6f;
__device__ __forceinline__ float rstd_of(const float* rowsq, int row) { return __builtin_amdgcn_rsqf(rowsq[row] * (1.0f / 1024.0f) + NORM_EPS); }
struct EpiZ {
    static constexpr bool PERM = true, AFTER_DRAIN = false, ALIGN = true;
    bf16_t* O; int ldc; const float* rowsq;
    __device__ __forceinline__ void operator()(const f32x4 (&acc)[2][2][4][2], const Unit& u, int wr, int wc, int fr, int fq) const {
        const int row0 = u.pm * BM + wr * 64 + fr, col0 = u.pn * BM + wc * 32 + 8 * fq;
        float rs8[8];
#pragma unroll
        for (int i = 0; i < 8; ++i) rs8[i] = rowsq[row0 + (i >> 2) * HALF + (i & 3) * 16];
#pragma unroll
        for (int i = 0; i < 8; ++i) rs8[i] = __builtin_amdgcn_rsqf(rs8[i] * (1.0f / 1024.0f) + NORM_EPS);
#pragma unroll
        for (int ai = 0; ai < 2; ++ai)
#pragma unroll
            for (int m = 0; m < 4; ++m) { const int row = row0 + ai * HALF + m * 16; const float rs = rs8[ai * 4 + m]; bf16_t* rowp = O + (size_t)row * ldc + col0;
#pragma unroll
                for (int bj = 0; bj < 2; ++bj) { const f32x4 v0 = acc[ai][bj][m][0] * rs, v1 = acc[ai][bj][m][1] * rs;
                    u32x4e w; w.x = cvt_pk_bf16(v0[0], v0[1]); w.y = cvt_pk_bf16(v0[2], v0[3]); w.z = cvt_pk_bf16(v1[0], v1[1]); w.w = cvt_pk_bf16(v1[2], v1[3]);
                    *(u32x4e*)(rowp + bj * HALF) = w; } }
    }
};
struct EpiEraw {
    static constexpr bool PERM = true, AFTER_DRAIN = false, ALIGN = true;
    bf16_t* O; float* rowsq;
    __device__ __forceinline__ void operator()(const f32x4 (&acc)[2][2][4][2], const Unit& u, int wr, int wc, int fr, int fq) const {
        const int row0 = u.pm * BM + wr * 64 + fr, col0 = u.pn * BM + wc * 32 + 8 * fq;
#pragma unroll
        for (int ai = 0; ai < 2; ++ai)
#pragma unroll
            for (int m = 0; m < 4; ++m) { const int row = row0 + ai * HALF + m * 16; bf16_t* rowp = O + (size_t)row * 1024 + col0; float ss = 0.f;
#pragma unroll
                for (int bj = 0; bj < 2; ++bj) { const f32x4 v0 = acc[ai][bj][m][0], v1 = acc[ai][bj][m][1];
                    ss += (v0[0] * v0[0] + v0[1] * v0[1]) + (v0[2] * v0[2] + v0[3] * v0[3]) + (v1[0] * v1[0] + v1[1] * v1[1]) + (v1[2] * v1[2] + v1[3] * v1[3]);
                    u32x4e w; w.x = cvt_pk_bf16(v0[0], v0[1]); w.y = cvt_pk_bf16(v0[2], v0[3]); w.z = cvt_pk_bf16(v1[0], v1[1]); w.w = cvt_pk_bf16(v1[2], v1[3]);
                    *(u32x4e*)(rowp + bj * HALF) = w; }
                ss += __shfl_xor(ss, 16); ss += __shfl_xor(ss, 32);
                if (fq == 0) atomicAdd(rowsq + row, ss); asm volatile("" ::: "memory"); }
    }
};
struct EpiSwiGLU {
    static constexpr bool PERM = true, AFTER_DRAIN = false, ALIGN = true;
    bf16_t* O; const float* rowsq;
    __device__ __forceinline__ void operator()(const f32x4 (&acc)[2][2][4][2], const Unit& u, int wr, int wc, int fr, int fq) const {
        const int row0 = u.pm * BM + wr * 64 + fr, col0 = u.pn * HALF + wc * 32 + 8 * fq;
        float rs8[8];
#pragma unroll
        for (int i = 0; i < 8; ++i) rs8[i] = rowsq[row0 + (i >> 2) * HALF + (i & 3) * 16];
#pragma unroll
        for (int i = 0; i < 8; ++i) rs8[i] = __builtin_amdgcn_rsqf(rs8[i] * (1.0f / 1024.0f) + NORM_EPS);
#pragma unroll
        for (int ai = 0; ai < 2; ++ai)
#pragma unroll
            for (int m = 0; m < 4; ++m) { const int row = row0 + ai * HALF + m * 16; const float rs = rs8[ai * 4 + m]; float h[8];
#pragma unroll
                for (int n = 0; n < 2; ++n)
#pragma unroll
                    for (int e2 = 0; e2 < 4; ++e2) { const float g = acc[ai][0][m][n][e2] * rs, up = acc[ai][1][m][n][e2] * rs;
                        h[4 * n + e2] = g * __builtin_amdgcn_rcpf(1.0f + __builtin_amdgcn_exp2f(-1.4426950408889634f * g)) * up; }
                u32x4e w; w.x = cvt_pk_bf16(h[0], h[1]); w.y = cvt_pk_bf16(h[2], h[3]); w.z = cvt_pk_bf16(h[4], h[5]); w.w = cvt_pk_bf16(h[6], h[7]);
                *(u32x4e*)(O + (size_t)row * 2816 + col0) = w; }
    }
};
struct EpiRes {
    static constexpr bool PERM = false, AFTER_DRAIN = false, ALIGN = true;
    const float* base; float* out; bf16_t* hb; float* rowsq;
    __device__ __forceinline__ void operator()(const f32x4 (&acc)[2][2][4][2], const Unit& u, int wr, int wc, int fr, int fq) const {
        const int row0 = u.pm * BM + wr * 64 + fr, col0 = u.pn * BM + wc * 32 + 4 * fq;
#pragma unroll
        for (int ai = 0; ai < 2; ++ai)
#pragma unroll
            for (int m = 0; m < 4; ++m) { const int row = row0 + ai * HALF + m * 16; const size_t off = (size_t)row * 1024 + col0; float ss = 0.f;
#pragma unroll
                for (int bj = 0; bj < 2; ++bj)
#pragma unroll
                    for (int n = 0; n < 2; ++n) { const size_t o2 = off + bj * HALF + n * 16; const f32x4 o = *(const f32x4*)(base + o2) + acc[ai][bj][m][n];
                        *(f32x4*)(out + o2) = o; u32x2e w; w.x = cvt_pk_bf16(o[0], o[1]); w.y = cvt_pk_bf16(o[2], o[3]); *(u32x2e*)(hb + o2) = w;
                        ss += (o[0] * o[0] + o[1] * o[1]) + (o[2] * o[2] + o[3] * o[3]); }
                ss += __shfl_xor(ss, 16); ss += __shfl_xor(ss, 32);
                if (fq == 0) atomicAdd(rowsq + row, ss); asm volatile("" ::: "memory"); }
    }
};
struct EpiPle {
    static constexpr bool PERM = false, AFTER_DRAIN = false, ALIGN = true;
    const float* base; float* out; bf16_t* hb; float* rowsq_out; const bf16_t* eraw; const float* rowsqE; const float* rowsqH; const float* postg;
    __device__ __forceinline__ void operator()(const f32x4 (&acc)[2][2][4][2], const Unit& u, int wr, int wc, int fr, int fq) const {
        const int row0 = u.pm * BM + wr * 64 + fr, col0 = u.pn * BM + wc * 32 + 4 * fq;
#pragma unroll
        for (int ai = 0; ai < 2; ++ai)
#pragma unroll
            for (int m = 0; m < 4; ++m) { const int row = row0 + ai * HALF + m * 16; const size_t off = (size_t)row * 1024 + col0; float ss = 0.f;
                const float rsE = rstd_of(rowsqE, row), rsH = rstd_of(rowsqH, row);
#pragma unroll
                for (int bj = 0; bj < 2; ++bj)
#pragma unroll
                    for (int n = 0; n < 2; ++n) { const size_t o2 = off + bj * HALF + n * 16; const int c2 = col0 + bj * HALF + n * 16;
                        const u32x2e ew = *(const u32x2e*)(eraw + o2); const f32x4 pg = *(const f32x4*)(postg + c2); const f32x4 b = *(const f32x4*)(base + o2);
                        float ev[4] = {__uint_as_float(ew.x << 16), __uint_as_float(ew.x & 0xffff0000u), __uint_as_float(ew.y << 16), __uint_as_float(ew.y & 0xffff0000u)};
                        f32x4 o;
#pragma unroll
                        for (int e = 0; e < 4; ++e) { const float gt = __builtin_amdgcn_rcpf(1.0f + __builtin_amdgcn_exp2f(-1.4426950408889634f * acc[ai][bj][m][n][e] * rsH)); o[e] = b[e] + ev[e] * rsE * pg[e] * gt; }
                        *(f32x4*)(out + o2) = o;
                        if (hb) { u32x2e w; w.x = cvt_pk_bf16(o[0], o[1]); w.y = cvt_pk_bf16(o[2], o[3]); *(u32x2e*)(hb + o2) = w; }
                        ss += (o[0] * o[0] + o[1] * o[1]) + (o[2] * o[2] + o[3] * o[3]); }
                if (rowsq_out) { ss += __shfl_xor(ss, 16); ss += __shfl_xor(ss, 32); if (fq == 0) atomicAdd(rowsq_out + row, ss); } asm volatile("" ::: "memory"); }
    }
};

__device__ __forceinline__ void unpack8e(const u32x4e w, float* v) {
    v[0] = __uint_as_float(w.x << 16); v[1] = __uint_as_float(w.x & 0xffff0000u); v[2] = __uint_as_float(w.y << 16); v[3] = __uint_as_float(w.y & 0xffff0000u);
    v[4] = __uint_as_float(w.z << 16); v[5] = __uint_as_float(w.z & 0xffff0000u); v[6] = __uint_as_float(w.w << 16); v[7] = __uint_as_float(w.w & 0xffff0000u); }
struct EpiResB {
    static constexpr bool PERM = true, AFTER_DRAIN = false, ALIGN = true;
    const float* basef; const bf16_t* baseb; bf16_t* hb; float* rowsq;
    __device__ __forceinline__ void operator()(const f32x4 (&acc)[2][2][4][2], const Unit& u, int wr, int wc, int fr, int fq) const {
        const int row0 = u.pm * BM + wr * 64 + fr, col0 = u.pn * BM + wc * 32 + 8 * fq;
#pragma unroll
        for (int ai = 0; ai < 2; ++ai) {
            u32x4e bw[4][2];
            if (!basef) {
#pragma unroll
                for (int m = 0; m < 4; ++m)
#pragma unroll
                    for (int bj = 0; bj < 2; ++bj) bw[m][bj] = *(const u32x4e*)(baseb + (size_t)(row0 + ai * HALF + m * 16) * 1024 + col0 + bj * HALF); }
#pragma unroll
            for (int m = 0; m < 4; ++m) { const int row = row0 + ai * HALF + m * 16; const size_t off = (size_t)row * 1024 + col0; float ss = 0.f;
#pragma unroll
                for (int bj = 0; bj < 2; ++bj) { const size_t o2 = off + bj * HALF; float b[8];
                    if (basef) { const f32x4 b0 = *(const f32x4*)(basef + o2), b1 = *(const f32x4*)(basef + o2 + 4); b[0] = b0[0]; b[1] = b0[1]; b[2] = b0[2]; b[3] = b0[3]; b[4] = b1[0]; b[5] = b1[1]; b[6] = b1[2]; b[7] = b1[3]; }
                    else unpack8e(bw[m][bj], b);
#pragma unroll
                    for (int n = 0; n < 2; ++n)
#pragma unroll
                        for (int e2 = 0; e2 < 4; ++e2) { b[4 * n + e2] += acc[ai][bj][m][n][e2]; ss += b[4 * n + e2] * b[4 * n + e2]; }
                    u32x4e w; w.x = cvt_pk_bf16(b[0], b[1]); w.y = cvt_pk_bf16(b[2], b[3]); w.z = cvt_pk_bf16(b[4], b[5]); w.w = cvt_pk_bf16(b[6], b[7]);
                    *(u32x4e*)(hb + o2) = w; }
                ss += __shfl_xor(ss, 16); ss += __shfl_xor(ss, 32);
                if (fq == 0) atomicAdd(rowsq + row, ss); }
        }
    }
};
struct EpiPleB {
    static constexpr bool PERM = true, AFTER_DRAIN = false, ALIGN = true;
    const bf16_t* baseb; float* outf; bf16_t* hb; float* rowsq_out; const bf16_t* eraw; const float* rowsqE; const float* rowsqH; const float* postg;
    __device__ __forceinline__ void operator()(const f32x4 (&acc)[2][2][4][2], const Unit& u, int wr, int wc, int fr, int fq) const {
        const int row0 = u.pm * BM + wr * 64 + fr, col0 = u.pn * BM + wc * 32 + 8 * fq;
#pragma unroll
        for (int ai = 0; ai < 2; ++ai)
#pragma unroll
            for (int m = 0; m < 4; ++m) { const int row = row0 + ai * HALF + m * 16; const size_t off = (size_t)row * 1024 + col0; float ss = 0.f;
                const float rsE = rstd_of(rowsqE, row), rsH = rstd_of(rowsqH, row);
#pragma unroll
                for (int bj = 0; bj < 2; ++bj) { const size_t o2 = off + bj * HALF; const int c2 = col0 + bj * HALF; float b[8], ev[8];
                    unpack8e(*(const u32x4e*)(baseb + o2), b); unpack8e(*(const u32x4e*)(eraw + o2), ev);
                    const f32x4 pg0 = *(const f32x4*)(postg + c2), pg1 = *(const f32x4*)(postg + c2 + 4);
#pragma unroll
                    for (int n = 0; n < 2; ++n)
#pragma unroll
                        for (int e2 = 0; e2 < 4; ++e2) { const int i8 = 4 * n + e2; const float gt = __builtin_amdgcn_rcpf(1.0f + __builtin_amdgcn_exp2f(-1.4426950408889634f * acc[ai][bj][m][n][e2] * rsH));
                            b[i8] += ev[i8] * rsE * (n ? pg1[e2] : pg0[e2]) * gt; ss += b[i8] * b[i8]; }
                    if (outf) { *(f32x4*)(outf + o2) = (f32x4){b[0], b[1], b[2], b[3]}; *(f32x4*)(outf + o2 + 4) = (f32x4){b[4], b[5], b[6], b[7]}; }
                    if (hb) { u32x4e w; w.x = cvt_pk_bf16(b[0], b[1]); w.y = cvt_pk_bf16(b[2], b[3]); w.z = cvt_pk_bf16(b[4], b[5]); w.w = cvt_pk_bf16(b[6], b[7]); *(u32x4e*)(hb + o2) = w; } }
                if (rowsq_out) { ss += __shfl_xor(ss, 16); ss += __shfl_xor(ss, 32); if (fq == 0) atomicAdd(rowsq_out + row, ss); } asm volatile("" ::: "memory"); }
    }
};
template <class Epi, class Sched, bool ALIGN_EPI = false, bool SP2 = false>
__device__ __forceinline__ void gemm_phase(PG8_LAS unsigned char* lds, const Gemm g, const Sched& S, const Epi& E, int tid_in) {
    const int tid = tid_in, wid = __builtin_amdgcn_readfirstlane(tid >> 6), lane = tid & 63, wr = wid >> 2, wc = wid & 3, fr = lane & 15, fq = lane >> 4;
    const int K = g.K, nt = K / BK;
    unsigned voffA[2], voffB[2];
#pragma unroll
    for (int i = 0; i < 2; ++i) { int R, C; stage_rc(tid * 16 + i * 8192, R, C); const int Rb = Epi::PERM ? ((R & ~31) + perm32(R & 31)) : R;
        voffA[i] = (unsigned)(R * K + C) * 2u; voffB[i] = (unsigned)(Rb * K + C) * 2u; }
    const size_t kstep = (size_t)(BK * 2);
    const size_t hstep = (size_t)HALF * K * 2;
    const size_t tstep = 2 * hstep;
    const unsigned ldsw = (unsigned)wid * 1024u;
    const int aoff = lds_byte(wr * 64 + fr, fq * 8), boff = lds_byte(wc * 32 + fr, fq * 8);
#define PG8_SA(b, h) (((b) * 2 + (h)) * HTB)
#define PG8_SB(b, h) ((4 + (b) * 2 + (h)) * HTB)
#define PG8_STAGE(bufoff, gbase, voff) do { _Pragma("unroll") for (int _i = 0; _i < 2; ++_i) \
        __builtin_amdgcn_global_load_lds((const unsigned*)((const char*)(gbase) + (voff)[_i]), (PG8_LAS unsigned*)(lds + (bufoff) + ldsw + _i * 8192), 16, 0, 0); } while (0)
#define PG8_LDA(dst, b, h) do { _Pragma("unroll") for (int m = 0; m < 4; ++m) _Pragma("unroll") for (int k = 0; k < 2; ++k) dst[m][k] = *(const PG8_LAS bf16x8*)(lds + PG8_SA(b, h) + aoff + m * 2048 + k * 1024); } while (0)
#define PG8_LDB(dst, b, h) do { _Pragma("unroll") for (int n = 0; n < 2; ++n) _Pragma("unroll") for (int k = 0; k < 2; ++k) dst[n][k] = *(const PG8_LAS bf16x8*)(lds + PG8_SB(b, h) + boff + n * 2048 + k * 1024); } while (0)
#define PG8_MMA(ai, bj, At, Bt) do { __builtin_amdgcn_s_setprio(1); _Pragma("unroll") for (int m = 0; m < 4; ++m) _Pragma("unroll") for (int n = 0; n < 2; ++n) _Pragma("unroll") for (int k = 0; k < 2; ++k) \
        acc[ai][bj][m][n] = __builtin_amdgcn_mfma_f32_16x16x32_bf16(Bt[n][k], At[m][k], acc[ai][bj][m][n], 0, 0, 0); __builtin_amdgcn_s_setprio(0); } while (0)
#define PG8_WAIT_V(n) asm volatile("s_waitcnt vmcnt(" #n ")" ::: "memory")
#define PG8_WAIT_L(n) asm volatile("s_waitcnt lgkmcnt(" #n ")" ::: "memory")
#define PG8_BAR __builtin_amdgcn_s_barrier()
#define PG8_SCHED __builtin_amdgcn_sched_barrier(0)
    Unit cur, nxt; int ui = 0;
    if (!S.next(0, cur)) return;
    f32x4 acc[2][2][4][2];
#pragma unroll
    for (int a = 0; a < 2; ++a)
#pragma unroll
        for (int b = 0; b < 2; ++b)
#pragma unroll
            for (int m = 0; m < 4; ++m)
#pragma unroll
                for (int n = 0; n < 2; ++n) acc[a][b][m][n] = (f32x4){0.f, 0.f, 0.f, 0.f};
    bf16x8 At[4][2], B0[2][2], B1[2][2];
    const char* cA = (const char*)g.A + (size_t)cur.pm * tstep; const char* cB = (const char*)g.Bt + (size_t)cur.pn * tstep;
    S.a_ready(cur);
    if constexpr (SP2) {
        PG8_STAGE(PG8_SB(0, 0), cB, voffB); PG8_STAGE(PG8_SB(0, 1), cB + hstep, voffB); PG8_STAGE(PG8_SA(0, 0), cA, voffA); PG8_STAGE(PG8_SA(0, 1), cA + hstep, voffA);
        if (wr == 1) PG8_BAR;
        PG8_WAIT_V(2); PG8_BAR;
        PG8_STAGE(PG8_SB(1, 0), cB + kstep, voffB); PG8_STAGE(PG8_SA(1, 0), cA + kstep, voffA); PG8_STAGE(PG8_SB(1, 1), cB + hstep + kstep, voffB);
        PG8_WAIT_V(6); PG8_BAR;
    } else {
        PG8_STAGE(PG8_SB(0, 0), cB, voffB); PG8_STAGE(PG8_SA(0, 0), cA, voffA); PG8_STAGE(PG8_SB(0, 1), cB + hstep, voffB); PG8_STAGE(PG8_SA(0, 1), cA + hstep, voffA);
        if (wr == 1) PG8_BAR;
        PG8_WAIT_V(4); PG8_BAR;
        PG8_STAGE(PG8_SB(1, 0), cB + kstep, voffB); PG8_STAGE(PG8_SA(1, 0), cA + kstep, voffA); PG8_STAGE(PG8_SB(1, 1), cB + hstep + kstep, voffB);
        PG8_WAIT_V(6); PG8_BAR;
    }
    for (;;) {
        const bool has_next = S.next(ui + 1, nxt);
        const char* nA = has_next ? (const char*)g.A + (size_t)nxt.pm * tstep : cA; const char* nB = has_next ? (const char*)g.Bt + (size_t)nxt.pn * tstep : cB;
        for (int t = 0; t < nt; t += 2) {
            const bool last = (t == nt - 2);
            const char* a1 = cA + (size_t)(t + 1) * kstep;
            const char* a2 = last ? nA : cA + (size_t)(t + 2) * kstep; const char* b2 = last ? nB : cB + (size_t)(t + 2) * kstep;
            const char* a3 = a2 + kstep; const char* b3 = b2 + kstep;
            if (last && has_next) S.a_ready(nxt);
            if constexpr (SP2) {
            PG8_LDB(B0, 0, 0); PG8_LDB(B1, 0, 1); PG8_SCHED; PG8_LDA(At, 0, 0); PG8_STAGE(PG8_SA(1, 1), a1 + hstep, voffA);
            PG8_WAIT_V(8); PG8_WAIT_L(0); PG8_BAR; PG8_MMA(0, 0, At, B0); PG8_MMA(0, 1, At, B1); PG8_BAR; PG8_SCHED;
            PG8_LDA(At, 0, 1); PG8_STAGE(PG8_SB(0, 0), b2, voffB); PG8_STAGE(PG8_SB(0, 1), b2 + hstep, voffB); PG8_STAGE(PG8_SA(0, 0), a2, voffA);
            PG8_WAIT_V(8); PG8_WAIT_L(0); PG8_BAR; PG8_MMA(1, 0, At, B0); PG8_MMA(1, 1, At, B1); PG8_BAR; PG8_SCHED;
            PG8_LDB(B0, 1, 0); PG8_LDB(B1, 1, 1); PG8_SCHED; PG8_LDA(At, 1, 0); PG8_STAGE(PG8_SA(0, 1), a2 + hstep, voffA);
            PG8_WAIT_V(8); PG8_WAIT_L(0); PG8_BAR; PG8_MMA(0, 0, At, B0); PG8_MMA(0, 1, At, B1); PG8_BAR; PG8_SCHED;
            PG8_LDA(At, 1, 1); PG8_STAGE(PG8_SB(1, 0), b3, voffB); PG8_STAGE(PG8_SB(1, 1), b3 + hstep, voffB); PG8_STAGE(PG8_SA(1, 0), a3, voffA);
            PG8_WAIT_V(8); PG8_WAIT_L(0); PG8_BAR; PG8_MMA(1, 0, At, B0); PG8_MMA(1, 1, At, B1); PG8_BAR; PG8_SCHED;
            } else {
            PG8_LDB(B0, 0, 0); PG8_SCHED; PG8_LDA(At, 0, 0); PG8_STAGE(PG8_SA(1, 1), a1 + hstep, voffA);
            PG8_WAIT_L(8); PG8_BAR; PG8_WAIT_L(0); PG8_MMA(0, 0, At, B0); PG8_BAR; PG8_SCHED;
            PG8_LDB(B1, 0, 1); PG8_STAGE(PG8_SB(0, 0), b2, voffB);
            PG8_BAR; PG8_WAIT_L(0); PG8_MMA(0, 1, At, B1); PG8_BAR;
            PG8_LDA(At, 0, 1); PG8_STAGE(PG8_SA(0, 0), a2, voffA);
            PG8_BAR; PG8_WAIT_L(0); PG8_MMA(1, 0, At, B0); PG8_BAR; PG8_SCHED;
            PG8_STAGE(PG8_SB(0, 1), b2 + hstep, voffB);
            PG8_WAIT_V(6); PG8_BAR; PG8_MMA(1, 1, At, B1); PG8_BAR;
            PG8_LDB(B0, 1, 0); PG8_SCHED; PG8_LDA(At, 1, 0); PG8_STAGE(PG8_SA(0, 1), a2 + hstep, voffA);
            PG8_WAIT_L(8); PG8_BAR; PG8_WAIT_L(0); PG8_MMA(0, 0, At, B0); PG8_BAR; PG8_SCHED;
            PG8_LDB(B1, 1, 1); PG8_STAGE(PG8_SB(1, 0), b3, voffB);
            PG8_BAR; PG8_WAIT_L(0); PG8_MMA(0, 1, At, B1); PG8_BAR;
            PG8_LDA(At, 1, 1); PG8_STAGE(PG8_SA(1, 0), a3, voffA);
            PG8_BAR; PG8_WAIT_L(0); PG8_MMA(1, 0, At, B0); PG8_BAR; PG8_SCHED;
            PG8_STAGE(PG8_SB(1, 1), b3 + hstep, voffB);
            PG8_WAIT_V(6); PG8_BAR; PG8_MMA(1, 1, At, B1); PG8_BAR;
            }
        }
        if constexpr (ALIGN_EPI) { if (wr == 0) PG8_BAR; }
        if constexpr (!Epi::AFTER_DRAIN) { E(acc, cur, wr, wc, fr, fq); S.done(cur); }
        if (!has_next) break;
#pragma unroll
        for (int a = 0; a < 2; ++a)
#pragma unroll
            for (int b = 0; b < 2; ++b)
#pragma unroll
                for (int m = 0; m < 4; ++m)
#pragma unroll
                    for (int n = 0; n < 2; ++n) acc[a][b][m][n] = (f32x4){0.f, 0.f, 0.f, 0.f};
        cur = nxt; cA = nA; cB = nB; ++ui;
        if constexpr (ALIGN_EPI) { if (wr == 1) PG8_BAR; }
    }
    PG8_WAIT_V(0);
    if constexpr (!ALIGN_EPI) { if (wr == 0) PG8_BAR; }
    PG8_BAR;
    if constexpr (Epi::AFTER_DRAIN) { E.fused(acc, cur, wr, wc, fr, fq, lds, wid, lane); S.done(cur); }
#undef PG8_SA
#undef PG8_SB
#undef PG8_STAGE
#undef PG8_LDA
#undef PG8_LDB
#undef PG8_MMA
#undef PG8_WAIT_V
#undef PG8_WAIT_L
#undef PG8_BAR
#undef PG8_SCHED
}
}
#define LAS __attribute__((address_space(3)))
typedef unsigned short bf16;
typedef short bf16x8 __attribute__((ext_vector_type(8)));
typedef float f32x4 __attribute__((ext_vector_type(4)));
typedef float f32x16 __attribute__((ext_vector_type(16)));
typedef unsigned u32x4 __attribute__((ext_vector_type(4)));
typedef unsigned long long u64;
constexpr int NB = 32, SEQ = 2048, DM = 1024, M = NB * SEQ;
constexpr int EV_N = 3656, EV_NP = 3840, OD_N = 4112, OD_NP = 4352, DFF = 2816;
constexpr float EPS = 1e-6f;
constexpr size_t MiB = (size_t)1 << 20;
constexpr size_t WS_RSQ = 0;
constexpr size_t WS_BAR = 3 * MiB;
constexpr size_t WS_W = 4 * MiB;
constexpr size_t W_EVIN = WS_W, W_EVOUT = W_EVIN + (size_t)EV_NP * 1024 * 2, W_ODIN = W_EVOUT + 2 * MiB, W_ODOUT = W_ODIN + (size_t)OD_NP * 1024 * 2;
constexpr size_t W_GU = W_ODOUT + 2 * MiB, W_DN = W_GU + 2 * (size_t)2 * DFF * 1024 * 2, W_PJ = W_DN + 2 * (size_t)DFF * 1024 * 2, W_PG = W_PJ + 2 * (size_t)256 * 1024 * 2, W_END = W_PG + 4 * MiB;
static_assert(W_END <= 62 * MiB, "weights");
constexpr size_t WS_HBA = 62 * MiB, WS_HBB = 190 * MiB, WS_Y = 318 * MiB, WS_Z = 446 * MiB, WS_TAIL = 990 * MiB, WS_END = 1024 * MiB;
constexpr size_t WS_QP = WS_HBA, WS_KP = WS_HBA + 64 * MiB;
constexpr size_t WS_QI = 926 * MiB, WS_KI = WS_TAIL, WS_WI = WS_TAIL + 8 * MiB, WS_MASK = WS_TAIL + 10 * MiB;
constexpr size_t WS_HID = WS_Z, WS_ERAW = WS_Z + 352 * MiB, WS_PB = WS_TAIL;
constexpr size_t WS_TG = WS_HBA, WS_KPD = WS_HBB, WS_VBD = WS_Y, WS_GCUM = WS_TAIL, WS_BETA = WS_TAIL + 2 * MiB;
constexpr int LDS_BYTES = 160 * 1024;
constexpr int NPH = 16;

__device__ __forceinline__ float bf2f(unsigned short b) { return __uint_as_float((unsigned)b << 16); }
__device__ __forceinline__ unsigned pk2(float lo, float hi) { return pg8::cvt_pk_bf16(lo, hi); }
__device__ __forceinline__ unsigned short f2bf(float f) { return (unsigned short)(pk2(f, 0.f) & 0xffffu); }
__device__ __forceinline__ void unpack8(const u32x4 w, float* v) {
    v[0] = __uint_as_float(w.x << 16); v[1] = __uint_as_float(w.x & 0xffff0000u); v[2] = __uint_as_float(w.y << 16); v[3] = __uint_as_float(w.y & 0xffff0000u);
    v[4] = __uint_as_float(w.z << 16); v[5] = __uint_as_float(w.z & 0xffff0000u); v[6] = __uint_as_float(w.w << 16); v[7] = __uint_as_float(w.w & 0xffff0000u); }
__device__ __forceinline__ void ld8(const bf16* p, float* v) { unpack8(*(const u32x4*)p, v); }
__device__ __forceinline__ u32x4 pack8(const float* v) { u32x4 w; w.x = pk2(v[0], v[1]); w.y = pk2(v[2], v[3]); w.z = pk2(v[4], v[5]); w.w = pk2(v[6], v[7]); return w; }
__device__ __forceinline__ void st8(bf16* p, const float* v) { *(u32x4*)p = pack8(v); }
__device__ __forceinline__ float sigmoidf_(float x) { return __builtin_amdgcn_rcpf(1.0f + __builtin_amdgcn_exp2f(-1.4426950408889634f * x)); }
__device__ __forceinline__ float siluf_(float x) { return x * sigmoidf_(x); }
#define MFMA16(a, b, c) __builtin_amdgcn_mfma_f32_16x16x32_bf16((a), (b), (c), 0, 0, 0)
#define MFMA32(a, b, c) __builtin_amdgcn_mfma_f32_32x32x16_bf16((a), (b), (c), 0, 0, 0)

struct Args { const void* in[25]; float* out; unsigned char* ws; int ph_lo, ph_hi, coop, pad; };
typedef const __attribute__((address_space(4))) Args CArgs;
__device__ __forceinline__ CArgs* launder_args(CArgs* p) { asm volatile("" : "+s"(p)); return p; }

__device__ __forceinline__ void transpose_item(const float* W, int K, int N, int NP, bf16* WT, const float* gain, int mode, LAS float* scr, int item, int lane) {
    const int nnb = NP / 32, kb = item / nnb, nb = item % nnb, k0 = 64 * kb, n0 = 32 * nb;
    const int n = n0 + (lane & 31);
#pragma unroll
    for (int i = 0; i < 32; ++i) { const int kk = 2 * i + (lane >> 5); float v = 0.f; if (n < N) { v = W[(size_t)(k0 + kk) * N + n]; if (gain) v *= gain[k0 + kk]; } scr[kk * 33 + (lane & 31)] = v; }
    asm volatile("s_waitcnt lgkmcnt(0)" ::: "memory");
    const int c = lane & 7;
    const int r0 = (mode == 0) ? n0 : ((n0 >> 7) * 256 + (mode == 2 ? 128 : 0) + (n0 & 127));
#pragma unroll
    for (int j = 0; j < 4; ++j) { const int nn = (lane >> 3) + 8 * j; const LAS float* s = scr + (8 * c) * 33 + nn;
        u32x4 o; o.x = pk2(s[0 * 33], s[1 * 33]); o.y = pk2(s[2 * 33], s[3 * 33]); o.z = pk2(s[4 * 33], s[5 * 33]); o.w = pk2(s[6 * 33], s[7 * 33]);
        *(u32x4*)(WT + (size_t)(r0 + nn) * K + k0 + 8 * c) = o; }
    asm volatile("s_waitcnt lgkmcnt(0)" ::: "memory");
}
__device__ __forceinline__ float wave_sum(float v) {
#pragma unroll
    for (int o = 1; o < 64; o <<= 1) v += __shfl_xor(v, o);
    return v;
}
__device__ __forceinline__ void prologue(CArgs& a, LAS unsigned char* lds, int tid) {
    const int lane = tid & 63, wave = tid >> 6, gw = blockIdx.x * 8 + wave, NGW = gridDim.x * 8;
    LAS float* scr = (LAS float*)(lds + wave * 16384);
    unsigned char* ws = a.ws;
    int it = gw;
#define DO_MAT(Wp, K_, N_, NP_, dst, gain, mode) { const int cnt = ((K_) / 64) * ((NP_) / 32); for (; it < cnt; it += NGW) transpose_item((Wp), (K_), (N_), (NP_), (bf16*)(dst), (gain), (mode), scr, it, lane); it -= cnt; }
    const float* nmg = (const float*)a.in[3]; const float* nfg = (const float*)a.in[4]; const float* png = (const float*)a.in[23];
    DO_MAT((const float*)a.in[5], 1024, EV_N, EV_NP, ws + W_EVIN, nmg, 0)
    DO_MAT((const float*)a.in[11], 1024, 1024, 1024, ws + W_EVOUT, (const float*)nullptr, 0)
    DO_MAT((const float*)a.in[12], 1024, OD_N, OD_NP, ws + W_ODIN, nmg + 1024, 0)
    DO_MAT((const float*)a.in[17], 1024, 1024, 1024, ws + W_ODOUT, (const float*)nullptr, 0)
    for (int l = 0; l < 2; ++l) {
        DO_MAT((const float*)a.in[18] + (size_t)l * 1024 * DFF, 1024, DFF, DFF, ws + W_GU + (size_t)l * 2 * DFF * 1024 * 2, nfg + l * 1024, 1)
        DO_MAT((const float*)a.in[19] + (size_t)l * 1024 * DFF, 1024, DFF, DFF, ws + W_GU + (size_t)l * 2 * DFF * 1024 * 2, nfg + l * 1024, 2)
        DO_MAT((const float*)a.in[20] + (size_t)l * 1024 * DFF, DFF, 1024, 1024, ws + W_DN + (size_t)l * DFF * 1024 * 2, (const float*)nullptr, 0)
        DO_MAT((const float*)a.in[21] + (size_t)l * 256 * 1024, 256, 1024, 1024, ws + W_PJ + (size_t)l * 256 * 1024 * 2, (const float*)nullptr, 0)
        DO_MAT((const float*)a.in[24] + (size_t)l * 1024 * 1024, 1024, 1024, 1024, ws + W_PG + (size_t)l * 1024 * 1024 * 2, png + l * 1024, 0)
    }
#undef DO_MAT
    const float* x = (const float*)a.in[0]; bf16* xb = (bf16*)(ws + WS_HBB); float* rsq = (float*)(ws + WS_RSQ);
    for (int m0 = gw; m0 < M; m0 += 4 * NGW) {
        f32x4 v[4][4];
#pragma unroll
        for (int r = 0; r < 4; ++r) { const int m = m0 + r * NGW; if (m < M) { const f32x4* xr = (const f32x4*)(x + (size_t)m * DM) + lane;
#pragma unroll
            for (int j = 0; j < 4; ++j) v[r][j] = xr[64 * j]; } }
#pragma unroll
        for (int r = 0; r < 4; ++r) { const int m = m0 + r * NGW; if (m < M) { unsigned long long* o8 = (unsigned long long*)(xb + (size_t)m * DM) + lane; float s = 0.f;
#pragma unroll
            for (int j = 0; j < 4; ++j) { const f32x4 w = v[r][j]; s += (w.x * w.x + w.y * w.y) + (w.z * w.z + w.w * w.w); o8[64 * j] = (unsigned long long)pk2(w.x, w.y) | ((unsigned long long)pk2(w.z, w.w) << 32); }
            s = wave_sum(s); if (lane == 0) rsq[m] = s; } }
    }
    for (int i = blockIdx.x * 512 + tid; i < 7 * M; i += gridDim.x * 512) rsq[M + i] = 0.f;
}
__device__ __forceinline__ void convert_p(const float* p, bf16* pb, int tid) {
    for (size_t i = (size_t)blockIdx.x * 512 + tid; i < (size_t)M * 256 / 8; i += (size_t)gridDim.x * 512) {
        const f32x4 v0 = *(const f32x4*)(p + i * 8), v1 = *(const f32x4*)(p + i * 8 + 4);
        u32x4 w; w.x = pk2(v0.x, v0.y); w.y = pk2(v0.z, v0.w); w.z = pk2(v1.x, v1.y); w.w = pk2(v1.z, v1.w); *(u32x4*)(pb + i * 8) = w; }
}

__device__ __forceinline__ void rope8(float* x, const LAS float* cs, const LAS float* sn, int i0, int xorm, bool first, bool active) {
#pragma unroll
    for (int e = 0; e < 8; ++e) { const float p = __shfl_xor(x[e], xorm); const float c = cs[i0 + e], s = sn[i0 + e]; const float r = first ? x[e] * c - p * s : p * s + x[e] * c; if (active) x[e] = r; }
}
__device__ __forceinline__ void even_post(CArgs& a, LAS unsigned char* lds, int tid) {
    const int lane = tid & 63, wave = tid >> 6, gw = blockIdx.x * 8 + wave, NGW = gridDim.x * 8, j = lane & 7, col = 8 * lane;
    LAS float* rs = (LAS float*)(lds + wave * 512);
    unsigned char* ws = a.ws;
    const bf16* Z = (const bf16*)(ws + WS_Z); bf16* Y = (bf16*)(ws + WS_Y); bf16* QP = (bf16*)(ws + WS_QP); bf16* KP = (bf16*)(ws + WS_KP);
    bf16* QI = (bf16*)(ws + WS_QI); bf16* KI = (bf16*)(ws + WS_KI); float* WI = (float*)(ws + WS_WI);
    const int* positions = (const int*)a.in[2]; const float* cw = (const float*)a.in[6];
    const float* qg = (const float*)a.in[7]; const float* kg = (const float*)a.in[8]; const float* lng = (const float*)a.in[9]; const float* lnb = (const float*)a.in[10];
    float cw0[8], cw1[8], cw2[8], qgv[8], kgv[8];
#pragma unroll
    for (int e = 0; e < 8; ++e) { cw0[e] = cw[col + e]; cw1[e] = cw[512 + col + e]; cw2[e] = cw[1024 + col + e]; qgv[e] = qg[(col & 63) + e]; kgv[e] = kg[(col & 63) + e]; }
    const float inva = 1.0f / powf(10000.f, (float)(2 * (lane & 31)) / 64.f), invi = 1.0f / powf(10000.f, (float)(2 * (lane & 15)) / 32.f);
    for (int row = gw; row < M; row += NGW) {
        const int t = row & (SEQ - 1); const float pos = (float)positions[row];
        if (lane < 32) { const float ang = pos * inva; rs[lane] = cosf(ang); rs[32 + lane] = sinf(ang); }
        else if (lane < 48) { const float ang = pos * invi; rs[64 + lane - 32] = cosf(ang); rs[80 + lane - 32] = sinf(ang); }
        const bf16* z = Z + (size_t)row * EV_NP;
        float v[8], u0[8], u1[8], u2[8], tmp[8];
        const bf16* z1 = z - (t >= 1 ? EV_NP : 0); const bf16* z2 = z - (t >= 2 ? 2 * EV_NP : 0); const float m1 = t >= 1 ? 1.f : 0.f, m2 = t >= 2 ? 1.f : 0.f;
        const u32x4 r_zb = *(const u32x4*)(z + col), r_c0 = *(const u32x4*)(z + 512 + col), r_h0 = *(const u32x4*)(z + 1024 + col);
        const u32x4 r_c1 = *(const u32x4*)(z1 + 512 + col), r_h1 = *(const u32x4*)(z1 + 1024 + col), r_c2 = *(const u32x4*)(z2 + 512 + col), r_h2 = *(const u32x4*)(z2 + 1024 + col);
        const u32x4 r_q = *(const u32x4*)(z + 1536 + col), r_k = *(const u32x4*)(z + 2048 + col), r_qi = *(const u32x4*)(z + 3072 + col), r_ki = *(const u32x4*)(z + 3584 + 8 * j), r_wi = *(const u32x4*)(z + 3648);
        unpack8(r_c0, u0); unpack8(r_h0, tmp);
#pragma unroll
        for (int e = 0; e < 8; ++e) u0[e] *= tmp[e];
        unpack8(r_c1, u1); unpack8(r_h1, tmp);
#pragma unroll
        for (int e = 0; e < 8; ++e) u1[e] *= tmp[e] * m1;
        unpack8(r_c2, u2); unpack8(r_h2, tmp);
#pragma unroll
        for (int e = 0; e < 8; ++e) u2[e] *= tmp[e] * m2;
        unpack8(r_zb, v);
#pragma unroll
        for (int e = 0; e < 8; ++e) v[e] = v[e] * (cw0[e] * u2[e] + cw1[e] * u1[e] + cw2[e] * u0[e]);
        st8(Y + (size_t)row * 1024 + col, v);
#pragma unroll
        for (int which = 0; which < 2; ++which) {
            unpack8(which ? r_k : r_q, v); float ss = 0.f;
#pragma unroll
            for (int e = 0; e < 8; ++e) ss += v[e] * v[e];
            ss += __shfl_xor(ss, 1); ss += __shfl_xor(ss, 2); ss += __shfl_xor(ss, 4);
            const float r = __builtin_amdgcn_rsqf(ss * (1.0f / 64.0f) + EPS);
#pragma unroll
            for (int e = 0; e < 8; ++e) v[e] = v[e] * r * (which ? kgv[e] : qgv[e]);
            rope8(v, rs, rs + 32, 8 * (j & 3), 4, j < 4, true);
            if (which == 0) {
#pragma unroll
                for (int e = 0; e < 8; ++e) v[e] *= 0.125f * 1.4426950408889634f;
                st8(QP + (size_t)row * 512 + col, v);
            } else st8(KP + (size_t)row * 512 + col, v);
        }
        unpack8(r_qi, v);
        rope8(v, rs + 64, rs + 80, 8 * (j & 1), 2, j < 2, j < 4);
        st8(QI + (size_t)row * 512 + col, v);
        unpack8(r_ki, v);
        { float s = 0.f;
#pragma unroll
            for (int e = 0; e < 8; ++e) s += v[e];
            s += __shfl_xor(s, 1); s += __shfl_xor(s, 2); s += __shfl_xor(s, 4);
            const float mu = s * (1.0f / 64.0f); float q = 0.f;
#pragma unroll
            for (int e = 0; e < 8; ++e) { v[e] -= mu; q += v[e] * v[e]; }
            q += __shfl_xor(q, 1); q += __shfl_xor(q, 2); q += __shfl_xor(q, 4);
            const float r = __builtin_amdgcn_rsqf(q * (1.0f / 64.0f) + EPS);
#pragma unroll
            for (int e = 0; e < 8; ++e) v[e] = v[e] * r * lng[8 * j + e] + lnb[8 * j + e];
            rope8(v, rs + 64, rs + 80, 8 * (j & 1), 2, j < 2, j < 4);
            if (lane < 8) st8(KI + (size_t)row * 64 + 8 * j, v);
        }
        if (lane == 8) { unpack8(r_wi, v); float* wo = WI + (size_t)row * 8;
#pragma unroll
            for (int e = 0; e < 8; ++e) wo[e] = v[e] * 0.044194173824159216f; }
    }
}
#define XB_TMO      128
#define XB_XCNT(j)  (256  + 64 * (j))
#define XB_XSUB(j)  (1280 + 64 * (j))
#define XB_XGEN(j)  (2304 + 64 * (j))
#define XB_TOP      3328
#define XB_TOPGEN   3392
#define XCD_BAR_WORDS 3456
#define XB_SPIN_CAP (1u << 18)

__device__ __forceinline__ unsigned xb_ld(unsigned* p)              { return __hip_atomic_load(p, __ATOMIC_RELAXED, __HIP_MEMORY_SCOPE_AGENT); }
__device__ __forceinline__ unsigned xb_add(unsigned* p, unsigned v) { return __hip_atomic_fetch_add(p, v, __ATOMIC_RELAXED, __HIP_MEMORY_SCOPE_AGENT); }
__device__ __forceinline__ unsigned xb_xcc_id() { return (unsigned)__builtin_amdgcn_s_getreg((3 << 11) | 20) & 0xFu; }
#define XB_SPIN(cond, bar) do { unsigned _sp = 0; while (cond) { __builtin_amdgcn_s_sleep(1); \
    if ((++_sp & 255u) == 0u) { if (xb_ld(&(bar)[XB_TMO])) break; if (_sp > XB_SPIN_CAP) { atomicAdd(&(bar)[XB_TMO], 1u); break; } } } } while (0)

struct XcdBarrier {
    unsigned* bar; unsigned x;
    volatile LAS unsigned* st;
};

__device__ __forceinline__ XcdBarrier xcd_barrier_post(unsigned* bar, volatile LAS unsigned* st) {
    XcdBarrier b; b.bar = bar; b.x = xb_xcc_id(); b.st = st;
    if (threadIdx.x == 0) (void)xb_add(&bar[XB_XCNT(b.x)], 1u);
    return b;
}
__device__ __forceinline__ void xcd_barrier_complete(unsigned* bar, unsigned x, unsigned& nloc, unsigned& nx) {
    const unsigned G = gridDim.x * gridDim.y * gridDim.z;
    unsigned sum, cnt, mine, sp = 0u;
    for (;;) {
        sum = 0u; cnt = 0u; mine = 0u;
#pragma unroll
        for (unsigned j = 0; j < 16; ++j) { const unsigned c = xb_ld(&bar[XB_XCNT(j)]); sum += c; cnt += (c > 0u) ? 1u : 0u; mine = (j == x) ? c : mine; }
        if (sum == G) break;
        __builtin_amdgcn_s_sleep(1);
        if ((++sp & 255u) == 0u) { if (xb_ld(&bar[XB_TMO])) break; if (sp > XB_SPIN_CAP) { atomicAdd(&bar[XB_TMO], 1u); break; } }
    }
    nloc = mine > 0u ? mine : 1u; nx = cnt > 0u ? cnt : 1u;
}

__device__ __forceinline__ void xcd_barrier(const XcdBarrier& b) {
    asm volatile("s_waitcnt vmcnt(0)" ::: "memory");
    __syncthreads();
    if (threadIdx.x == 0) {
        unsigned* bar = b.bar;
        __builtin_amdgcn_s_waitcnt(0);
        unsigned nloc = b.st[0], nx = b.st[1];
        if (nloc == 0u) { xcd_barrier_complete(bar, b.x, nloc, nx); b.st[0] = nloc; b.st[1] = nx; }
        const unsigned old = xb_add(&bar[XB_XSUB(b.x)], 1u);
        const unsigned gen = old / nloc;
        if (old + 1u == (gen + 1u) * nloc) {
            __builtin_amdgcn_fence(__ATOMIC_RELEASE, "agent");
            asm volatile("s_waitcnt vmcnt(0)" ::: "memory");
            const unsigned og = xb_add(&bar[XB_TOP], 1u);
            const unsigned tg = og / nx;
            if (og + 1u == (tg + 1u) * nx) xb_add(&bar[XB_TOPGEN], 1u);
            else XB_SPIN(xb_ld(&bar[XB_TOPGEN]) == tg, bar);
            __builtin_amdgcn_fence(__ATOMIC_ACQUIRE, "agent");
            xb_add(&bar[XB_XGEN(b.x)], 1u);
            asm volatile("s_waitcnt vmcnt(0)" ::: "memory");
        } else {
            XB_SPIN(xb_ld(&bar[XB_XGEN(b.x)]) == gen, bar);
            __builtin_amdgcn_fence(__ATOMIC_ACQUIRE, "agent");
            asm volatile("s_waitcnt vmcnt(0)" ::: "memory");
        }
    }
    __syncthreads();
}
__device__ __forceinline__ void idx_phase(LAS unsigned char* lds, const bf16* QI, const bf16* KI, const float* WI, u64* MASK, int tid) {
    const int lane = tid & 63, wave = __builtin_amdgcn_readfirstlane(tid >> 6), l15 = lane & 15, kq = lane >> 4;
    LAS float* sc = (LAS float*)lds; constexpr int SCP = 2052;
    for (int u = blockIdx.x; u < 4096; u += gridDim.x) {
        const int b = u & 31, r = u >> 5, rnd = r >> 3, sub = r & 7; const int qt = rnd * 8 + ((rnd & 1) ? 7 - sub : sub);
        const int q0 = qt * 16; const size_t rb = (size_t)b * SEQ;
        if (q0 < 256) {
            for (int qq = 2 * wave; qq < 2 * wave + 2; ++qq) { const int t = q0 + qq; if (lane < 32) { const int n = t + 1 - 64 * lane; const u64 w = n <= 0 ? 0ull : (n >= 64 ? ~0ull : ((1ull << n) - 1ull)); MASK[(rb + t) * 32 + lane] = w; } }
            continue;
        }
        bf16x8 Bq[8][2]; float wv[8];
        { const bf16* qp = QI + (rb + q0 + l15) * 512 + kq * 8; const float* wp = WI + (rb + q0 + l15) * 8;
#pragma unroll
            for (int h = 0; h < 8; ++h) { Bq[h][0] = *(const bf16x8*)(qp + h * 64); Bq[h][1] = *(const bf16x8*)(qp + h * 64 + 32); wv[h] = wp[h]; } }
        bf16x8 A0n, A1n; { const int kt0 = wave <= qt ? wave : qt; const bf16* kp = KI + (rb + 16 * kt0 + l15) * 64 + kq * 8; A0n = *(const bf16x8*)kp; A1n = *(const bf16x8*)(kp + 32); }
        for (int kt = wave; kt <= qt; kt += 8) {
            const bf16x8 A0 = A0n, A1 = A1n;
            { const int ktn = kt + 8 <= qt ? kt + 8 : qt; const bf16* kp = KI + (rb + 16 * ktn + l15) * 64 + kq * 8; A0n = *(const bf16x8*)kp; A1n = *(const bf16x8*)(kp + 32); }
            f32x4 s = {0.f, 0.f, 0.f, 0.f};
#pragma unroll
            for (int h = 0; h < 8; ++h) { f32x4 D = {0.f, 0.f, 0.f, 0.f}; D = MFMA16(A0, Bq[h][0], D); D = MFMA16(A1, Bq[h][1], D);
#pragma unroll
                for (int e = 0; e < 4; ++e) s[e] = fmaf(wv[h], fmaxf(D[e], 0.f), s[e]); }
            *(LAS f32x4*)(sc + l15 * SCP + 16 * kt + 4 * kq) = s;
        }
        __syncthreads();
        for (int qq = 2 * wave; qq < 2 * wave + 2; ++qq) {
            const int t = q0 + qq; const int nrows = __builtin_amdgcn_readfirstlane((t >> 6) + 1);
            unsigned kv[32];
#pragma unroll
            for (int i = 0; i < 32; ++i) { const int idx = 64 * i + lane; unsigned k = 0u;
                if (idx <= t) { const float f = sc[qq * SCP + idx]; unsigned ub = __float_as_uint(f); if (f == 0.f) ub = 0u; k = (ub & 0x80000000u) ? ~ub : (ub | 0x80000000u); }
                kv[i] = k; }
            unsigned T = 0u;
            for (int bit = 31; bit >= 0; --bit) {
                const unsigned cand = T | (1u << bit); int cnt = 0;
#pragma unroll
                for (int g = 0; g < 4; ++g) if (8 * g < nrows) {
                    u64 bm[8];
#pragma unroll
                    for (int i = 0; i < 8; ++i) bm[i] = __ballot(kv[8 * g + i] >= cand);
                    __builtin_amdgcn_sched_barrier(0);
#pragma unroll
                    for (int i = 0; i < 8; ++i) cnt += __popcll(bm[i]);
                    __builtin_amdgcn_sched_barrier(0); }
                if (cnt >= 256) { T = cand; if (cnt == 256) break; }
            }
            int cgt = 0;
#pragma unroll
            for (int g = 0; g < 4; ++g) if (8 * g < nrows) {
#pragma unroll
                for (int i = 8 * g; i < 8 * g + 8; ++i) cgt += __popcll(__ballot(kv[i] > T)); }
            const int need = 256 - cgt; int tb = 0; u64 word = 0ull; const u64 ltm = (1ull << lane) - 1ull;
#pragma unroll
            for (int g = 0; g < 4; ++g) if (8 * g < nrows) {
#pragma unroll
                for (int i = 8 * g; i < 8 * g + 8; ++i) {
                    const u64 eqm = __ballot(kv[i] == T); const int rank = tb + __popcll(eqm & ltm);
                    const u64 selm = __ballot(kv[i] > T || (kv[i] == T && rank < need)); tb += __popcll(eqm);
                    if (lane == i) word = selm; } }
            if (lane < 32) MASK[(rb + t) * 32 + lane] = word;
        }
        __syncthreads();
    }
}

__device__ __forceinline__ int crow(int r, int hi) { return (r & 3) + 8 * (r >> 2) + 4 * hi; }
__device__ __forceinline__ void attn_phase(LAS unsigned char* lds, const bf16* QP, const bf16* KP, const bf16* Z0, const u64* MASK, bf16* Y, int tid) {
    const int lane = tid & 63, wave = __builtin_amdgcn_readfirstlane(tid >> 6), l31 = lane & 31, hi = lane >> 5;
    LAS bf16* Kb = (LAS bf16*)lds; LAS bf16* Vt = (LAS bf16*)(lds + 18432); LAS float* lsc = (LAS float*)(lds + 36864) + wave * 32;
    const int lk = tid >> 3, lc = tid & 7;
    for (int u = blockIdx.x; u < 256; u += gridDim.x) {
        const int b = u >> 3, h = u & 7; const size_t rb = (size_t)b * SEQ;
        for (int qb = 7; qb >= 0; --qb) {
            const int q0 = qb * 256, NT = 4 * (qb + 1), qw0 = q0 + 32 * wave, q = qw0 + l31;
            bf16x8 qr[4];
#pragma unroll
            for (int d0 = 0; d0 < 4; ++d0) qr[d0] = *(const bf16x8*)(QP + (rb + q) * 512 + h * 64 + 16 * d0 + 8 * hi);
            f32x16 O0, O1;
#pragma unroll
            for (int r = 0; r < 16; ++r) { O0[r] = 0.f; O1[r] = 0.f; }
            float l = 0.f;
            u32x4 kreg = *(const u32x4*)(KP + (rb + lk) * 512 + h * 64 + 8 * lc), vreg = *(const u32x4*)(Z0 + (rb + lane) * EV_NP + 2560 + h * 64 + 8 * wave);
#define ATT_STORE(buf) do { *(LAS u32x4*)(Kb + (buf) * 4608 + lk * 72 + 8 * lc) = kreg; LAS bf16* vt_ = Vt + (buf) * 4608 + (8 * wave) * 72 + lane; \
            vt_[0] = (bf16)(vreg.x & 0xffffu); vt_[72] = (bf16)(vreg.x >> 16); vt_[144] = (bf16)(vreg.y & 0xffffu); vt_[216] = (bf16)(vreg.y >> 16); \
            vt_[288] = (bf16)(vreg.z & 0xffffu); vt_[360] = (bf16)(vreg.z >> 16); vt_[432] = (bf16)(vreg.w & 0xffffu); vt_[504] = (bf16)(vreg.w >> 16); } while (0)
            ATT_STORE(0);
            u64 mwn = MASK[(rb + q) * 32];
            __syncthreads();
            for (int t = 0; t < NT; ++t) {
                const int cur = t & 1; const u64 mw = mwn;
                if (t + 1 < NT) { kreg = *(const u32x4*)(KP + (rb + 64 * (t + 1) + lk) * 512 + h * 64 + 8 * lc); vreg = *(const u32x4*)(Z0 + (rb + 64 * (t + 1) + lane) * EV_NP + 2560 + h * 64 + 8 * wave); mwn = MASK[(rb + q) * 32 + t + 1]; }
                if (64 * t <= qw0 + 31) {
                    f32x16 S0, S1;
#pragma unroll
                    for (int r = 0; r < 16; ++r) { S0[r] = 0.f; S1[r] = 0.f; }
                    const LAS bf16* kb = Kb + cur * 4608 + l31 * 72 + 8 * hi;
#pragma unroll
                    for (int d0 = 0; d0 < 4; ++d0) { const bf16x8 a0 = *(const LAS bf16x8*)(kb + 16 * d0), a1 = *(const LAS bf16x8*)(kb + 32 * 72 + 16 * d0);
                        S0 = MFMA32(a0, qr[d0], S0); S1 = MFMA32(a1, qr[d0], S1); }
                    const unsigned mlo = (unsigned)mw >> (4 * hi), mhi = (unsigned)(mw >> 32) >> (4 * hi);
                    float ps = 0.f;
#pragma unroll
                    for (int r = 0; r < 16; ++r) { const int cb = (r & 3) + 8 * (r >> 2);
                        const unsigned b0 = (unsigned)__builtin_amdgcn_sbfe(mlo, cb, 1), b1 = (unsigned)__builtin_amdgcn_sbfe(mhi, cb, 1);
                        const float p0 = __uint_as_float(__float_as_uint(__builtin_amdgcn_exp2f(S0[r])) & b0), p1 = __uint_as_float(__float_as_uint(__builtin_amdgcn_exp2f(S1[r])) & b1);
                        ps += p0 + p1; S0[r] = p0; S1[r] = p1; }
                    l += ps;
                    u32x4 pw[4];
                    pw[0] = (u32x4){pk2(S0[0], S0[1]), pk2(S0[2], S0[3]), pk2(S0[4], S0[5]), pk2(S0[6], S0[7])};
                    pw[1] = (u32x4){pk2(S0[8], S0[9]), pk2(S0[10], S0[11]), pk2(S0[12], S0[13]), pk2(S0[14], S0[15])};
                    pw[2] = (u32x4){pk2(S1[0], S1[1]), pk2(S1[2], S1[3]), pk2(S1[4], S1[5]), pk2(S1[6], S1[7])};
                    pw[3] = (u32x4){pk2(S1[8], S1[9]), pk2(S1[10], S1[11]), pk2(S1[12], S1[13]), pk2(S1[14], S1[15])};
                    const LAS bf16* vt = Vt + cur * 4608 + l31 * 72 + 4 * hi;
#pragma unroll
                    for (int m = 0; m < 4; ++m) { const int base = 16 * (m & 1) + 32 * (m >> 1);
                        const u64 lo0 = *(const LAS u64*)(vt + base), hi0 = *(const LAS u64*)(vt + base + 8), lo1 = *(const LAS u64*)(vt + 32 * 72 + base), hi1 = *(const LAS u64*)(vt + 32 * 72 + base + 8);
                        const u32x4 v0 = {(unsigned)lo0, (unsigned)(lo0 >> 32), (unsigned)hi0, (unsigned)(hi0 >> 32)}, v1 = {(unsigned)lo1, (unsigned)(lo1 >> 32), (unsigned)hi1, (unsigned)(hi1 >> 32)};
                        O0 = MFMA32(__builtin_bit_cast(bf16x8, pw[m]), __builtin_bit_cast(bf16x8, v0), O0);
                        O1 = MFMA32(__builtin_bit_cast(bf16x8, pw[m]), __builtin_bit_cast(bf16x8, v1), O1); }
                }
                if (t + 1 < NT) ATT_STORE(cur ^ 1);
                __syncthreads();
            }
#undef ATT_STORE
            l += __shfl_xor(l, 32);
            if (hi == 0) lsc[l31] = l;
            asm volatile("s_waitcnt lgkmcnt(0)" ::: "memory");
#pragma unroll
            for (int r = 0; r < 16; ++r) { const int qr_ = crow(r, hi); const float rl = __builtin_amdgcn_rcpf(lsc[qr_]);
                bf16* yp = Y + (rb + qw0 + qr_) * 1024 + 512 + h * 64 + l31; yp[0] = f2bf(O0[r] * rl); yp[32] = f2bf(O1[r] * rl); }
        }
    }
}
__device__ __forceinline__ void conv16(const bf16* zbase, int t, const float* cwp, float* out) {
    float acc[16];
#pragma unroll
    for (int e = 0; e < 16; ++e) acc[e] = 0.f;
#pragma unroll
    for (int jt = 0; jt < 4; ++jt) { if (t - 3 + jt >= 0) { float x[16]; ld8(zbase + (ptrdiff_t)(jt - 3) * OD_NP, x); ld8(zbase + (ptrdiff_t)(jt - 3) * OD_NP + 8, x + 8);
            const float* w = cwp + jt * 3072;
#pragma unroll
            for (int e = 0; e < 16; ++e) acc[e] = fmaf(w[e], x[e], acc[e]); } }
#pragma unroll
    for (int e = 0; e < 16; ++e) out[e] = siluf_(acc[e]);
}
__device__ __forceinline__ void conv16_ld(const bf16* zbase, int t, u32x4* raw) {
#pragma unroll
    for (int jt = 0; jt < 4; ++jt) { const int back = (t - 3 + jt >= 0) ? (3 - jt) : 0; const bf16* p = zbase - (ptrdiff_t)back * OD_NP; raw[2 * jt] = *(const u32x4*)p; raw[2 * jt + 1] = *(const u32x4*)(p + 8); }
}
__device__ __forceinline__ void conv16_fin(const u32x4* raw, int t, const LAS float* wl, int c16, float* out) {
    float acc[16];
#pragma unroll
    for (int e = 0; e < 16; ++e) acc[e] = 0.f;
#pragma unroll
    for (int jt = 0; jt < 4; ++jt) { float x[16]; unpack8(raw[2 * jt], x); unpack8(raw[2 * jt + 1], x + 8); const float msk = (t - 3 + jt >= 0) ? 1.f : 0.f;
#pragma unroll
        for (int q4 = 0; q4 < 4; ++q4) { const f32x4 w = *(const LAS f32x4*)(wl + jt * 128 + c16 + 4 * q4);
#pragma unroll
            for (int e = 0; e < 4; ++e) acc[4 * q4 + e] = fmaf(w[e] * msk, x[4 * q4 + e], acc[4 * q4 + e]); } }
#pragma unroll
    for (int e = 0; e < 16; ++e) out[e] = siluf_(acc[e]);
}
__device__ __forceinline__ void dn_prep(CArgs& a, LAS unsigned char* lds, int tid) {
    const int lane = tid & 63, wave = __builtin_amdgcn_readfirstlane(tid >> 6), l15 = lane & 15, kq = lane >> 4;
    unsigned char* ws = a.ws;
    const bf16* Z1 = (const bf16*)(ws + WS_Z); bf16* KPD = (bf16*)(ws + WS_KPD); bf16* VBD = (bf16*)(ws + WS_VBD); bf16* TG = (bf16*)a.out;
    float* GCUM = (float*)(ws + WS_GCUM); float* BETA = (float*)(ws + WS_BETA);
    const float* cw = (const float*)a.in[13]; const float* a_log = (const float*)a.in[14]; const float* dt_bias = (const float*)a.in[15];
    LAS bf16* KN = (LAS bf16*)lds; LAS float* AM = (LAS float*)(lds + 17408); LAS float* GC = (LAS float*)(lds + 17408 + 131072); LAS float* BT = GC + 64; LAS float* CWK = GC + 128; LAS float* CWV = CWK + 512;
    const int row = tid >> 3, c8 = tid & 7;
    for (int grp = blockIdx.x; grp < 1024; grp += gridDim.x) {
        const int bh = grp >> 2, ng = grp & 3, b = bh >> 3, h = bh & 7; const size_t rb = (size_t)b * SEQ;
        { const int jt_ = tid >> 7, cc_ = tid & 127; CWK[jt_ * 128 + cc_] = cw[jt_ * 3072 + 1024 + h * 128 + cc_]; CWV[jt_ * 128 + cc_] = cw[jt_ * 3072 + 2048 + h * 128 + cc_]; }
        __syncthreads();
#ifndef NO_PREPA
        for (int ci = 0; ci < 8; ++ci) {
            const int n = ng * 8 + ci, t0 = 64 * n, t = t0 + row;
            if (tid < 64) { const int tt = t0 + tid; const bf16* zr = Z1 + (rb + tt) * OD_NP;
                const float av = bf2f(zr[4096 + h]), bv = bf2f(zr[4104 + h]); const float xx = av + dt_bias[h];
                const float sp = xx > 20.f ? xx : log1pf(expf(xx)); float g = -expf(a_log[h]) * sp; const float beta = sigmoidf_(bv);
#pragma unroll
                for (int o = 1; o < 64; o <<= 1) { const float up = __shfl_up(g, o); if (lane >= o) g += up; }
                GC[tid] = g; BT[tid] = beta; GCUM[(size_t)bh * SEQ + tt] = g; BETA[(size_t)bh * SEQ + tt] = beta; }
            const bf16* zr = Z1 + (rb + t) * OD_NP;
            u32x4 rawk[8], rawv[8]; conv16_ld(zr + 1024 + h * 128 + 16 * c8, t, rawk); conv16_ld(zr + 2048 + h * 128 + 16 * c8, t, rawv);
            const float betar = sigmoidf_(bf2f(zr[4104 + h]));
            float x[16];
            conv16_fin(rawk, t, CWK, 16 * c8, x);
            float ss = 0.f;
#pragma unroll
            for (int e = 0; e < 16; ++e) ss += x[e] * x[e];
            ss += __shfl_xor(ss, 1); ss += __shfl_xor(ss, 2); ss += __shfl_xor(ss, 4);
            const float rn = __builtin_amdgcn_rsqf(ss + EPS);
#pragma unroll
            for (int e = 0; e < 16; ++e) x[e] *= rn;
            { const u32x4 w0 = pack8(x), w1 = pack8(x + 8); bf16* kp = KPD + (rb + t) * 1024 + h * 128 + 16 * c8; *(u32x4*)kp = w0; *(u32x4*)(kp + 8) = w1;
              LAS bf16* kl = KN + row * 136 + 16 * c8; *(LAS u32x4*)kl = w0; *(LAS u32x4*)(kl + 8) = w1; }
            conv16_fin(rawv, t, CWV, 16 * c8, x);
            {
#pragma unroll
              for (int e = 0; e < 16; ++e) x[e] *= betar;
              bf16* vp = VBD + (rb + t) * 1024 + h * 128 + 16 * c8; *(u32x4*)vp = pack8(x); *(u32x4*)(vp + 8) = pack8(x + 8); }
            __syncthreads();
#pragma unroll
            for (int ti = 0; ti < 2; ++ti) { const int id = 2 * wave + ti, ct = id >> 2, st = id & 3; LAS float* am = AM + ci * 4096;
                f32x4 D = {0.f, 0.f, 0.f, 0.f};
                if (st <= ct) {
#pragma unroll
                    for (int ks = 0; ks < 4; ++ks) { const bf16x8 A = *(const LAS bf16x8*)(KN + (16 * ct + l15) * 136 + 32 * ks + 8 * kq), B = *(const LAS bf16x8*)(KN + (16 * st + l15) * 136 + 32 * ks + 8 * kq); D = MFMA16(A, B, D); }
                }
                const int s = 16 * st + l15; const float gs = GC[s];
#pragma unroll
                for (int e = 0; e < 4; ++e) { const int c = 16 * ct + 4 * kq + e; am[c * 64 + s] = (c > s) ? BT[c] * __expf(GC[c] - gs) * D[e] : 0.f; } }
            __syncthreads();
        }
#endif
#ifndef NO_FSUB
        {
            const LAS float* am = AM + wave * 4096; const int n = ng * 8 + wave; bf16* tg = TG + ((size_t)bh * 32 + n) * 4096;
            float xs[64];
#pragma unroll
            for (int i = 0; i < 64; ++i) { float acc0 = (i == lane) ? 1.f : 0.f, acc1 = 0.f;
#pragma unroll
                for (int jj = 0; jj < (i + 3) / 4; ++jj) { const f32x4 a4 = *(const LAS f32x4*)(am + i * 64 + 4 * jj);
#pragma unroll
                    for (int e = 0; e < 4; ++e) if (4 * jj + e < i) { if (jj & 1) acc1 = fmaf(-a4[e], xs[4 * jj + e], acc1); else acc0 = fmaf(-a4[e], xs[4 * jj + e], acc0); } }
                xs[i] = acc0 + acc1; tg[i * 64 + lane] = f2bf(xs[i]); __builtin_amdgcn_sched_barrier(0); }
        }
#endif
        __syncthreads();
    }
}

__device__ __forceinline__ void dn_scan(CArgs& a, LAS unsigned char* lds, int tid) {
    const int lane = tid & 63, wave = __builtin_amdgcn_readfirstlane(tid >> 6); int l15 = lane & 15, kq = lane >> 4;
    unsigned char* ws = a.ws;
    const bf16* Z1 = (const bf16*)(ws + WS_Z); const bf16* KPD = (const bf16*)(ws + WS_KPD); const bf16* VBD = (const bf16*)(ws + WS_VBD); const bf16* TG = (const bf16*)a.out;
    const float* GCUM = (const float*)(ws + WS_GCUM); const float* BETA = (const float*)(ws + WS_BETA); bf16* Y = (bf16*)(ws + WS_Y);
    const float* cw = (const float*)a.in[13]; const float* ong = (const float*)a.in[16];
    LAS bf16* TM = (LAS bf16*)lds; LAS bf16* KN = (LAS bf16*)(lds + 9216); LAS bf16* KT = (LAS bf16*)(lds + 26624); LAS bf16* QN = (LAS bf16*)(lds + 45056);
    LAS bf16* VB = (LAS bf16*)(lds + 62464); LAS bf16* STB = (LAS bf16*)(lds + 80896); LAS bf16* RT = (LAS bf16*)(lds + 115712); LAS bf16* VNT = (LAS bf16*)(lds + 134144);
    LAS float* GC = (LAS float*)(lds + 152576); LAS float* COEF = GC + 64; LAS float* EGL = GC + 128; LAS float* EG = GC + 192; LAS float* ONP = GC + 256;
    LAS bf16* QK = TM; LAS bf16* VNS = VB; LAS bf16* QKB = VB;     LAS float* CWQ = ONP + 512;
    LAS bf16* ZL = RT;
    int row = tid >> 3, c8 = tid & 7;
#define RELAUNDER() asm volatile("" : "+v"(l15), "+v"(kq), "+v"(row), "+v"(c8))
    for (int bh = blockIdx.x; bh < 256; bh += gridDim.x) {
        const int b = bh >> 3, h = bh & 7; const size_t rb = (size_t)b * SEQ;
        f32x4 St[8];
#pragma unroll
        for (int i = 0; i < 8; ++i) St[i] = (f32x4){0.f, 0.f, 0.f, 0.f};
        for (int i = tid; i < 128 * 136 / 8; i += 512) *(LAS u32x4*)(STB + 8 * i) = (u32x4){0u, 0u, 0u, 0u};
        float ongv = ong[16 * wave + l15];
        { const int jt_ = tid >> 7, cc_ = tid & 127; CWQ[jt_ * 128 + cc_] = cw[jt_ * 3072 + h * 128 + cc_]; }
        __syncthreads();
#ifndef DBG_NCH
#define DBG_NCH 32
#endif
        for (int n = 0; n < DBG_NCH; ++n) {
            RELAUNDER();
            const int t0 = 64 * n, t = t0 + row;
            u32x4 rawq[8]; conv16_ld(Z1 + (rb + t) * OD_NP + h * 128 + 16 * c8, t, rawq);
            const u32x4 tgv = *(const u32x4*)(TG + ((size_t)bh * 32 + n) * 4096 + tid * 8);
            const bf16* kp = KPD + (rb + t) * 1024 + h * 128 + 16 * c8; const u32x4 kw0 = *(const u32x4*)kp, kw1 = *(const u32x4*)(kp + 8);
            const bf16* vp = VBD + (rb + t) * 1024 + h * 128 + 16 * c8; const u32x4 vw0 = *(const u32x4*)vp, vw1 = *(const u32x4*)(vp + 8);
            const bf16* zp = Z1 + (rb + t) * OD_NP + 3072 + h * 128 + 16 * c8; const u32x4 zw0 = *(const u32x4*)zp, zw1 = *(const u32x4*)(zp + 8);
            const float gl = GCUM[(size_t)bh * SEQ + t0 + 63]; const float gcr = GCUM[(size_t)bh * SEQ + t0 + row];
            float gcv = 0.f, betav = 0.f; if (tid < 64) { gcv = GCUM[(size_t)bh * SEQ + t0 + tid]; betav = BETA[(size_t)bh * SEQ + t0 + tid]; }
            *(LAS u32x4*)(TM + row * 72 + 8 * c8) = tgv;
            { LAS bf16* kl = KN + row * 136 + 16 * c8; *(LAS u32x4*)kl = kw0; *(LAS u32x4*)(kl + 8) = kw1;
              LAS bf16* ktp = KT + (16 * c8) * 72 + row; float kx[16]; unpack8(kw0, kx); unpack8(kw1, kx + 8); const float eglr = __expf(gl - gcr);
#pragma unroll
              for (int e = 0; e < 16; ++e) ktp[e * 72] = f2bf(kx[e] * eglr); }
            { LAS bf16* vl = VB + row * 136 + 16 * c8; *(LAS u32x4*)vl = vw0; *(LAS u32x4*)(vl + 8) = vw1; }
            { float x[16]; conv16_fin(rawq, t, CWQ, 16 * c8, x); float ss = 0.f;
#pragma unroll
              for (int e = 0; e < 16; ++e) ss += x[e] * x[e];
              ss += __shfl_xor(ss, 1); ss += __shfl_xor(ss, 2); ss += __shfl_xor(ss, 4);
              const float rn = __builtin_amdgcn_rsqf(ss + EPS) * 0.08838834764831845f;
#pragma unroll
              for (int e = 0; e < 16; ++e) x[e] *= rn;
              LAS bf16* ql = QN + row * 136 + 16 * c8; *(LAS u32x4*)ql = pack8(x); *(LAS u32x4*)(ql + 8) = pack8(x + 8); }
            if (tid < 64) { GC[tid] = gcv; COEF[tid] = betav * __expf(gcv); EG[tid] = __expf(gcv); }
            const float egl_last = __expf(gl);
            __syncthreads(); RELAUNDER();
#pragma nounroll
            for (int st = 0; st < 4; ++st) { f32x4 D = {0.f, 0.f, 0.f, 0.f};
#pragma unroll
                for (int ks = 0; ks < 4; ++ks) { const bf16x8 A = *(const LAS bf16x8*)(STB + (16 * wave + l15) * 136 + 32 * ks + 8 * kq), B = *(const LAS bf16x8*)(KN + (16 * st + l15) * 136 + 32 * ks + 8 * kq); D = MFMA16(A, B, D); }
                const int s = 16 * st + l15; const float coef = COEF[s];
#pragma unroll
                for (int e = 0; e < 4; ++e) { const int dv = 16 * wave + 4 * kq + e; RT[dv * 72 + s] = f2bf(bf2f(VB[s * 136 + dv]) - coef * D[e]); } __builtin_amdgcn_sched_barrier(0); }
            f32x4 Oa[4];
#pragma unroll
            for (int ct = 0; ct < 4; ++ct) { f32x4 D = {0.f, 0.f, 0.f, 0.f};
#pragma unroll
                for (int ks = 0; ks < 4; ++ks) { const bf16x8 A = *(const LAS bf16x8*)(QN + (16 * ct + l15) * 136 + 32 * ks + 8 * kq), B = *(const LAS bf16x8*)(STB + (16 * wave + l15) * 136 + 32 * ks + 8 * kq); D = MFMA16(A, B, D); }
#pragma unroll
                for (int e = 0; e < 4; ++e) D[e] *= EG[16 * ct + 4 * kq + e];
                Oa[ct] = D; __builtin_amdgcn_sched_barrier(0); }
            __syncthreads(); RELAUNDER();
#pragma nounroll
            for (int ct = 0; ct < 4; ++ct) { f32x4 D = {0.f, 0.f, 0.f, 0.f};
#pragma unroll
                for (int ks = 0; ks < 2; ++ks) { const bf16x8 A = *(const LAS bf16x8*)(RT + (16 * wave + l15) * 72 + 32 * ks + 8 * kq), B = *(const LAS bf16x8*)(TM + (16 * ct + l15) * 72 + 32 * ks + 8 * kq); D = MFMA16(A, B, D); }
                const int c = 16 * ct + l15;
#pragma unroll
                for (int e = 0; e < 4; ++e) { const int dv = 16 * wave + 4 * kq + e; VNT[dv * 72 + c] = f2bf(D[e]); } __builtin_amdgcn_sched_barrier(0); }
#pragma unroll
            for (int ti = 0; ti < 2; ++ti) { const int id = 2 * wave + ti, ct = id >> 2, st = id & 3; f32x4 D = {0.f, 0.f, 0.f, 0.f};
                if (st <= ct) {
#pragma unroll
                    for (int ks = 0; ks < 4; ++ks) { const bf16x8 A = *(const LAS bf16x8*)(QN + (16 * ct + l15) * 136 + 32 * ks + 8 * kq), B = *(const LAS bf16x8*)(KN + (16 * st + l15) * 136 + 32 * ks + 8 * kq); D = MFMA16(A, B, D); }
                }
                const int s = 16 * st + l15; const float gs = GC[s];
#pragma unroll
                for (int e = 0; e < 4; ++e) { const int c = 16 * ct + 4 * kq + e; QKB[c * 72 + s] = (c >= s) ? f2bf(D[e] * __expf(GC[c] - gs)) : (bf16)0; } __builtin_amdgcn_sched_barrier(0); }
            __syncthreads(); RELAUNDER();
            { LAS bf16* zl = ZL + row * 136 + 16 * c8; *(LAS u32x4*)zl = zw0; *(LAS u32x4*)(zl + 8) = zw1; }
#pragma unroll
            for (int ct = 0; ct < 4; ++ct) {
#pragma unroll
                for (int ks = 0; ks < 2; ++ks) { const bf16x8 A = *(const LAS bf16x8*)(QKB + (16 * ct + l15) * 72 + 32 * ks + 8 * kq), B = *(const LAS bf16x8*)(VNT + (16 * wave + l15) * 72 + 32 * ks + 8 * kq); Oa[ct] = MFMA16(A, B, Oa[ct]); }
#pragma unroll
                for (int e = 0; e < 4; ++e) { float q2 = Oa[ct][e] * Oa[ct][e]; q2 += __shfl_xor(q2, 1); q2 += __shfl_xor(q2, 2); q2 += __shfl_xor(q2, 4); q2 += __shfl_xor(q2, 8);
                    if (l15 == 0) ONP[(16 * ct + 4 * kq + e) * 8 + wave] = q2; } __builtin_amdgcn_sched_barrier(0); }
#pragma unroll
            for (int dkt = 0; dkt < 8; ++dkt) { f32x4 D = St[dkt] * egl_last;
#pragma unroll
                for (int ks = 0; ks < 2; ++ks) { const bf16x8 A = *(const LAS bf16x8*)(VNT + (16 * wave + l15) * 72 + 32 * ks + 8 * kq), B = *(const LAS bf16x8*)(KT + (16 * dkt + l15) * 72 + 32 * ks + 8 * kq); D = MFMA16(A, B, D); }
                St[dkt] = D;
#pragma unroll
                for (int e = 0; e < 4; ++e) STB[(16 * wave + 4 * kq + e) * 136 + 16 * dkt + l15] = f2bf(D[e]); __builtin_amdgcn_sched_barrier(0); }
            __syncthreads(); RELAUNDER();
#pragma unroll
            for (int ct = 0; ct < 4; ++ct) {
#pragma unroll
                for (int e = 0; e < 4; ++e) { const int c = 16 * ct + 4 * kq + e;
                    const f32x4 pa = *(const LAS f32x4*)(ONP + c * 8), pb = *(const LAS f32x4*)(ONP + c * 8 + 4);
                    const float tot = ((pa[0] + pa[1]) + (pa[2] + pa[3])) + ((pb[0] + pb[1]) + (pb[2] + pb[3]));
                    const float rstd = __builtin_amdgcn_rsqf(tot * (1.0f / 128.0f) + EPS); const int dv = 16 * wave + l15;
                    const float z = bf2f(ZL[c * 136 + dv]);
#if defined(DBG_Q) && DBG_Q == 1
                    Y[(rb + t0 + c) * 1024 + h * 128 + dv] = f2bf(Oa[ct][e] * 64.f + 0.f * rstd * z); }
#elif defined(DBG_Q) && DBG_Q == 2
                    Y[(rb + t0 + c) * 1024 + h * 128 + dv] = f2bf(bf2f(VNT[dv * 72 + c]) * 64.f + 0.f * rstd * z); }
#elif defined(DBG_Q) && DBG_Q == 5
                    Y[(rb + t0 + c) * 1024 + h * 128 + dv] = f2bf(bf2f(RT[dv * 72 + c]) * 64.f + 0.f * rstd * z); }
#elif defined(DBG_Q) && DBG_Q == 3
                    Y[(rb + t0 + c) * 1024 + h * 128 + dv] = f2bf(bf2f(QK[c * 72 + (dv & 63)]) * 64.f + 0.f * rstd * z); }
#elif defined(DBG_Q) && DBG_Q == 4
                    Y[(rb + t0 + c) * 1024 + h * 128 + dv] = f2bf(bf2f(TM[c * 72 + (dv & 63)]) * 64.f + 0.f * rstd * z); }
#else
                    Y[(rb + t0 + c) * 1024 + h * 128 + dv] = f2bf(Oa[ct][e] * rstd * ongv * siluf_(z)); }
#endif
                __builtin_amdgcn_sched_barrier(0); }
            RELAUNDER();
        }
        __syncthreads();
    }
}
#undef RELAUNDER

#if defined(DBG_TS)
#define STAMP(k) do { if (blockIdx.x == 0 && tid == 0) ((volatile unsigned long long*)(ws + WS_BAR + 65536))[(k)] = __builtin_amdgcn_s_memrealtime(); } while (0)
#else
#define STAMP(k) do {} while (0)
#endif
#ifndef REP1
#define REP1 1
#endif
#ifndef REP0
#define REP0 1
#endif
#ifndef REP2
#define REP2 1
#endif
#ifndef REP3
#define REP3 1
#endif
#ifndef REP4
#define REP4 1
#endif
#ifndef REP10
#define REP10 1
#endif
#if defined(DBG_CUT)
#define DBGCUT(k, ptr, pitch, coloff) do { if ((k) == DBG_CUT) { asm volatile("s_waitcnt vmcnt(0) lgkmcnt(0)" ::: "memory"); cg::this_grid().sync(); \
        const bf16* src_ = (const bf16*)(ptr); float* dst_ = a.out; \
        for (size_t i_ = (size_t)blockIdx.x * 512 + tid; i_ < (size_t)M * 1024; i_ += (size_t)gridDim.x * 512) { const size_t r_ = i_ >> 10, c_ = i_ & 1023; dst_[i_] = bf2f(src_[r_ * (pitch) + (coloff) + c_]); } \
        return; } } while (0)
#else
#define DBGCUT(k, ptr, pitch, coloff) do {} while (0)
#endif
__global__ void __launch_bounds__(512, 2) mega(Args a_unused) {
    extern __shared__ __attribute__((aligned(16))) unsigned char lds_raw[];
    LAS unsigned char* lds = (LAS unsigned char*)lds_raw;
    int tid = threadIdx.x;
    volatile LAS unsigned* xb_st = (volatile LAS unsigned*)(lds + LDS_BYTES - 64);
    if (tid < 16) xb_st[tid] = 0u;
    __syncthreads();
    XcdBarrier bar = xcd_barrier_post((unsigned*)(((CArgs*)__builtin_amdgcn_kernarg_segment_ptr())->ws + WS_BAR), xb_st);
    CArgs* ap = (CArgs*)__builtin_amdgcn_kernarg_segment_ptr();
#define a (*launder_args(ap))
#define ws (a.ws)
#define rsq ((float*)(ws + WS_RSQ))
    const int lo = a.ph_lo, hi = a.ph_hi;
#ifndef PHMASK
#define PHMASK 0xFFFFFFFFu
#endif
#define IN(k) (((PHMASK >> ((k) > 11 ? (k) - 7 : (k))) & 1u) && lo <= (k) && (k) < hi)
#define SEAM(k) do { if (IN(k) && IN((k) + 1)) { if (a.pad == 0x5EED) { cg::this_grid().sync(); }     \
        xcd_barrier(bar); } } while (0)
#define GEMM(EpiT, Aptr, Bptr, N_, K_, ...) do { int k_ = (K_); asm volatile("" : "+s"(k_)); pg8::Gemm g{(const pg8::bf16_t*)(Aptr), (const pg8::bf16_t*)(Bptr), M, (N_), k_}; pg8::StaticOrder S; S.init(M, (N_), (int)gridDim.x, (int)blockIdx.x); \
        pg8::EpiT E{__VA_ARGS__}; pg8::gemm_phase<pg8::EpiT, pg8::StaticOrder, pg8::EpiT::ALIGN, true>(lds, g, S, E, tid); } while (0)
    asm volatile("; ==== PHASE 0" : "+v"(tid)); STAMP(0); if (IN(0)) { for (int rep_ = 0; rep_ < REP0; ++rep_) prologue(a, lds, tid); } SEAM(0);
    asm volatile("; ==== PHASE 1" : "+v"(tid)); STAMP(1); if (IN(1)) { for (int rep_ = 0; rep_ < REP1; ++rep_) GEMM(EpiZ, ws + WS_HBB, ws + W_EVIN, EV_NP, 1024, (pg8::bf16_t*)(ws + WS_Z), EV_NP, rsq); } SEAM(1); DBGCUT(1, ws + WS_Z, EV_NP, DBG_COL);
    asm volatile("; ==== PHASE 2" : "+v"(tid)); STAMP(2); if (IN(2)) { for (int rep_ = 0; rep_ < REP2; ++rep_) even_post(a, lds, tid); } SEAM(2); DBGCUT(2, ws + WS_QI, 512, 0);
    asm volatile("; ==== PHASE 3" : "+v"(tid)); STAMP(3); if (IN(3)) { for (int rep_ = 0; rep_ < REP3; ++rep_) idx_phase(lds, (const bf16*)(ws + WS_QI), (const bf16*)(ws + WS_KI), (const float*)(ws + WS_WI), (u64*)(ws + WS_MASK), tid); } SEAM(3);
    asm volatile("; ==== PHASE 4" : "+v"(tid)); STAMP(4); if (IN(4)) { for (int rep_ = 0; rep_ < REP4; ++rep_) attn_phase(lds, (const bf16*)(ws + WS_QP), (const bf16*)(ws + WS_KP), (const bf16*)(ws + WS_Z), (const u64*)(ws + WS_MASK), (bf16*)(ws + WS_Y), tid); } SEAM(4); DBGCUT(4, ws + WS_Y, 1024, 0);
    for (int l = 0; l < 2; ++l) {
        const int pb = 5 + 7 * l;
        bf16* hb1 = (bf16*)(ws + (l == 0 ? WS_HBA : WS_HBB)); bf16* hb2 = (bf16*)(ws + (l == 0 ? WS_HBB : WS_HBA));
        float* rs1 = rsq + (size_t)(1 + 3 * l) * M; float* rs2 = rs1 + M; float* rs3 = rs2 + M; float* rsE = rsq + (size_t)(6 + l) * M;
        asm volatile("; ==== PHASE pb" : "+v"(tid)); STAMP(pb); if (IN(pb)) { convert_p((const float*)a.in[1] + (size_t)l * M * 256, (bf16*)(ws + WS_PB), tid);
            GEMM(EpiResB, ws + WS_Y, ws + (l == 0 ? W_EVOUT : W_ODOUT), 1024, 1024, (l == 0 ? (const float*)a.in[0] : (const float*)nullptr), (const pg8::bf16_t*)(l == 0 ? nullptr : hb2), (pg8::bf16_t*)hb1, rs1); } SEAM(pb);
        asm volatile("; ==== PHASE pb1" : "+v"(tid)); STAMP(pb + 1); if (IN(pb + 1)) {
#ifndef NO_SWIGLU
 GEMM(EpiSwiGLU, hb1, ws + W_GU + (size_t)l * 2 * DFF * 1024 * 2, 2 * DFF, 1024, (pg8::bf16_t*)(ws + WS_HID), rs1);
#endif
#ifndef NO_ERAW
            GEMM(EpiEraw, ws + WS_PB, ws + W_PJ + (size_t)l * 256 * 1024 * 2, 1024, 256, (pg8::bf16_t*)(ws + WS_ERAW), rsE);
#endif
 } SEAM(pb + 1);
        asm volatile("; ==== PHASE pb2" : "+v"(tid)); STAMP(pb + 2); if (IN(pb + 2)) { GEMM(EpiResB, ws + WS_HID, ws + W_DN + (size_t)l * DFF * 1024 * 2, 1024, DFF, (const float*)nullptr, (const pg8::bf16_t*)hb1, (pg8::bf16_t*)hb2, rs2); } SEAM(pb + 2);
        asm volatile("; ==== PHASE pb3" : "+v"(tid)); STAMP(pb + 3); if (IN(pb + 3)) { GEMM(EpiPleB, hb2, ws + W_PG + (size_t)l * 1024 * 1024 * 2, 1024, 1024, (const pg8::bf16_t*)hb2, (l == 0 ? (float*)nullptr : a.out), (pg8::bf16_t*)(l == 0 ? hb1 : nullptr), (l == 0 ? rs3 : nullptr),
                               (const pg8::bf16_t*)(ws + WS_ERAW), rsE, rs2, (const float*)a.in[22] + l * 1024); } SEAM(pb + 3);
        if (l == 0) {
            asm volatile("; ==== PHASE 9" : "+v"(tid)); STAMP(9); if (IN(9)) { GEMM(EpiZ, hb1, ws + W_ODIN, OD_NP, 1024, (pg8::bf16_t*)(ws + WS_Z), OD_NP, rs3); } SEAM(9); DBGCUT(9, ws + WS_Z, OD_NP, DBG_COL);
            asm volatile("; ==== PHASE 10" : "+v"(tid)); STAMP(10); if (IN(10)) { for (int rep_ = 0; rep_ < REP10; ++rep_) dn_prep(a, lds, tid); } SEAM(10);
#if defined(DBG_CUT) && DBG_CUT == 10
            { asm volatile("s_waitcnt vmcnt(0) lgkmcnt(0)" ::: "memory"); cg::this_grid().sync();
              const bf16* s1_ = (const bf16*)(ws + WS_KPD); const bf16* s2_ = (const bf16*)(ws + WS_VBD); const float* s3_ = (const float*)(ws + WS_GCUM); float* dst_ = a.out;
              for (size_t i_ = (size_t)blockIdx.x * 512 + tid; i_ < (size_t)M * 1024; i_ += (size_t)gridDim.x * 512) dst_[i_] = bf2f(s1_[i_]) + 3.f * bf2f(s2_[i_]) + (i_ < (size_t)M * 16 ? s3_[i_] : 0.f);
              return; }
#endif
            asm volatile("; ==== PHASE 11" : "+v"(tid)); STAMP(11); if (IN(11)) { dn_scan(a, lds, tid); } SEAM(11); DBGCUT(11, ws + WS_Y, 1024, 0);
        }
    }
#if defined(DBG_TS)
    xcd_barrier(bar); STAMP(16);
    asm volatile("s_waitcnt vmcnt(0)" ::: "memory"); xcd_barrier(bar);
    { const volatile unsigned long long* ts_ = (const volatile unsigned long long*)(ws + WS_BAR + 65536);
      const float val_ = (float)(long long)(__hip_atomic_load((const unsigned long long*)ts_ + DBG_TS + 1, __ATOMIC_RELAXED, __HIP_MEMORY_SCOPE_AGENT) - __hip_atomic_load((const unsigned long long*)ts_ + DBG_TS, __ATOMIC_RELAXED, __HIP_MEMORY_SCOPE_AGENT)) * 0.01f;
      const float valq_ = 32.f * __builtin_rintf(val_ * (1.f / 32.f));
      float* dst_ = a.out; for (size_t i_ = (size_t)blockIdx.x * 512 + tid; i_ < (size_t)M * 1024; i_ += (size_t)gridDim.x * 512) dst_[i_] = valq_; }
#endif
#undef IN
#undef SEAM
#undef GEMM
#undef a
#undef ws
#undef rsq
}

extern "C" void kernel_launch(void* const* d_in, const int* in_sizes, int n_in, void* d_out, int out_size, void* d_ws, size_t ws_size, hipStream_t stream) {
    static int grid = 0;
    if (grid == 0) {
        if (n_in != 25 || out_size != M * DM || ws_size < WS_END) { fprintf(stderr, "kernel_launch: unexpected problem (n_in %d, out %d, ws %zu)\n", n_in, out_size, ws_size); grid = -1; return; }
        int dev = 0, cus = 0, per_cu = 0;
        hipGetDevice(&dev); hipDeviceGetAttribute(&cus, hipDeviceAttributeMultiprocessorCount, dev);
        hipFuncSetAttribute((const void*)mega, hipFuncAttributeMaxDynamicSharedMemorySize, LDS_BYTES);
        hipOccupancyMaxActiveBlocksPerMultiprocessor(&per_cu, (const void*)mega, 512, LDS_BYTES);
        (void)hipGetLastError();
        if (per_cu < 1) { fprintf(stderr, "kernel_launch: occupancy query says %d blocks per CU\n", per_cu); per_cu = 1; }
        grid = cus;
        if (grid > 256) grid = 256;
    }
    if (grid < 0) return;
    Args a{};
    for (int i = 0; i < 25; ++i) a.in[i] = d_in[i];
    a.out = (float*)d_out; a.ws = (unsigned char*)d_ws; a.ph_lo = 0; a.ph_hi = NPH; a.coop = 1; a.pad = 0;
    if (hipMemsetAsync((char*)d_ws + WS_BAR, 0, 16384, stream) != hipSuccess) { fprintf(stderr, "kernel_launch: memset failed\n"); return; }
#if defined(MK_MULTI)
    for (int p = 0; p < NPH; ++p) { a.ph_lo = p; a.ph_hi = p + 1; hipLaunchKernelGGL(mega, dim3(grid), dim3(512), LDS_BYTES, stream, a); }
#else
    void* args[] = {&a};
    hipError_t e = hipLaunchCooperativeKernel((const void*)mega, dim3(grid), dim3(512), args, LDS_BYTES, stream);
    if (e != hipSuccess) fprintf(stderr, "kernel_launch: cooperative launch failed: %s (grid %d)\n", hipGetErrorString(e), grid);
#endif
}
```

```cpp
#include <hip/hip_runtime.h>
#include <hip/hip_cooperative_groups.h>
#include <cstdio>
#include <cstdint>
#include <cstddef>
namespace cg = cooperative_groups;
namespace pg8 {
#define PG8_LAS __attribute__((address_space(3)))
typedef unsigned short bf16_t;
typedef short bf16x8 __attribute__((ext_vector_type(8)));
typedef float f32x4 __attribute__((ext_vector_type(4)));
typedef unsigned u32x4 __attribute__((ext_vector_type(4)));
constexpr int BM = 256, BK = 64, HALF = 128, HTB = HALF * BK * 2  , STAGE_BYTES = 8 * HTB, NXCD = 8, WGM = 8;

__host__ __device__ __forceinline__ int lds_byte(int r, int c) { const int st = (r >> 4) * 2 + (c >> 5), rr = r & 15, cc = c & 31, ob = rr * 64 + cc * 2; return st * 1024 + (ob ^ (((ob >> 9) & 1) << 5)); }
__host__ __device__ __forceinline__ void stage_rc(int b, int& R, int& C) { const int st = b / 1024, sb = b % 1024, swz = sb ^ (((sb >> 9) & 1) << 5); R = (st >> 1) * 16 + swz / 64; C = (st & 1) * 32 + (swz % 64) / 2; }
__host__ __device__ __forceinline__ int perm32(int rho) { const int n = rho >> 4, i = rho & 15; return 8 * (i >> 2) + 4 * n + (i & 3); }

struct Unit { int pm, pn; };
struct Gemm { const bf16_t* A; const bf16_t* Bt; int M, N, K; };

struct StaticOrder {
    int nM, nN, nwg, G, c;
    __host__ __device__ void init(int M, int N, int G_, int c_) { nM = M / BM; nN = N / BM; nwg = nM * nN; G = G_; c = c_; }
    __host__ __device__ bool next(int i, Unit& u) const {
        const long L = (long)i * G + c; if (L >= nwg) return false;
        int wgid = (int)L; { const int q = nwg / NXCD, r = nwg % NXCD, xcd = wgid % NXCD, off = wgid / NXCD; wgid = (xcd < r ? xcd * (q + 1) : r * (q + 1) + (xcd - r) * q) + off; }
        const int nig = WGM * nN, gid = wgid / nig, fm = gid * WGM, gsz = (nM - fm) < WGM ? (nM - fm) : WGM;
        u.pm = fm + ((wgid % nig) % gsz); u.pn = (wgid % nig) / gsz; return true;
    }
    __device__ __forceinline__ void a_ready(const Unit&) const {}
    __device__ __forceinline__ void done(const Unit&) const {}
};
typedef float f32x2cv __attribute__((ext_vector_type(2))); typedef __bf16 bf16x2cv __attribute__((ext_vector_type(2)));
__device__ __forceinline__ unsigned cvt_pk_bf16(float lo, float hi) { const f32x2cv v = {lo, hi}; const bf16x2cv b = __builtin_convertvector(v, bf16x2cv); return __builtin_bit_cast(unsigned, b); }
typedef unsigned u32x4e __attribute__((ext_vector_type(4)));
typedef unsigned u32x2e __attribute__((ext_vector_type(2)));
constexpr float NORM_EPS = 1e-6f;
__device__ __forceinline__ float rstd_of(const float* rowsq, int row) { return __builtin_amdgcn_rsqf(rowsq[row] * (1.0f / 1024.0f) + NORM_EPS); }
struct EpiZ {
    static constexpr bool PERM = true, AFTER_DRAIN = false, ALIGN = true;
    bf16_t* O; int ldc; const float* rowsq;
    __device__ __forceinline__ void operator()(const f32x4 (&acc)[2][2][4][2], const Unit& u, int wr, int wc, int fr, int fq) const {
        const int row0 = u.pm * BM + wr * 64 + fr, col0 = u.pn * BM + wc * 32 + 8 * fq;
        float rs8[8];
#pragma unroll
        for (int i = 0; i < 8; ++i) rs8[i] = rowsq[row0 + (i >> 2) * HALF + (i & 3) * 16];
#pragma unroll
        for (int i = 0; i < 8; ++i) rs8[i] = __builtin_amdgcn_rsqf(rs8[i] * (1.0f / 1024.0f) + NORM_EPS);
#pragma unroll
        for (int ai = 0; ai < 2; ++ai)
#pragma unroll
            for (int m = 0; m < 4; ++m) { const int row = row0 + ai * HALF + m * 16; const float rs = rs8[ai * 4 + m]; bf16_t* rowp = O + (size_t)row * ldc + col0;
#pragma unroll
                for (int bj = 0; bj < 2; ++bj) { const f32x4 v0 = acc[ai][bj][m][0] * rs, v1 = acc[ai][bj][m][1] * rs;
                    u32x4e w; w.x = cvt_pk_bf16(v0[0], v0[1]); w.y = cvt_pk_bf16(v0[2], v0[3]); w.z = cvt_pk_bf16(v1[0], v1[1]); w.w = cvt_pk_bf16(v1[2], v1[3]);
                    *(u32x4e*)(rowp + bj * HALF) = w; } }
    }
};
struct EpiEraw {
    static constexpr bool PERM = true, AFTER_DRAIN = false, ALIGN = true;
    bf16_t* O; float* rowsq;
    __device__ __forceinline__ void operator()(const f32x4 (&acc)[2][2][4][2], const Unit& u, int wr, int wc, int fr, int fq) const {
        const int row0 = u.pm * BM + wr * 64 + fr, col0 = u.pn * BM + wc * 32 + 8 * fq;
#pragma unroll
        for (int ai = 0; ai < 2; ++ai)
#pragma unroll
            for (int m = 0; m < 4; ++m) { const int row = row0 + ai * HALF + m * 16; bf16_t* rowp = O + (size_t)row * 1024 + col0; float ss = 0.f;
#pragma unroll
                for (int bj = 0; bj < 2; ++bj) { const f32x4 v0 = acc[ai][bj][m][0], v1 = acc[ai][bj][m][1];
                    ss += (v0[0] * v0[0] + v0[1] * v0[1]) + (v0[2] * v0[2] + v0[3] * v0[3]) + (v1[0] * v1[0] + v1[1] * v1[1]) + (v1[2] * v1[2] + v1[3] * v1[3]);
                    u32x4e w; w.x = cvt_pk_bf16(v0[0], v0[1]); w.y = cvt_pk_bf16(v0[2], v0[3]); w.z = cvt_pk_bf16(v1[0], v1[1]); w.w = cvt_pk_bf16(v1[2], v1[3]);
                    *(u32x4e*)(rowp + bj * HALF) = w; }
                ss += __shfl_xor(ss, 16); ss += __shfl_xor(ss, 32);
                if (fq == 0) atomicAdd(rowsq + row, ss); asm volatile("" ::: "memory"); }
    }
};
struct EpiSwiGLU {
    static constexpr bool PERM = true, AFTER_DRAIN = false, ALIGN = true;
    bf16_t* O; const float* rowsq;
    __device__ __forceinline__ void operator()(const f32x4 (&acc)[2][2][4][2], const Unit& u, int wr, int wc, int fr, int fq) const {
        const int row0 = u.pm * BM + wr * 64 + fr, col0 = u.pn * HALF + wc * 32 + 8 * fq;
        float rs8[8];
#pragma unroll
        for (int i = 0; i < 8; ++i) rs8[i] = rowsq[row0 + (i >> 2) * HALF + (i & 3) * 16];
#pragma unroll
        for (int i = 0; i < 8; ++i) rs8[i] = __builtin_amdgcn_rsqf(rs8[i] * (1.0f / 1024.0f) + NORM_EPS);
#pragma unroll
        for (int ai = 0; ai < 2; ++ai)
#pragma unroll
            for (int m = 0; m < 4; ++m) { const int row = row0 + ai * HALF + m * 16; const float rs = rs8[ai * 4 + m]; float h[8];
#pragma unroll
                for (int n = 0; n < 2; ++n)
#pragma unroll
                    for (int e2 = 0; e2 < 4; ++e2) { const float g = acc[ai][0][m][n][e2] * rs, up = acc[ai][1][m][n][e2] * rs;
                        h[4 * n + e2] = g * __builtin_amdgcn_rcpf(1.0f + __builtin_amdgcn_exp2f(-1.4426950408889634f * g)) * up; }
                u32x4e w; w.x = cvt_pk_bf16(h[0], h[1]); w.y = cvt_pk_bf16(h[2], h[3]); w.z = cvt_pk_bf16(h[4], h[5]); w.w = cvt_pk_bf16(h[6], h[7]);
                *(u32x4e*)(O + (size_t)row * 2816 + col0) = w; }
    }
};
struct EpiRes {
    static constexpr bool PERM = false, AFTER_DRAIN = false, ALIGN = true;
    const float* base; float* out; bf16_t* hb; float* rowsq;
    __device__ __forceinline__ void operator()(const f32x4 (&acc)[2][2][4][2], const Unit& u, int wr, int wc, int fr, int fq) const {
        const int row0 = u.pm * BM + wr * 64 + fr, col0 = u.pn * BM + wc * 32 + 4 * fq;
#pragma unroll
        for (int ai = 0; ai < 2; ++ai)
#pragma unroll
            for (int m = 0; m < 4; ++m) { const int row = row0 + ai * HALF + m * 16; const size_t off = (size_t)row * 1024 + col0; float ss = 0.f;
#pragma unroll
                for (int bj = 0; bj < 2; ++bj)
#pragma unroll
                    for (int n = 0; n < 2; ++n) { const size_t o2 = off + bj * HALF + n * 16; const f32x4 o = *(const f32x4*)(base + o2) + acc[ai][bj][m][n];
                        *(f32x4*)(out + o2) = o; u32x2e w; w.x = cvt_pk_bf16(o[0], o[1]); w.y = cvt_pk_bf16(o[2], o[3]); *(u32x2e*)(hb + o2) = w;
                        ss += (o[0] * o[0] + o[1] * o[1]) + (o[2] * o[2] + o[3] * o[3]); }
                ss += __shfl_xor(ss, 16); ss += __shfl_xor(ss, 32);
                if (fq == 0) atomicAdd(rowsq + row, ss); asm volatile("" ::: "memory"); }
    }
};
struct EpiPle {
    static constexpr bool PERM = false, AFTER_DRAIN = false, ALIGN = true;
    const float* base; float* out; bf16_t* hb; float* rowsq_out; const bf16_t* eraw; const float* rowsqE; const float* rowsqH; const float* postg;
    __device__ __forceinline__ void operator()(const f32x4 (&acc)[2][2][4][2], const Unit& u, int wr, int wc, int fr, int fq) const {
        const int row0 = u.pm * BM + wr * 64 + fr, col0 = u.pn * BM + wc * 32 + 4 * fq;
#pragma unroll
        for (int ai = 0; ai < 2; ++ai)
#pragma unroll
            for (int m = 0; m < 4; ++m) { const int row = row0 + ai * HALF + m * 16; const size_t off = (size_t)row * 1024 + col0; float ss = 0.f;
                const float rsE = rstd_of(rowsqE, row), rsH = rstd_of(rowsqH, row);
#pragma unroll
                for (int bj = 0; bj < 2; ++bj)
#pragma unroll
                    for (int n = 0; n < 2; ++n) { const size_t o2 = off + bj * HALF + n * 16; const int c2 = col0 + bj * HALF + n * 16;
                        const u32x2e ew = *(const u32x2e*)(eraw + o2); const f32x4 pg = *(const f32x4*)(postg + c2); const f32x4 b = *(const f32x4*)(base + o2);
                        float ev[4] = {__uint_as_float(ew.x << 16), __uint_as_float(ew.x & 0xffff0000u), __uint_as_float(ew.y << 16), __uint_as_float(ew.y & 0xffff0000u)};
                        f32x4 o;
#pragma unroll
                        for (int e = 0; e < 4; ++e) { const float gt = __builtin_amdgcn_rcpf(1.0f + __builtin_amdgcn_exp2f(-1.4426950408889634f * acc[ai][bj][m][n][e] * rsH)); o[e] = b[e] + ev[e] * rsE * pg[e] * gt; }
                        *(f32x4*)(out + o2) = o;
                        if (hb) { u32x2e w; w.x = cvt_pk_bf16(o[0], o[1]); w.y = cvt_pk_bf16(o[2], o[3]); *(u32x2e*)(hb + o2) = w; }
                        ss += (o[0] * o[0] + o[1] * o[1]) + (o[2] * o[2] + o[3] * o[3]); }
                if (rowsq_out) { ss += __shfl_xor(ss, 16); ss += __shfl_xor(ss, 32); if (fq == 0) atomicAdd(rowsq_out + row, ss); } asm volatile("" ::: "memory"); }
    }
};

__device__ __forceinline__ void unpack8e(const u32x4e w, float* v) {
    v[0] = __uint_as_float(w.x << 16); v[1] = __uint_as_float(w.x & 0xffff0000u); v[2] = __uint_as_float(w.y << 16); v[3] = __uint_as_float(w.y & 0xffff0000u);
    v[4] = __uint_as_float(w.z << 16); v[5] = __uint_as_float(w.z & 0xffff0000u); v[6] = __uint_as_float(w.w << 16); v[7] = __uint_as_float(w.w & 0xffff0000u); }
struct EpiResB {
    static constexpr bool PERM = true, AFTER_DRAIN = false, ALIGN = true;
    const float* basef; const bf16_t* baseb; bf16_t* hb; float* rowsq;
    __device__ __forceinline__ void operator()(const f32x4 (&acc)[2][2][4][2], const Unit& u, int wr, int wc, int fr, int fq) const {
        const int row0 = u.pm * BM + wr * 64 + fr, col0 = u.pn * BM + wc * 32 + 8 * fq;
#pragma unroll
        for (int ai = 0; ai < 2; ++ai) {
            u32x4e bw[4][2];
            if (!basef) {
#pragma unroll
                for (int m = 0; m < 4; ++m)
#pragma unroll
                    for (int bj = 0; bj < 2; ++bj) bw[m][bj] = *(const u32x4e*)(baseb + (size_t)(row0 + ai * HALF + m * 16) * 1024 + col0 + bj * HALF); }
#pragma unroll
            for (int m = 0; m < 4; ++m) { const int row = row0 + ai * HALF + m * 16; const size_t off = (size_t)row * 1024 + col0; float ss = 0.f;
#pragma unroll
                for (int bj = 0; bj < 2; ++bj) { const size_t o2 = off + bj * HALF; float b[8];
                    if (basef) { const f32x4 b0 = *(const f32x4*)(basef + o2), b1 = *(const f32x4*)(basef + o2 + 4); b[0] = b0[0]; b[1] = b0[1]; b[2] = b0[2]; b[3] = b0[3]; b[4] = b1[0]; b[5] = b1[1]; b[6] = b1[2]; b[7] = b1[3]; }
                    else unpack8e(bw[m][bj], b);
#pragma unroll
                    for (int n = 0; n < 2; ++n)
#pragma unroll
                        for (int e2 = 0; e2 < 4; ++e2) { b[4 * n + e2] += acc[ai][bj][m][n][e2]; ss += b[4 * n + e2] * b[4 * n + e2]; }
                    u32x4e w; w.x = cvt_pk_bf16(b[0], b[1]); w.y = cvt_pk_bf16(b[2], b[3]); w.z = cvt_pk_bf16(b[4], b[5]); w.w = cvt_pk_bf16(b[6], b[7]);
                    *(u32x4e*)(hb + o2) = w; }
                ss += __shfl_xor(ss, 16); ss += __shfl_xor(ss, 32);
                if (fq == 0) atomicAdd(rowsq + row, ss); }
        }
    }
};
struct EpiPleB {
    static constexpr bool PERM = true, AFTER_DRAIN = false, ALIGN = true;
    const bf16_t* baseb; float* outf; bf16_t* hb; float* rowsq_out; const bf16_t* eraw; const float* rowsqE; const float* rowsqH; const float* postg;
    __device__ __forceinline__ void operator()(const f32x4 (&acc)[2][2][4][2], const Unit& u, int wr, int wc, int fr, int fq) const {
        const int row0 = u.pm * BM + wr * 64 + fr, col0 = u.pn * BM + wc * 32 + 8 * fq;
        float rsE8[8], rsH8[8];
#pragma unroll
        for (int i = 0; i < 8; ++i) { const int row = row0 + (i >> 2) * HALF + (i & 3) * 16; rsE8[i] = rowsqE[row]; rsH8[i] = rowsqH[row]; }
        f32x4 pg[2][2];
#pragma unroll
        for (int bj = 0; bj < 2; ++bj) { pg[bj][0] = *(const f32x4*)(postg + col0 + bj * HALF); pg[bj][1] = *(const f32x4*)(postg + col0 + bj * HALF + 4); }
#pragma unroll
        for (int i = 0; i < 8; ++i) { rsE8[i] = __builtin_amdgcn_rsqf(rsE8[i] * (1.0f / 1024.0f) + NORM_EPS); rsH8[i] = __builtin_amdgcn_rsqf(rsH8[i] * (1.0f / 1024.0f) + NORM_EPS); }
#pragma unroll
        for (int ai = 0; ai < 2; ++ai)
#pragma unroll
            for (int mp = 0; mp < 2; ++mp) {
                u32x4e bw[2][2], ew[2][2];
#pragma unroll
                for (int mm = 0; mm < 2; ++mm)
#pragma unroll
                    for (int bj = 0; bj < 2; ++bj) { const size_t o2 = (size_t)(row0 + ai * HALF + (2 * mp + mm) * 16) * 1024 + col0 + bj * HALF; bw[mm][bj] = *(const u32x4e*)(baseb + o2); ew[mm][bj] = *(const u32x4e*)(eraw + o2); }
#pragma unroll
                for (int mm = 0; mm < 2; ++mm) { const int m = 2 * mp + mm; const int row = row0 + ai * HALF + m * 16; const size_t off = (size_t)row * 1024 + col0; float ss = 0.f;
                    const float rsE = rsE8[ai * 4 + m], rsH = rsH8[ai * 4 + m];
#pragma unroll
                    for (int bj = 0; bj < 2; ++bj) { const size_t o2 = off + bj * HALF; float b[8], ev[8];
                        unpack8e(bw[mm][bj], b); unpack8e(ew[mm][bj], ev);
#pragma unroll
                        for (int n = 0; n < 2; ++n)
#pragma unroll
                            for (int e2 = 0; e2 < 4; ++e2) { const int i8 = 4 * n + e2; const float gt = __builtin_amdgcn_rcpf(1.0f + __builtin_amdgcn_exp2f(-1.4426950408889634f * acc[ai][bj][m][n][e2] * rsH));
                                b[i8] += ev[i8] * rsE * pg[bj][n][e2] * gt; ss += b[i8] * b[i8]; }
                        if (outf) { *(f32x4*)(outf + o2) = (f32x4){b[0], b[1], b[2], b[3]}; *(f32x4*)(outf + o2 + 4) = (f32x4){b[4], b[5], b[6], b[7]}; }
                        if (hb) { u32x4e w; w.x = cvt_pk_bf16(b[0], b[1]); w.y = cvt_pk_bf16(b[2], b[3]); w.z = cvt_pk_bf16(b[4], b[5]); w.w = cvt_pk_bf16(b[6], b[7]); *(u32x4e*)(hb + o2) = w; } }
                    if (rowsq_out) { ss += __shfl_xor(ss, 16); ss += __shfl_xor(ss, 32); if (fq == 0) atomicAdd(rowsq_out + row, ss); } }
            }
    }
};
template <class Epi, class Sched, bool ALIGN_EPI = false, bool SP2 = false>
__device__ __forceinline__ void gemm_phase(PG8_LAS unsigned char* lds, const Gemm g, const Sched& S, const Epi& E, int tid_in) {
    const int tid = tid_in, wid = __builtin_amdgcn_readfirstlane(tid >> 6), lane = tid & 63, wr = wid >> 2, wc = wid & 3, fr = lane & 15, fq = lane >> 4;
    const int K = g.K, nt = K / BK;
    unsigned voffA[2], voffB[2];
#pragma unroll
    for (int i = 0; i < 2; ++i) { int R, C; stage_rc(tid * 16 + i * 8192, R, C); const int Rb = Epi::PERM ? ((R & ~31) + perm32(R & 31)) : R;
        voffA[i] = (unsigned)(R * K + C) * 2u; voffB[i] = (unsigned)(Rb * K + C) * 2u; }
    const size_t kstep = (size_t)(BK * 2);
    const size_t hstep = (size_t)HALF * K * 2;
    const size_t tstep = 2 * hstep;
    const unsigned ldsw = (unsigned)wid * 1024u;
    const int aoff = lds_byte(wr * 64 + fr, fq * 8), boff = lds_byte(wc * 32 + fr, fq * 8);
#define PG8_SA(b, h) (((b) * 2 + (h)) * HTB)
#define PG8_SB(b, h) ((4 + (b) * 2 + (h)) * HTB)
#define PG8_STAGE(bufoff, gbase, voff) do { _Pragma("unroll") for (int _i = 0; _i < 2; ++_i) \
        __builtin_amdgcn_global_load_lds((const unsigned*)((const char*)(gbase) + (voff)[_i]), (PG8_LAS unsigned*)(lds + (bufoff) + ldsw + _i * 8192), 16, 0, 0); } while (0)
#define PG8_LDA(dst, b, h) do { _Pragma("unroll") for (int m = 0; m < 4; ++m) _Pragma("unroll") for (int k = 0; k < 2; ++k) dst[m][k] = *(const PG8_LAS bf16x8*)(lds + PG8_SA(b, h) + aoff + m * 2048 + k * 1024); } while (0)
#define PG8_LDB(dst, b, h) do { _Pragma("unroll") for (int n = 0; n < 2; ++n) _Pragma("unroll") for (int k = 0; k < 2; ++k) dst[n][k] = *(const PG8_LAS bf16x8*)(lds + PG8_SB(b, h) + boff + n * 2048 + k * 1024); } while (0)
#define PG8_MMA(ai, bj, At, Bt) do { __builtin_amdgcn_s_setprio(1); _Pragma("unroll") for (int m = 0; m < 4; ++m) _Pragma("unroll") for (int n = 0; n < 2; ++n) _Pragma("unroll") for (int k = 0; k < 2; ++k) \
        acc[ai][bj][m][n] = __builtin_amdgcn_mfma_f32_16x16x32_bf16(Bt[n][k], At[m][k], acc[ai][bj][m][n], 0, 0, 0); __builtin_amdgcn_s_setprio(0); } while (0)
#define PG8_WAIT_V(n) asm volatile("s_waitcnt vmcnt(" #n ")" ::: "memory")
#define PG8_WAIT_L(n) asm volatile("s_waitcnt lgkmcnt(" #n ")" ::: "memory")
#define PG8_BAR __builtin_amdgcn_s_barrier()
#define PG8_SCHED __builtin_amdgcn_sched_barrier(0)
    Unit cur, nxt; int ui = 0;
    if (!S.next(0, cur)) return;
    f32x4 acc[2][2][4][2];
#pragma unroll
    for (int a = 0; a < 2; ++a)
#pragma unroll
        for (int b = 0; b < 2; ++b)
#pragma unroll
            for (int m = 0; m < 4; ++m)
#pragma unroll
                for (int n = 0; n < 2; ++n) acc[a][b][m][n] = (f32x4){0.f, 0.f, 0.f, 0.f};
    bf16x8 At[4][2], B0[2][2], B1[2][2];
    const char* cA = (const char*)g.A + (size_t)cur.pm * tstep; const char* cB = (const char*)g.Bt + (size_t)cur.pn * tstep;
    S.a_ready(cur);
    if constexpr (SP2) {
        PG8_STAGE(PG8_SB(0, 0), cB, voffB); PG8_STAGE(PG8_SB(0, 1), cB + hstep, voffB); PG8_STAGE(PG8_SA(0, 0), cA, voffA); PG8_STAGE(PG8_SA(0, 1), cA + hstep, voffA);
        if (wr == 1) PG8_BAR;
        PG8_WAIT_V(2); PG8_BAR;
        PG8_STAGE(PG8_SB(1, 0), cB + kstep, voffB); PG8_STAGE(PG8_SA(1, 0), cA + kstep, voffA); PG8_STAGE(PG8_SB(1, 1), cB + hstep + kstep, voffB);
        PG8_WAIT_V(6); PG8_BAR;
    } else {
        PG8_STAGE(PG8_SB(0, 0), cB, voffB); PG8_STAGE(PG8_SA(0, 0), cA, voffA); PG8_STAGE(PG8_SB(0, 1), cB + hstep, voffB); PG8_STAGE(PG8_SA(0, 1), cA + hstep, voffA);
        if (wr == 1) PG8_BAR;
        PG8_WAIT_V(4); PG8_BAR;
        PG8_STAGE(PG8_SB(1, 0), cB + kstep, voffB); PG8_STAGE(PG8_SA(1, 0), cA + kstep, voffA); PG8_STAGE(PG8_SB(1, 1), cB + hstep + kstep, voffB);
        PG8_WAIT_V(6); PG8_BAR;
    }
    for (;;) {
        const bool has_next = S.next(ui + 1, nxt);
        const char* nA = has_next ? (const char*)g.A + (size_t)nxt.pm * tstep : cA; const char* nB = has_next ? (const char*)g.Bt + (size_t)nxt.pn * tstep : cB;
        for (int t = 0; t < nt; t += 2) {
            const bool last = (t == nt - 2);
            const char* a1 = cA + (size_t)(t + 1) * kstep;
            const char* a2 = last ? nA : cA + (size_t)(t + 2) * kstep; const char* b2 = last ? nB : cB + (size_t)(t + 2) * kstep;
            const char* a3 = a2 + kstep; const char* b3 = b2 + kstep;
            if (last && has_next) S.a_ready(nxt);
            if constexpr (SP2) {
            PG8_LDB(B0, 0, 0); PG8_LDB(B1, 0, 1); PG8_SCHED; PG8_LDA(At, 0, 0); PG8_STAGE(PG8_SA(1, 1), a1 + hstep, voffA);
            PG8_WAIT_V(8); PG8_WAIT_L(0); PG8_BAR; PG8_MMA(0, 0, At, B0); PG8_MMA(0, 1, At, B1); PG8_BAR; PG8_SCHED;
            PG8_LDA(At, 0, 1); PG8_STAGE(PG8_SB(0, 0), b2, voffB); PG8_STAGE(PG8_SB(0, 1), b2 + hstep, voffB); PG8_STAGE(PG8_SA(0, 0), a2, voffA);
            PG8_WAIT_V(8); PG8_WAIT_L(0); PG8_BAR; PG8_MMA(1, 0, At, B0); PG8_MMA(1, 1, At, B1); PG8_BAR; PG8_SCHED;
            PG8_LDB(B0, 1, 0); PG8_LDB(B1, 1, 1); PG8_SCHED; PG8_LDA(At, 1, 0); PG8_STAGE(PG8_SA(0, 1), a2 + hstep, voffA);
            PG8_WAIT_V(8); PG8_WAIT_L(0); PG8_BAR; PG8_MMA(0, 0, At, B0); PG8_MMA(0, 1, At, B1); PG8_BAR; PG8_SCHED;
            PG8_LDA(At, 1, 1); PG8_STAGE(PG8_SB(1, 0), b3, voffB); PG8_STAGE(PG8_SB(1, 1), b3 + hstep, voffB); PG8_STAGE(PG8_SA(1, 0), a3, voffA);
            PG8_WAIT_V(8); PG8_WAIT_L(0); PG8_BAR; PG8_MMA(1, 0, At, B0); PG8_MMA(1, 1, At, B1); PG8_BAR; PG8_SCHED;
            } else {
            PG8_LDB(B0, 0, 0); PG8_SCHED; PG8_LDA(At, 0, 0); PG8_STAGE(PG8_SA(1, 1), a1 + hstep, voffA);
            PG8_WAIT_L(8); PG8_BAR; PG8_WAIT_L(0); PG8_MMA(0, 0, At, B0); PG8_BAR; PG8_SCHED;
            PG8_LDB(B1, 0, 1); PG8_STAGE(PG8_SB(0, 0), b2, voffB);
            PG8_BAR; PG8_WAIT_L(0); PG8_MMA(0, 1, At, B1); PG8_BAR;
            PG8_LDA(At, 0, 1); PG8_STAGE(PG8_SA(0, 0), a2, voffA);
            PG8_BAR; PG8_WAIT_L(0); PG8_MMA(1, 0, At, B0); PG8_BAR; PG8_SCHED;
            PG8_STAGE(PG8_SB(0, 1), b2 + hstep, voffB);
            PG8_WAIT_V(6); PG8_BAR; PG8_MMA(1, 1, At, B1); PG8_BAR;
            PG8_LDB(B0, 1, 0); PG8_SCHED; PG8_LDA(At, 1, 0); PG8_STAGE(PG8_SA(0, 1), a2 + hstep, voffA);
            PG8_WAIT_L(8); PG8_BAR; PG8_WAIT_L(0); PG8_MMA(0, 0, At, B0); PG8_BAR; PG8_SCHED;
            PG8_LDB(B1, 1, 1); PG8_STAGE(PG8_SB(1, 0), b3, voffB);
            PG8_BAR; PG8_WAIT_L(0); PG8_MMA(0, 1, At, B1); PG8_BAR;
            PG8_LDA(At, 1, 1); PG8_STAGE(PG8_SA(1, 0), a3, voffA);
            PG8_BAR; PG8_WAIT_L(0); PG8_MMA(1, 0, At, B0); PG8_BAR; PG8_SCHED;
            PG8_STAGE(PG8_SB(1, 1), b3 + hstep, voffB);
            PG8_WAIT_V(6); PG8_BAR; PG8_MMA(1, 1, At, B1); PG8_BAR;
            }
        }
        if constexpr (ALIGN_EPI) { if (wr == 0) PG8_BAR; }
        if constexpr (!Epi::AFTER_DRAIN) { E(acc, cur, wr, wc, fr, fq); S.done(cur); }
        if (!has_next) break;
#pragma unroll
        for (int a = 0; a < 2; ++a)
#pragma unroll
            for (int b = 0; b < 2; ++b)
#pragma unroll
                for (int m = 0; m < 4; ++m)
#pragma unroll
                    for (int n = 0; n < 2; ++n) acc[a][b][m][n] = (f32x4){0.f, 0.f, 0.f, 0.f};
        cur = nxt; cA = nA; cB = nB; ++ui;
        if constexpr (ALIGN_EPI) { if (wr == 1) PG8_BAR; }
    }
    PG8_WAIT_V(0);
    if constexpr (!ALIGN_EPI) { if (wr == 0) PG8_BAR; }
    PG8_BAR;
    if constexpr (Epi::AFTER_DRAIN) { E.fused(acc, cur, wr, wc, fr, fq, lds, wid, lane); S.done(cur); }
#undef PG8_SA
#undef PG8_SB
#undef PG8_STAGE
#undef PG8_LDA
#undef PG8_LDB
#undef PG8_MMA
#undef PG8_WAIT_V
#undef PG8_WAIT_L
#undef PG8_BAR
#undef PG8_SCHED
}
}
#define LAS __attribute__((address_space(3)))
typedef unsigned short bf16;
typedef short bf16x8 __attribute__((ext_vector_type(8)));
typedef float f32x4 __attribute__((ext_vector_type(4)));
typedef float f32x16 __attribute__((ext_vector_type(16)));
typedef unsigned u32x4 __attribute__((ext_vector_type(4)));
typedef unsigned long long u64;
constexpr int NB = 32, SEQ = 2048, DM = 1024, M = NB * SEQ;
constexpr int EV_N = 3656, EV_NP = 3840, OD_N = 4112, OD_NP = 4352, DFF = 2816;
constexpr float EPS = 1e-6f;
constexpr size_t MiB = (size_t)1 << 20;
constexpr size_t WS_RSQ = 0;
constexpr size_t WS_BAR = 3 * MiB;
constexpr size_t WS_W = 4 * MiB;
constexpr size_t W_EVIN = WS_W, W_EVOUT = W_EVIN + (size_t)EV_NP * 1024 * 2, W_ODIN = W_EVOUT + 2 * MiB, W_ODOUT = W_ODIN + (size_t)OD_NP * 1024 * 2;
constexpr size_t W_GU = W_ODOUT + 2 * MiB, W_DN = W_GU + 2 * (size_t)2 * DFF * 1024 * 2, W_PJ = W_DN + 2 * (size_t)DFF * 1024 * 2, W_PG = W_PJ + 2 * (size_t)256 * 1024 * 2, W_END = W_PG + 4 * MiB;
static_assert(W_END <= 62 * MiB, "weights");
constexpr size_t WS_HBA = 62 * MiB, WS_HBB = 190 * MiB, WS_Y = 318 * MiB, WS_Z = 446 * MiB, WS_TAIL = 990 * MiB, WS_END = 1024 * MiB;
constexpr size_t WS_QP = WS_HBA, WS_KP = WS_HBA + 64 * MiB;
constexpr size_t WS_QI = 926 * MiB, WS_KI = WS_TAIL, WS_WI = WS_TAIL + 8 * MiB, WS_MASK = WS_TAIL + 10 * MiB;
constexpr size_t WS_HID = WS_Z, WS_ERAW = WS_Z + 352 * MiB, WS_PB = WS_TAIL;
constexpr size_t WS_TG = WS_HBA, WS_KPD = WS_HBB, WS_VBD = WS_Y, WS_GCUM = WS_TAIL, WS_BETA = WS_TAIL + 2 * MiB;
constexpr int LDS_BYTES = 160 * 1024;
constexpr int NPH = 16;

__device__ __forceinline__ float bf2f(unsigned short b) { return __uint_as_float((unsigned)b << 16); }
__device__ __forceinline__ unsigned pk2(float lo, float hi) { return pg8::cvt_pk_bf16(lo, hi); }
__device__ __forceinline__ unsigned short f2bf(float f) { return (unsigned short)(pk2(f, 0.f) & 0xffffu); }
__device__ __forceinline__ void unpack8(const u32x4 w, float* v) {
    v[0] = __uint_as_float(w.x << 16); v[1] = __uint_as_float(w.x & 0xffff0000u); v[2] = __uint_as_float(w.y << 16); v[3] = __uint_as_float(w.y & 0xffff0000u);
    v[4] = __uint_as_float(w.z << 16); v[5] = __uint_as_float(w.z & 0xffff0000u); v[6] = __uint_as_float(w.w << 16); v[7] = __uint_as_float(w.w & 0xffff0000u); }
__device__ __forceinline__ void ld8(const bf16* p, float* v) { unpack8(*(const u32x4*)p, v); }
__device__ __forceinline__ u32x4 pack8(const float* v) { u32x4 w; w.x = pk2(v[0], v[1]); w.y = pk2(v[2], v[3]); w.z = pk2(v[4], v[5]); w.w = pk2(v[6], v[7]); return w; }
__device__ __forceinline__ void st8(bf16* p, const float* v) { *(u32x4*)p = pack8(v); }
__device__ __forceinline__ float sigmoidf_(float x) { return __builtin_amdgcn_rcpf(1.0f + __builtin_amdgcn_exp2f(-1.4426950408889634f * x)); }
__device__ __forceinline__ float siluf_(float x) { return x * sigmoidf_(x); }
#define MFMA16(a, b, c) __builtin_amdgcn_mfma_f32_16x16x32_bf16((a), (b), (c), 0, 0, 0)
#define MFMA32(a, b, c) __builtin_amdgcn_mfma_f32_32x32x16_bf16((a), (b), (c), 0, 0, 0)

struct Args { const void* in[25]; float* out; unsigned char* ws; int ph_lo, ph_hi, coop, pad; };
typedef const __attribute__((address_space(4))) Args CArgs;
__device__ __forceinline__ CArgs* launder_args(CArgs* p) { asm volatile("" : "+s"(p)); return p; }

__device__ __forceinline__ void transpose_item(const float* W, int K, int N, int NP, bf16* WT, const float* gain, int mode, LAS float* scr, int item, int lane) {
    const int nnb = NP / 32, kb = item / nnb, nb = item % nnb, k0 = 64 * kb, n0 = 32 * nb;
    const int n = n0 + (lane & 31);
#pragma unroll
    for (int i = 0; i < 32; ++i) { const int kk = 2 * i + (lane >> 5); float v = 0.f; if (n < N) { v = W[(size_t)(k0 + kk) * N + n]; if (gain) v *= gain[k0 + kk]; } scr[kk * 33 + (lane & 31)] = v; }
    asm volatile("s_waitcnt lgkmcnt(0)" ::: "memory");
    const int c = lane & 7;
    const int r0 = (mode == 0) ? n0 : ((n0 >> 7) * 256 + (mode == 2 ? 128 : 0) + (n0 & 127));
#pragma unroll
    for (int j = 0; j < 4; ++j) { const int nn = (lane >> 3) + 8 * j; const LAS float* s = scr + (8 * c) * 33 + nn;
        u32x4 o; o.x = pk2(s[0 * 33], s[1 * 33]); o.y = pk2(s[2 * 33], s[3 * 33]); o.z = pk2(s[4 * 33], s[5 * 33]); o.w = pk2(s[6 * 33], s[7 * 33]);
        *(u32x4*)(WT + (size_t)(r0 + nn) * K + k0 + 8 * c) = o; }
    asm volatile("s_waitcnt lgkmcnt(0)" ::: "memory");
}
__device__ __forceinline__ float wave_sum(float v) {
#pragma unroll
    for (int o = 1; o < 64; o <<= 1) v += __shfl_xor(v, o);
    return v;
}
__device__ __forceinline__ void prologue(CArgs& a, LAS unsigned char* lds, int tid) {
    const int lane = tid & 63, wave = tid >> 6, gw = blockIdx.x * 8 + wave, NGW = gridDim.x * 8;
    LAS float* scr = (LAS float*)(lds + wave * 16384);
    unsigned char* ws = a.ws;
    int it = gw;
#define DO_MAT(Wp, K_, N_, NP_, dst, gain, mode) { const int cnt = ((K_) / 64) * ((NP_) / 32); for (; it < cnt; it += NGW) transpose_item((Wp), (K_), (N_), (NP_), (bf16*)(dst), (gain), (mode), scr, it, lane); it -= cnt; }
    const float* nmg = (const float*)a.in[3]; const float* nfg = (const float*)a.in[4]; const float* png = (const float*)a.in[23];
    DO_MAT((const float*)a.in[5], 1024, EV_N, EV_NP, ws + W_EVIN, nmg, 0)
    DO_MAT((const float*)a.in[11], 1024, 1024, 1024, ws + W_EVOUT, (const float*)nullptr, 0)
    DO_MAT((const float*)a.in[12], 1024, OD_N, OD_NP, ws + W_ODIN, nmg + 1024, 0)
    DO_MAT((const float*)a.in[17], 1024, 1024, 1024, ws + W_ODOUT, (const float*)nullptr, 0)
    for (int l = 0; l < 2; ++l) {
        DO_MAT((const float*)a.in[18] + (size_t)l * 1024 * DFF, 1024, DFF, DFF, ws + W_GU + (size_t)l * 2 * DFF * 1024 * 2, nfg + l * 1024, 1)
        DO_MAT((const float*)a.in[19] + (size_t)l * 1024 * DFF, 1024, DFF, DFF, ws + W_GU + (size_t)l * 2 * DFF * 1024 * 2, nfg + l * 1024, 2)
        DO_MAT((const float*)a.in[20] + (size_t)l * 1024 * DFF, DFF, 1024, 1024, ws + W_DN + (size_t)l * DFF * 1024 * 2, (const float*)nullptr, 0)
        DO_MAT((const float*)a.in[21] + (size_t)l * 256 * 1024, 256, 1024, 1024, ws + W_PJ + (size_t)l * 256 * 1024 * 2, (const float*)nullptr, 0)
        DO_MAT((const float*)a.in[24] + (size_t)l * 1024 * 1024, 1024, 1024, 1024, ws + W_PG + (size_t)l * 1024 * 1024 * 2, png + l * 1024, 0)
    }
#undef DO_MAT
    const float* x = (const float*)a.in[0]; bf16* xb = (bf16*)(ws + WS_HBB); float* rsq = (float*)(ws + WS_RSQ);
    for (int m0 = gw; m0 < M; m0 += 4 * NGW) {
        f32x4 v[4][4];
#pragma unroll
        for (int r = 0; r < 4; ++r) { const int m = m0 + r * NGW; if (m < M) { const f32x4* xr = (const f32x4*)(x + (size_t)m * DM) + lane;
#pragma unroll
            for (int j = 0; j < 4; ++j) v[r][j] = xr[64 * j]; } }
#pragma unroll
        for (int r = 0; r < 4; ++r) { const int m = m0 + r * NGW; if (m < M) { unsigned long long* o8 = (unsigned long long*)(xb + (size_t)m * DM) + lane; float s = 0.f;
#pragma unroll
            for (int j = 0; j < 4; ++j) { const f32x4 w = v[r][j]; s += (w.x * w.x + w.y * w.y) + (w.z * w.z + w.w * w.w); o8[64 * j] = (unsigned long long)pk2(w.x, w.y) | ((unsigned long long)pk2(w.z, w.w) << 32); }
            s = wave_sum(s); if (lane == 0) rsq[m] = s; } }
    }
    for (int i = blockIdx.x * 512 + tid; i < 7 * M; i += gridDim.x * 512) rsq[M + i] = 0.f;
}
__device__ __forceinline__ void convert_p(const float* p, bf16* pb, int tid) {
    for (size_t i = (size_t)blockIdx.x * 512 + tid; i < (size_t)M * 256 / 8; i += (size_t)gridDim.x * 512) {
        const f32x4 v0 = *(const f32x4*)(p + i * 8), v1 = *(const f32x4*)(p + i * 8 + 4);
        u32x4 w; w.x = pk2(v0.x, v0.y); w.y = pk2(v0.z, v0.w); w.z = pk2(v1.x, v1.y); w.w = pk2(v1.z, v1.w); *(u32x4*)(pb + i * 8) = w; }
}

__device__ __forceinline__ void rope8(float* x, const LAS float* cs, const LAS float* sn, int i0, int xorm, bool first, bool active) {
#pragma unroll
    for (int e = 0; e < 8; ++e) { const float p = __shfl_xor(x[e], xorm); const float c = cs[i0 + e], s = sn[i0 + e]; const float r = first ? x[e] * c - p * s : p * s + x[e] * c; if (active) x[e] = r; }
}
__device__ __forceinline__ void even_post(CArgs& a, LAS unsigned char* lds, int tid) {
    const int lane = tid & 63, wave = tid >> 6, gw = blockIdx.x * 8 + wave, NGW = gridDim.x * 8, j = lane & 7, col = 8 * lane;
    LAS float* rs = (LAS float*)(lds + wave * 512);
    unsigned char* ws = a.ws;
    const bf16* Z = (const bf16*)(ws + WS_Z); bf16* Y = (bf16*)(ws + WS_Y); bf16* QP = (bf16*)(ws + WS_QP); bf16* KP = (bf16*)(ws + WS_KP);
    bf16* QI = (bf16*)(ws + WS_QI); bf16* KI = (bf16*)(ws + WS_KI); float* WI = (float*)(ws + WS_WI);
    const int* positions = (const int*)a.in[2]; const float* cw = (const float*)a.in[6];
    const float* qg = (const float*)a.in[7]; const float* kg = (const float*)a.in[8]; const float* lng = (const float*)a.in[9]; const float* lnb = (const float*)a.in[10];
    float cw0[8], cw1[8], cw2[8], qgv[8], kgv[8];
#pragma unroll
    for (int e = 0; e < 8; ++e) { cw0[e] = cw[col + e]; cw1[e] = cw[512 + col + e]; cw2[e] = cw[1024 + col + e]; qgv[e] = qg[(col & 63) + e]; kgv[e] = kg[(col & 63) + e]; }
    const float inva = 1.0f / powf(10000.f, (float)(2 * (lane & 31)) / 64.f), invi = 1.0f / powf(10000.f, (float)(2 * (lane & 15)) / 32.f);
    for (int row = gw; row < M; row += NGW) {
        const int t = row & (SEQ - 1); const float pos = (float)positions[row];
        if (lane < 32) { const float ang = pos * inva; rs[lane] = cosf(ang); rs[32 + lane] = sinf(ang); }
        else if (lane < 48) { const float ang = pos * invi; rs[64 + lane - 32] = cosf(ang); rs[80 + lane - 32] = sinf(ang); }
        const bf16* z = Z + (size_t)row * EV_NP;
        float v[8], u0[8], u1[8], u2[8], tmp[8];
        const bf16* z1 = z - (t >= 1 ? EV_NP : 0); const bf16* z2 = z - (t >= 2 ? 2 * EV_NP : 0); const float m1 = t >= 1 ? 1.f : 0.f, m2 = t >= 2 ? 1.f : 0.f;
        const u32x4 r_zb = *(const u32x4*)(z + col), r_c0 = *(const u32x4*)(z + 512 + col), r_h0 = *(const u32x4*)(z + 1024 + col);
        const u32x4 r_c1 = *(const u32x4*)(z1 + 512 + col), r_h1 = *(const u32x4*)(z1 + 1024 + col), r_c2 = *(const u32x4*)(z2 + 512 + col), r_h2 = *(const u32x4*)(z2 + 1024 + col);
        const u32x4 r_q = *(const u32x4*)(z + 1536 + col), r_k = *(const u32x4*)(z + 2048 + col), r_qi = *(const u32x4*)(z + 3072 + col), r_ki = *(const u32x4*)(z + 3584 + 8 * j), r_wi = *(const u32x4*)(z + 3648);
        unpack8(r_c0, u0); unpack8(r_h0, tmp);
#pragma unroll
        for (int e = 0; e < 8; ++e) u0[e] *= tmp[e];
        unpack8(r_c1, u1); unpack8(r_h1, tmp);
#pragma unroll
        for (int e = 0; e < 8; ++e) u1[e] *= tmp[e] * m1;
        unpack8(r_c2, u2); unpack8(r_h2, tmp);
#pragma unroll
        for (int e = 0; e < 8; ++e) u2[e] *= tmp[e] * m2;
        unpack8(r_zb, v);
#pragma unroll
        for (int e = 0; e < 8; ++e) v[e] = v[e] * (cw0[e] * u2[e] + cw1[e] * u1[e] + cw2[e] * u0[e]);
        st8(Y + (size_t)row * 1024 + col, v);
#pragma unroll
        for (int which = 0; which < 2; ++which) {
            unpack8(which ? r_k : r_q, v); float ss = 0.f;
#pragma unroll
            for (int e = 0; e < 8; ++e) ss += v[e] * v[e];
            ss += __shfl_xor(ss, 1); ss += __shfl_xor(ss, 2); ss += __shfl_xor(ss, 4);
            const float r = __builtin_amdgcn_rsqf(ss * (1.0f / 64.0f) + EPS);
#pragma unroll
            for (int e = 0; e < 8; ++e) v[e] = v[e] * r * (which ? kgv[e] : qgv[e]);
            rope8(v, rs, rs + 32, 8 * (j & 3), 4, j < 4, true);
            if (which == 0) {
#pragma unroll
                for (int e = 0; e < 8; ++e) v[e] *= 0.125f * 1.4426950408889634f;
                st8(QP + (size_t)row * 512 + col, v);
            } else st8(KP + (size_t)row * 512 + col, v);
        }
        unpack8(r_qi, v);
        rope8(v, rs + 64, rs + 80, 8 * (j & 1), 2, j < 2, j < 4);
        st8(QI + (size_t)row * 512 + col, v);
        unpack8(r_ki, v);
        { float s = 0.f;
#pragma unroll
            for (int e = 0; e < 8; ++e) s += v[e];
            s += __shfl_xor(s, 1); s += __shfl_xor(s, 2); s += __shfl_xor(s, 4);
            const float mu = s * (1.0f / 64.0f); float q = 0.f;
#pragma unroll
            for (int e = 0; e < 8; ++e) { v[e] -= mu; q += v[e] * v[e]; }
            q += __shfl_xor(q, 1); q += __shfl_xor(q, 2); q += __shfl_xor(q, 4);
            const float r = __builtin_amdgcn_rsqf(q * (1.0f / 64.0f) + EPS);
#pragma unroll
            for (int e = 0; e < 8; ++e) v[e] = v[e] * r * lng[8 * j + e] + lnb[8 * j + e];
            rope8(v, rs + 64, rs + 80, 8 * (j & 1), 2, j < 2, j < 4);
            if (lane < 8) st8(KI + (size_t)row * 64 + 8 * j, v);
        }
        if (lane == 8) { unpack8(r_wi, v); float* wo = WI + (size_t)row * 8;
#pragma unroll
            for (int e = 0; e < 8; ++e) wo[e] = v[e] * 0.044194173824159216f; }
    }
}
#define XB_TMO      128
#define XB_XCNT(j)  (256  + 64 * (j))
#define XB_XSUB(j)  (1280 + 64 * (j))
#define XB_XGEN(j)  (2304 + 64 * (j))
#define XB_TOP      3328
#define XB_TOPGEN   3392
#define XCD_BAR_WORDS 3456
#define XB_SPIN_CAP (1u << 18)

__device__ __forceinline__ unsigned xb_ld(unsigned* p)              { return __hip_atomic_load(p, __ATOMIC_RELAXED, __HIP_MEMORY_SCOPE_AGENT); }
__device__ __forceinline__ unsigned xb_add(unsigned* p, unsigned v) { return __hip_atomic_fetch_add(p, v, __ATOMIC_RELAXED, __HIP_MEMORY_SCOPE_AGENT); }
__device__ __forceinline__ unsigned xb_xcc_id() { return (unsigned)__builtin_amdgcn_s_getreg((3 << 11) | 20) & 0xFu; }
#define XB_SPIN(cond, bar) do { unsigned _sp = 0; while (cond) { __builtin_amdgcn_s_sleep(1); \
    if ((++_sp & 255u) == 0u) { if (xb_ld(&(bar)[XB_TMO])) break; if (_sp > XB_SPIN_CAP) { atomicAdd(&(bar)[XB_TMO], 1u); break; } } } } while (0)

struct XcdBarrier {
    unsigned* bar; unsigned x;
    volatile LAS unsigned* st;
};

__device__ __forceinline__ XcdBarrier xcd_barrier_post(unsigned* bar, volatile LAS unsigned* st) {
    XcdBarrier b; b.bar = bar; b.x = xb_xcc_id(); b.st = st;
    if (threadIdx.x == 0) (void)xb_add(&bar[XB_XCNT(b.x)], 1u);
    return b;
}
__device__ __forceinline__ void xcd_barrier_complete(unsigned* bar, unsigned x, unsigned& nloc, unsigned& nx) {
    const unsigned G = gridDim.x * gridDim.y * gridDim.z;
    unsigned sum, cnt, mine, sp = 0u;
    for (;;) {
        sum = 0u; cnt = 0u; mine = 0u;
#pragma unroll
        for (unsigned j = 0; j < 16; ++j) { const unsigned c = xb_ld(&bar[XB_XCNT(j)]); sum += c; cnt += (c > 0u) ? 1u : 0u; mine = (j == x) ? c : mine; }
        if (sum == G) break;
        __builtin_amdgcn_s_sleep(1);
        if ((++sp & 255u) == 0u) { if (xb_ld(&bar[XB_TMO])) break; if (sp > XB_SPIN_CAP) { atomicAdd(&bar[XB_TMO], 1u); break; } }
    }
    nloc = mine > 0u ? mine : 1u; nx = cnt > 0u ? cnt : 1u;
}

__device__ __forceinline__ void xcd_barrier(const XcdBarrier& b) {
    asm volatile("s_waitcnt vmcnt(0)" ::: "memory");
    __syncthreads();
    if (threadIdx.x == 0) {
        unsigned* bar = b.bar;
        __builtin_amdgcn_s_waitcnt(0);
        unsigned nloc = b.st[0], nx = b.st[1];
        if (nloc == 0u) { xcd_barrier_complete(bar, b.x, nloc, nx); b.st[0] = nloc; b.st[1] = nx; }
        const unsigned old = xb_add(&bar[XB_XSUB(b.x)], 1u);
        const unsigned gen = old / nloc;
        if (old + 1u == (gen + 1u) * nloc) {
            __builtin_amdgcn_fence(__ATOMIC_RELEASE, "agent");
            asm volatile("s_waitcnt vmcnt(0)" ::: "memory");
            const unsigned og = xb_add(&bar[XB_TOP], 1u);
            const unsigned tg = og / nx;
            if (og + 1u == (tg + 1u) * nx) xb_add(&bar[XB_TOPGEN], 1u);
            else XB_SPIN(xb_ld(&bar[XB_TOPGEN]) == tg, bar);
            __builtin_amdgcn_fence(__ATOMIC_ACQUIRE, "agent");
            xb_add(&bar[XB_XGEN(b.x)], 1u);
            asm volatile("s_waitcnt vmcnt(0)" ::: "memory");
        } else {
            XB_SPIN(xb_ld(&bar[XB_XGEN(b.x)]) == gen, bar);
            __builtin_amdgcn_fence(__ATOMIC_ACQUIRE, "agent");
            asm volatile("s_waitcnt vmcnt(0)" ::: "memory");
        }
    }
    __syncthreads();
}
__device__ __forceinline__ void idx_phase(LAS unsigned char* lds, const bf16* QI, const bf16* KI, const float* WI, u64* MASK, int tid) {
    const int lane = tid & 63, wave = __builtin_amdgcn_readfirstlane(tid >> 6), l15 = lane & 15, kq = lane >> 4;
    LAS float* sc = (LAS float*)lds; constexpr int SCP = 2052;
    for (int u = blockIdx.x; u < 4096; u += gridDim.x) {
        const int b = u & 31, r = u >> 5, rnd = r >> 3, sub = r & 7; const int qt = rnd * 8 + ((rnd & 1) ? 7 - sub : sub);
        const int q0 = qt * 16; const size_t rb = (size_t)b * SEQ;
        if (q0 < 256) {
            for (int qq = 2 * wave; qq < 2 * wave + 2; ++qq) { const int t = q0 + qq; if (lane < 32) { const int n = t + 1 - 64 * lane; const u64 w = n <= 0 ? 0ull : (n >= 64 ? ~0ull : ((1ull << n) - 1ull)); MASK[(rb + t) * 32 + lane] = w; } }
            continue;
        }
        bf16x8 Bq[8][2]; float wv[8];
        { const bf16* qp = QI + (rb + q0 + l15) * 512 + kq * 8; const float* wp = WI + (rb + q0 + l15) * 8;
#pragma unroll
            for (int h = 0; h < 8; ++h) { Bq[h][0] = *(const bf16x8*)(qp + h * 64); Bq[h][1] = *(const bf16x8*)(qp + h * 64 + 32); wv[h] = wp[h]; } }
        bf16x8 A0n, A1n; { const int kt0 = wave <= qt ? wave : qt; const bf16* kp = KI + (rb + 16 * kt0 + l15) * 64 + kq * 8; A0n = *(const bf16x8*)kp; A1n = *(const bf16x8*)(kp + 32); }
        for (int kt = wave; kt <= qt; kt += 8) {
            const bf16x8 A0 = A0n, A1 = A1n;
            { const int ktn = kt + 8 <= qt ? kt + 8 : qt; const bf16* kp = KI + (rb + 16 * ktn + l15) * 64 + kq * 8; A0n = *(const bf16x8*)kp; A1n = *(const bf16x8*)(kp + 32); }
            f32x4 s = {0.f, 0.f, 0.f, 0.f};
#pragma unroll
            for (int h = 0; h < 8; ++h) { f32x4 D = {0.f, 0.f, 0.f, 0.f}; D = MFMA16(A0, Bq[h][0], D); D = MFMA16(A1, Bq[h][1], D);
#pragma unroll
                for (int e = 0; e < 4; ++e) s[e] = fmaf(wv[h], fmaxf(D[e], 0.f), s[e]); }
            *(LAS f32x4*)(sc + l15 * SCP + 16 * kt + 4 * kq) = s;
        }
        __syncthreads();
        for (int qq = 2 * wave; qq < 2 * wave + 2; ++qq) {
            const int t = q0 + qq; const int nrows = __builtin_amdgcn_readfirstlane((t >> 6) + 1);
            unsigned kv[32];
#pragma unroll
            for (int i = 0; i < 32; ++i) { const int idx = 64 * i + lane; unsigned k = 0u;
                if (idx <= t) { const float f = sc[qq * SCP + idx]; unsigned ub = __float_as_uint(f); if (f == 0.f) ub = 0u; k = (ub & 0x80000000u) ? ~ub : (ub | 0x80000000u); }
                kv[i] = k; }
            unsigned T = 0u;
            for (int bit = 31; bit >= 0; --bit) {
                const unsigned cand = T | (1u << bit); int cnt = 0;
#pragma unroll
                for (int g = 0; g < 4; ++g) if (8 * g < nrows) {
                    u64 bm[8];
#pragma unroll
                    for (int i = 0; i < 8; ++i) bm[i] = __ballot(kv[8 * g + i] >= cand);
                    __builtin_amdgcn_sched_barrier(0);
#pragma unroll
                    for (int i = 0; i < 8; ++i) cnt += __popcll(bm[i]);
                    __builtin_amdgcn_sched_barrier(0); }
                if (cnt >= 256) { T = cand; if (cnt == 256) break; }
            }
            int cgt = 0;
#pragma unroll
            for (int g = 0; g < 4; ++g) if (8 * g < nrows) {
#pragma unroll
                for (int i = 8 * g; i < 8 * g + 8; ++i) cgt += __popcll(__ballot(kv[i] > T)); }
            const int need = 256 - cgt; int tb = 0; u64 word = 0ull; const u64 ltm = (1ull << lane) - 1ull;
#pragma unroll
            for (int g = 0; g < 4; ++g) if (8 * g < nrows) {
#pragma unroll
                for (int i = 8 * g; i < 8 * g + 8; ++i) {
                    const u64 eqm = __ballot(kv[i] == T); const int rank = tb + __popcll(eqm & ltm);
                    const u64 selm = __ballot(kv[i] > T || (kv[i] == T && rank < need)); tb += __popcll(eqm);
                    if (lane == i) word = selm; } }
            if (lane < 32) MASK[(rb + t) * 32 + lane] = word;
        }
        __syncthreads();
    }
}

__device__ __forceinline__ int crow(int r, int hi) { return (r & 3) + 8 * (r >> 2) + 4 * hi; }
__device__ __forceinline__ void attn_phase(LAS unsigned char* lds, const bf16* QP, const bf16* KP, const bf16* Z0, const u64* MASK, bf16* Y, int tid) {
    const int lane = tid & 63, wave = __builtin_amdgcn_readfirstlane(tid >> 6), l31 = lane & 31, hi = lane >> 5;
    LAS bf16* Kb = (LAS bf16*)lds; LAS bf16* Vt = (LAS bf16*)(lds + 18432); LAS float* lsc = (LAS float*)(lds + 36864) + wave * 32;
    const int lk = tid >> 3, lc = tid & 7;
    for (int u = blockIdx.x; u < 256; u += gridDim.x) {
        const int b = u >> 3, h = u & 7; const size_t rb = (size_t)b * SEQ;
        for (int qb = 7; qb >= 0; --qb) {
            const int q0 = qb * 256, NT = 4 * (qb + 1), qw0 = q0 + 32 * wave, q = qw0 + l31;
            bf16x8 qr[4];
#pragma unroll
            for (int d0 = 0; d0 < 4; ++d0) qr[d0] = *(const bf16x8*)(QP + (rb + q) * 512 + h * 64 + 16 * d0 + 8 * hi);
            f32x16 O0, O1;
#pragma unroll
            for (int r = 0; r < 16; ++r) { O0[r] = 0.f; O1[r] = 0.f; }
            float l = 0.f;
            u32x4 kreg = *(const u32x4*)(KP + (rb + lk) * 512 + h * 64 + 8 * lc), vreg = *(const u32x4*)(Z0 + (rb + lane) * EV_NP + 2560 + h * 64 + 8 * wave);
#define ATT_STORE(buf) do { *(LAS u32x4*)(Kb + (buf) * 4608 + lk * 72 + 8 * lc) = kreg; LAS bf16* vt_ = Vt + (buf) * 4608 + (8 * wave) * 72 + lane; \
            vt_[0] = (bf16)(vreg.x & 0xffffu); vt_[72] = (bf16)(vreg.x >> 16); vt_[144] = (bf16)(vreg.y & 0xffffu); vt_[216] = (bf16)(vreg.y >> 16); \
            vt_[288] = (bf16)(vreg.z & 0xffffu); vt_[360] = (bf16)(vreg.z >> 16); vt_[432] = (bf16)(vreg.w & 0xffffu); vt_[504] = (bf16)(vreg.w >> 16); } while (0)
            ATT_STORE(0);
            u64 mwn = MASK[(rb + q) * 32];
            __syncthreads();
            for (int t = 0; t < NT; ++t) {
                const int cur = t & 1; const u64 mw = mwn;
                if (t + 1 < NT) { kreg = *(const u32x4*)(KP + (rb + 64 * (t + 1) + lk) * 512 + h * 64 + 8 * lc); vreg = *(const u32x4*)(Z0 + (rb + 64 * (t + 1) + lane) * EV_NP + 2560 + h * 64 + 8 * wave); mwn = MASK[(rb + q) * 32 + t + 1]; }
                if (64 * t <= qw0 + 31) {
                    f32x16 S0, S1;
#pragma unroll
                    for (int r = 0; r < 16; ++r) { S0[r] = 0.f; S1[r] = 0.f; }
                    const LAS bf16* kb = Kb + cur * 4608 + l31 * 72 + 8 * hi;
#pragma unroll
                    for (int d0 = 0; d0 < 4; ++d0) { const bf16x8 a0 = *(const LAS bf16x8*)(kb + 16 * d0), a1 = *(const LAS bf16x8*)(kb + 32 * 72 + 16 * d0);
                        S0 = MFMA32(a0, qr[d0], S0); S1 = MFMA32(a1, qr[d0], S1); }
                    const unsigned mlo = (unsigned)mw >> (4 * hi), mhi = (unsigned)(mw >> 32) >> (4 * hi);
                    float ps = 0.f;
#pragma unroll
                    for (int r = 0; r < 16; ++r) { const int cb = (r & 3) + 8 * (r >> 2);
                        const unsigned b0 = (unsigned)__builtin_amdgcn_sbfe(mlo, cb, 1), b1 = (unsigned)__builtin_amdgcn_sbfe(mhi, cb, 1);
                        const float p0 = __uint_as_float(__float_as_uint(__builtin_amdgcn_exp2f(S0[r])) & b0), p1 = __uint_as_float(__float_as_uint(__builtin_amdgcn_exp2f(S1[r])) & b1);
                        ps += p0 + p1; S0[r] = p0; S1[r] = p1; }
                    l += ps;
                    u32x4 pw[4];
                    pw[0] = (u32x4){pk2(S0[0], S0[1]), pk2(S0[2], S0[3]), pk2(S0[4], S0[5]), pk2(S0[6], S0[7])};
                    pw[1] = (u32x4){pk2(S0[8], S0[9]), pk2(S0[10], S0[11]), pk2(S0[12], S0[13]), pk2(S0[14], S0[15])};
                    pw[2] = (u32x4){pk2(S1[0], S1[1]), pk2(S1[2], S1[3]), pk2(S1[4], S1[5]), pk2(S1[6], S1[7])};
                    pw[3] = (u32x4){pk2(S1[8], S1[9]), pk2(S1[10], S1[11]), pk2(S1[12], S1[13]), pk2(S1[14], S1[15])};
                    const LAS bf16* vt = Vt + cur * 4608 + l31 * 72 + 4 * hi;
#pragma unroll
                    for (int m = 0; m < 4; ++m) { const int base = 16 * (m & 1) + 32 * (m >> 1);
                        const u64 lo0 = *(const LAS u64*)(vt + base), hi0 = *(const LAS u64*)(vt + base + 8), lo1 = *(const LAS u64*)(vt + 32 * 72 + base), hi1 = *(const LAS u64*)(vt + 32 * 72 + base + 8);
                        const u32x4 v0 = {(unsigned)lo0, (unsigned)(lo0 >> 32), (unsigned)hi0, (unsigned)(hi0 >> 32)}, v1 = {(unsigned)lo1, (unsigned)(lo1 >> 32), (unsigned)hi1, (unsigned)(hi1 >> 32)};
                        O0 = MFMA32(__builtin_bit_cast(bf16x8, pw[m]), __builtin_bit_cast(bf16x8, v0), O0);
                        O1 = MFMA32(__builtin_bit_cast(bf16x8, pw[m]), __builtin_bit_cast(bf16x8, v1), O1); }
                }
                if (t + 1 < NT) ATT_STORE(cur ^ 1);
                __syncthreads();
            }
#undef ATT_STORE
            l += __shfl_xor(l, 32);
            if (hi == 0) lsc[l31] = l;
            asm volatile("s_waitcnt lgkmcnt(0)" ::: "memory");
#pragma unroll
            for (int r = 0; r < 16; ++r) { const int qr_ = crow(r, hi); const float rl = __builtin_amdgcn_rcpf(lsc[qr_]);
                bf16* yp = Y + (rb + qw0 + qr_) * 1024 + 512 + h * 64 + l31; yp[0] = f2bf(O0[r] * rl); yp[32] = f2bf(O1[r] * rl); }
        }
    }
}
__device__ __forceinline__ void conv16(const bf16* zbase, int t, const float* cwp, float* out) {
    float acc[16];
#pragma unroll
    for (int e = 0; e < 16; ++e) acc[e] = 0.f;
#pragma unroll
    for (int jt = 0; jt < 4; ++jt) { if (t - 3 + jt >= 0) { float x[16]; ld8(zbase + (ptrdiff_t)(jt - 3) * OD_NP, x); ld8(zbase + (ptrdiff_t)(jt - 3) * OD_NP + 8, x + 8);
            const float* w = cwp + jt * 3072;
#pragma unroll
            for (int e = 0; e < 16; ++e) acc[e] = fmaf(w[e], x[e], acc[e]); } }
#pragma unroll
    for (int e = 0; e < 16; ++e) out[e] = siluf_(acc[e]);
}
__device__ __forceinline__ void conv16_ld(const bf16* zbase, int t, u32x4* raw) {
#pragma unroll
    for (int jt = 0; jt < 4; ++jt) { const int back = (t - 3 + jt >= 0) ? (3 - jt) : 0; const bf16* p = zbase - (ptrdiff_t)back * OD_NP; raw[2 * jt] = *(const u32x4*)p; raw[2 * jt + 1] = *(const u32x4*)(p + 8); }
}
__device__ __forceinline__ void conv16_fin(const u32x4* raw, int t, const LAS float* wl, int c16, float* out) {
    float acc[16];
#pragma unroll
    for (int e = 0; e < 16; ++e) acc[e] = 0.f;
#pragma unroll
    for (int jt = 0; jt < 4; ++jt) { float x[16]; unpack8(raw[2 * jt], x); unpack8(raw[2 * jt + 1], x + 8); const float msk = (t - 3 + jt >= 0) ? 1.f : 0.f;
#pragma unroll
        for (int q4 = 0; q4 < 4; ++q4) { const f32x4 w = *(const LAS f32x4*)(wl + jt * 128 + c16 + 4 * q4);
#pragma unroll
            for (int e = 0; e < 4; ++e) acc[4 * q4 + e] = fmaf(w[e] * msk, x[4 * q4 + e], acc[4 * q4 + e]); } }
#pragma unroll
    for (int e = 0; e < 16; ++e) out[e] = siluf_(acc[e]);
}
__device__ __forceinline__ void dn_prep(CArgs& a, LAS unsigned char* lds, int tid) {
    const int lane = tid & 63, wave = __builtin_amdgcn_readfirstlane(tid >> 6), l15 = lane & 15, kq = lane >> 4;
    unsigned char* ws = a.ws;
    const bf16* Z1 = (const bf16*)(ws + WS_Z); bf16* KPD = (bf16*)(ws + WS_KPD); bf16* VBD = (bf16*)(ws + WS_VBD); bf16* TG = (bf16*)a.out;
    float* GCUM = (float*)(ws + WS_GCUM); float* BETA = (float*)(ws + WS_BETA);
    const float* cw = (const float*)a.in[13]; const float* a_log = (const float*)a.in[14]; const float* dt_bias = (const float*)a.in[15];
    LAS bf16* KN = (LAS bf16*)lds; LAS float* AM = (LAS float*)(lds + 17408); LAS float* GC = (LAS float*)(lds + 17408 + 131072); LAS float* BT = GC + 64; LAS float* CWK = GC + 128; LAS float* CWV = CWK + 512;
    const int row = tid >> 3, c8 = tid & 7;
    for (int grp = blockIdx.x; grp < 1024; grp += gridDim.x) {
        const int bh = grp >> 2, ng = grp & 3, b = bh >> 3, h = bh & 7; const size_t rb = (size_t)b * SEQ;
        { const int jt_ = tid >> 7, cc_ = tid & 127; CWK[jt_ * 128 + cc_] = cw[jt_ * 3072 + 1024 + h * 128 + cc_]; CWV[jt_ * 128 + cc_] = cw[jt_ * 3072 + 2048 + h * 128 + cc_]; }
        __syncthreads();
#ifndef NO_PREPA
        for (int ci = 0; ci < 8; ++ci) {
            const int n = ng * 8 + ci, t0 = 64 * n, t = t0 + row;
            if (tid < 64) { const int tt = t0 + tid; const bf16* zr = Z1 + (rb + tt) * OD_NP;
                const float av = bf2f(zr[4096 + h]), bv = bf2f(zr[4104 + h]); const float xx = av + dt_bias[h];
                const float sp = xx > 20.f ? xx : log1pf(expf(xx)); float g = -expf(a_log[h]) * sp; const float beta = sigmoidf_(bv);
#pragma unroll
                for (int o = 1; o < 64; o <<= 1) { const float up = __shfl_up(g, o); if (lane >= o) g += up; }
                GC[tid] = g; BT[tid] = beta; GCUM[(size_t)bh * SEQ + tt] = g; BETA[(size_t)bh * SEQ + tt] = beta; }
            const bf16* zr = Z1 + (rb + t) * OD_NP;
            u32x4 rawk[8], rawv[8]; conv16_ld(zr + 1024 + h * 128 + 16 * c8, t, rawk); conv16_ld(zr + 2048 + h * 128 + 16 * c8, t, rawv);
            const float betar = sigmoidf_(bf2f(zr[4104 + h]));
            float x[16];
            conv16_fin(rawk, t, CWK, 16 * c8, x);
            float ss = 0.f;
#pragma unroll
            for (int e = 0; e < 16; ++e) ss += x[e] * x[e];
            ss += __shfl_xor(ss, 1); ss += __shfl_xor(ss, 2); ss += __shfl_xor(ss, 4);
            const float rn = __builtin_amdgcn_rsqf(ss + EPS);
#pragma unroll
            for (int e = 0; e < 16; ++e) x[e] *= rn;
            { const u32x4 w0 = pack8(x), w1 = pack8(x + 8); bf16* kp = KPD + (rb + t) * 1024 + h * 128 + 16 * c8; *(u32x4*)kp = w0; *(u32x4*)(kp + 8) = w1;
              LAS bf16* kl = KN + row * 136 + 16 * c8; *(LAS u32x4*)kl = w0; *(LAS u32x4*)(kl + 8) = w1; }
            conv16_fin(rawv, t, CWV, 16 * c8, x);
            {
#pragma unroll
              for (int e = 0; e < 16; ++e) x[e] *= betar;
              bf16* vp = VBD + (rb + t) * 1024 + h * 128 + 16 * c8; *(u32x4*)vp = pack8(x); *(u32x4*)(vp + 8) = pack8(x + 8); }
            __syncthreads();
#pragma unroll
            for (int ti = 0; ti < 2; ++ti) { const int id = 2 * wave + ti, ct = id >> 2, st = id & 3; LAS float* am = AM + ci * 4096;
                f32x4 D = {0.f, 0.f, 0.f, 0.f};
                if (st <= ct) {
#pragma unroll
                    for (int ks = 0; ks < 4; ++ks) { const bf16x8 A = *(const LAS bf16x8*)(KN + (16 * ct + l15) * 136 + 32 * ks + 8 * kq), B = *(const LAS bf16x8*)(KN + (16 * st + l15) * 136 + 32 * ks + 8 * kq); D = MFMA16(A, B, D); }
                }
                const int s = 16 * st + l15; const float gs = GC[s];
#pragma unroll
                for (int e = 0; e < 4; ++e) { const int c = 16 * ct + 4 * kq + e; am[c * 64 + s] = (c > s) ? BT[c] * __expf(GC[c] - gs) * D[e] : 0.f; } }
            __syncthreads();
        }
#endif
#ifndef NO_FSUB
        {
            const LAS float* am = AM + wave * 4096; const int n = ng * 8 + wave; bf16* tg = TG + ((size_t)bh * 32 + n) * 4096;
            float xs[64];
#pragma unroll
            for (int i = 0; i < 64; ++i) { float acc0 = (i == lane) ? 1.f : 0.f, acc1 = 0.f;
#pragma unroll
                for (int jj = 0; jj < (i + 3) / 4; ++jj) { const f32x4 a4 = *(const LAS f32x4*)(am + i * 64 + 4 * jj);
#pragma unroll
                    for (int e = 0; e < 4; ++e) if (4 * jj + e < i) { if (jj & 1) acc1 = fmaf(-a4[e], xs[4 * jj + e], acc1); else acc0 = fmaf(-a4[e], xs[4 * jj + e], acc0); } }
                xs[i] = acc0 + acc1; tg[i * 64 + lane] = f2bf(xs[i]); __builtin_amdgcn_sched_barrier(0); }
        }
#endif
        __syncthreads();
    }
}

__device__ __forceinline__ void dn_scan(CArgs& a, LAS unsigned char* lds, int tid) {
    const int lane = tid & 63, wave = __builtin_amdgcn_readfirstlane(tid >> 6); int l15 = lane & 15, kq = lane >> 4;
    unsigned char* ws = a.ws;
    const bf16* Z1 = (const bf16*)(ws + WS_Z); const bf16* KPD = (const bf16*)(ws + WS_KPD); const bf16* VBD = (const bf16*)(ws + WS_VBD); const bf16* TG = (const bf16*)a.out;
    const float* GCUM = (const float*)(ws + WS_GCUM); const float* BETA = (const float*)(ws + WS_BETA); bf16* Y = (bf16*)(ws + WS_Y);
    const float* cw = (const float*)a.in[13]; const float* ong = (const float*)a.in[16];
    LAS bf16* TM = (LAS bf16*)lds; LAS bf16* KN = (LAS bf16*)(lds + 9216); LAS bf16* KT = (LAS bf16*)(lds + 26624); LAS bf16* QN = (LAS bf16*)(lds + 45056);
    LAS bf16* VB = (LAS bf16*)(lds + 62464); LAS bf16* STB = (LAS bf16*)(lds + 80896); LAS bf16* RT = (LAS bf16*)(lds + 115712); LAS bf16* VNT = (LAS bf16*)(lds + 134144);
    LAS float* GC = (LAS float*)(lds + 152576); LAS float* COEF = GC + 64; LAS float* EGL = GC + 128; LAS float* EG = GC + 192; LAS float* ONP = GC + 256;
    LAS bf16* QK = TM; LAS bf16* VNS = VB; LAS bf16* QKB = VB;     LAS float* CWQ = ONP + 512;
    LAS bf16* ZL = RT;
    int row = tid >> 3, c8 = tid & 7;
#define RELAUNDER() asm volatile("" : "+v"(l15), "+v"(kq), "+v"(row), "+v"(c8))
    for (int bh = blockIdx.x; bh < 256; bh += gridDim.x) {
        const int b = bh >> 3, h = bh & 7; const size_t rb = (size_t)b * SEQ;
        f32x4 St[8];
#pragma unroll
        for (int i = 0; i < 8; ++i) St[i] = (f32x4){0.f, 0.f, 0.f, 0.f};
        for (int i = tid; i < 128 * 136 / 8; i += 512) *(LAS u32x4*)(STB + 8 * i) = (u32x4){0u, 0u, 0u, 0u};
        float ongv = ong[16 * wave + l15];
        { const int jt_ = tid >> 7, cc_ = tid & 127; CWQ[jt_ * 128 + cc_] = cw[jt_ * 3072 + h * 128 + cc_]; }
        __syncthreads();
#ifndef DBG_NCH
#define DBG_NCH 32
#endif
        for (int n = 0; n < DBG_NCH; ++n) {
            RELAUNDER();
            const int t0 = 64 * n, t = t0 + row;
            u32x4 rawq[8]; conv16_ld(Z1 + (rb + t) * OD_NP + h * 128 + 16 * c8, t, rawq);
            const u32x4 tgv = *(const u32x4*)(TG + ((size_t)bh * 32 + n) * 4096 + tid * 8);
            const bf16* kp = KPD + (rb + t) * 1024 + h * 128 + 16 * c8; const u32x4 kw0 = *(const u32x4*)kp, kw1 = *(const u32x4*)(kp + 8);
            const bf16* vp = VBD + (rb + t) * 1024 + h * 128 + 16 * c8; const u32x4 vw0 = *(const u32x4*)vp, vw1 = *(const u32x4*)(vp + 8);
            const bf16* zp = Z1 + (rb + t) * OD_NP + 3072 + h * 128 + 16 * c8; const u32x4 zw0 = *(const u32x4*)zp, zw1 = *(const u32x4*)(zp + 8);
            const float gl = GCUM[(size_t)bh * SEQ + t0 + 63]; const float gcr = GCUM[(size_t)bh * SEQ + t0 + row];
            float gcv = 0.f, betav = 0.f; if (tid < 64) { gcv = GCUM[(size_t)bh * SEQ + t0 + tid]; betav = BETA[(size_t)bh * SEQ + t0 + tid]; }
            *(LAS u32x4*)(TM + row * 72 + 8 * c8) = tgv;
            { LAS bf16* kl = KN + row * 136 + 16 * c8; *(LAS u32x4*)kl = kw0; *(LAS u32x4*)(kl + 8) = kw1;
              LAS bf16* ktp = KT + (16 * c8) * 72 + row; float kx[16]; unpack8(kw0, kx); unpack8(kw1, kx + 8); const float eglr = __expf(gl - gcr);
#pragma unroll
              for (int e = 0; e < 16; ++e) ktp[e * 72] = f2bf(kx[e] * eglr); }
            { LAS bf16* vl = VB + row * 136 + 16 * c8; *(LAS u32x4*)vl = vw0; *(LAS u32x4*)(vl + 8) = vw1; }
            { float x[16]; conv16_fin(rawq, t, CWQ, 16 * c8, x); float ss = 0.f;
#pragma unroll
              for (int e = 0; e < 16; ++e) ss += x[e] * x[e];
              ss += __shfl_xor(ss, 1); ss += __shfl_xor(ss, 2); ss += __shfl_xor(ss, 4);
              const float rn = __builtin_amdgcn_rsqf(ss + EPS) * 0.08838834764831845f;
#pragma unroll
              for (int e = 0; e < 16; ++e) x[e] *= rn;
              LAS bf16* ql = QN + row * 136 + 16 * c8; *(LAS u32x4*)ql = pack8(x); *(LAS u32x4*)(ql + 8) = pack8(x + 8); }
            if (tid < 64) { GC[tid] = gcv; COEF[tid] = betav * __expf(gcv); EG[tid] = __expf(gcv); }
            const float egl_last = __expf(gl);
            __syncthreads(); RELAUNDER();
#pragma nounroll
            for (int st = 0; st < 4; ++st) { f32x4 D = {0.f, 0.f, 0.f, 0.f};
#pragma unroll
                for (int ks = 0; ks < 4; ++ks) { const bf16x8 A = *(const LAS bf16x8*)(STB + (16 * wave + l15) * 136 + 32 * ks + 8 * kq), B = *(const LAS bf16x8*)(KN + (16 * st + l15) * 136 + 32 * ks + 8 * kq); D = MFMA16(A, B, D); }
                const int s = 16 * st + l15; const float coef = COEF[s];
#pragma unroll
                for (int e = 0; e < 4; ++e) { const int dv = 16 * wave + 4 * kq + e; RT[dv * 72 + s] = f2bf(bf2f(VB[s * 136 + dv]) - coef * D[e]); } __builtin_amdgcn_sched_barrier(0); }
            f32x4 Oa[4];
#pragma unroll
            for (int ct = 0; ct < 4; ++ct) { f32x4 D = {0.f, 0.f, 0.f, 0.f};
#pragma unroll
                for (int ks = 0; ks < 4; ++ks) { const bf16x8 A = *(const LAS bf16x8*)(QN + (16 * ct + l15) * 136 + 32 * ks + 8 * kq), B = *(const LAS bf16x8*)(STB + (16 * wave + l15) * 136 + 32 * ks + 8 * kq); D = MFMA16(A, B, D); }
#pragma unroll
                for (int e = 0; e < 4; ++e) D[e] *= EG[16 * ct + 4 * kq + e];
                Oa[ct] = D; __builtin_amdgcn_sched_barrier(0); }
            __syncthreads(); RELAUNDER();
#pragma nounroll
            for (int ct = 0; ct < 4; ++ct) { f32x4 D = {0.f, 0.f, 0.f, 0.f};
#pragma unroll
                for (int ks = 0; ks < 2; ++ks) { const bf16x8 A = *(const LAS bf16x8*)(RT + (16 * wave + l15) * 72 + 32 * ks + 8 * kq), B = *(const LAS bf16x8*)(TM + (16 * ct + l15) * 72 + 32 * ks + 8 * kq); D = MFMA16(A, B, D); }
                const int c = 16 * ct + l15;
#pragma unroll
                for (int e = 0; e < 4; ++e) { const int dv = 16 * wave + 4 * kq + e; VNT[dv * 72 + c] = f2bf(D[e]); } __builtin_amdgcn_sched_barrier(0); }
#pragma unroll
            for (int ti = 0; ti < 2; ++ti) { const int id = 2 * wave + ti, ct = id >> 2, st = id & 3; f32x4 D = {0.f, 0.f, 0.f, 0.f};
                if (st <= ct) {
#pragma unroll
                    for (int ks = 0; ks < 4; ++ks) { const bf16x8 A = *(const LAS bf16x8*)(QN + (16 * ct + l15) * 136 + 32 * ks + 8 * kq), B = *(const LAS bf16x8*)(KN + (16 * st + l15) * 136 + 32 * ks + 8 * kq); D = MFMA16(A, B, D); }
                }
                const int s = 16 * st + l15; const float gs = GC[s];
#pragma unroll
                for (int e = 0; e < 4; ++e) { const int c = 16 * ct + 4 * kq + e; QKB[c * 72 + s] = (c >= s) ? f2bf(D[e] * __expf(GC[c] - gs)) : (bf16)0; } __builtin_amdgcn_sched_barrier(0); }
            __syncthreads(); RELAUNDER();
            { LAS bf16* zl = ZL + row * 136 + 16 * c8; *(LAS u32x4*)zl = zw0; *(LAS u32x4*)(zl + 8) = zw1; }
#pragma unroll
            for (int ct = 0; ct < 4; ++ct) {
#pragma unroll
                for (int ks = 0; ks < 2; ++ks) { const bf16x8 A = *(const LAS bf16x8*)(QKB + (16 * ct + l15) * 72 + 32 * ks + 8 * kq), B = *(const LAS bf16x8*)(VNT + (16 * wave + l15) * 72 + 32 * ks + 8 * kq); Oa[ct] = MFMA16(A, B, Oa[ct]); }
#pragma unroll
                for (int e = 0; e < 4; ++e) { float q2 = Oa[ct][e] * Oa[ct][e]; q2 += __shfl_xor(q2, 1); q2 += __shfl_xor(q2, 2); q2 += __shfl_xor(q2, 4); q2 += __shfl_xor(q2, 8);
                    if (l15 == 0) ONP[(16 * ct + 4 * kq + e) * 8 + wave] = q2; } __builtin_amdgcn_sched_barrier(0); }
#pragma unroll
            for (int dkt = 0; dkt < 8; ++dkt) { f32x4 D = St[dkt] * egl_last;
#pragma unroll
                for (int ks = 0; ks < 2; ++ks) { const bf16x8 A = *(const LAS bf16x8*)(VNT + (16 * wave + l15) * 72 + 32 * ks + 8 * kq), B = *(const LAS bf16x8*)(KT + (16 * dkt + l15) * 72 + 32 * ks + 8 * kq); D = MFMA16(A, B, D); }
                St[dkt] = D;
#pragma unroll
                for (int e = 0; e < 4; ++e) STB[(16 * wave + 4 * kq + e) * 136 + 16 * dkt + l15] = f2bf(D[e]); __builtin_amdgcn_sched_barrier(0); }
            __syncthreads(); RELAUNDER();
#pragma unroll
            for (int ct = 0; ct < 4; ++ct) {
#pragma unroll
                for (int e = 0; e < 4; ++e) { const int c = 16 * ct + 4 * kq + e;
                    const f32x4 pa = *(const LAS f32x4*)(ONP + c * 8), pb = *(const LAS f32x4*)(ONP + c * 8 + 4);
                    const float tot = ((pa[0] + pa[1]) + (pa[2] + pa[3])) + ((pb[0] + pb[1]) + (pb[2] + pb[3]));
                    const float rstd = __builtin_amdgcn_rsqf(tot * (1.0f / 128.0f) + EPS); const int dv = 16 * wave + l15;
                    const float z = bf2f(ZL[c * 136 + dv]);
#if defined(DBG_Q) && DBG_Q == 1
                    Y[(rb + t0 + c) * 1024 + h * 128 + dv] = f2bf(Oa[ct][e] * 64.f + 0.f * rstd * z); }
#elif defined(DBG_Q) && DBG_Q == 2
                    Y[(rb + t0 + c) * 1024 + h * 128 + dv] = f2bf(bf2f(VNT[dv * 72 + c]) * 64.f + 0.f * rstd * z); }
#elif defined(DBG_Q) && DBG_Q == 5
                    Y[(rb + t0 + c) * 1024 + h * 128 + dv] = f2bf(bf2f(RT[dv * 72 + c]) * 64.f + 0.f * rstd * z); }
#elif defined(DBG_Q) && DBG_Q == 3
                    Y[(rb + t0 + c) * 1024 + h * 128 + dv] = f2bf(bf2f(QK[c * 72 + (dv & 63)]) * 64.f + 0.f * rstd * z); }
#elif defined(DBG_Q) && DBG_Q == 4
                    Y[(rb + t0 + c) * 1024 + h * 128 + dv] = f2bf(bf2f(TM[c * 72 + (dv & 63)]) * 64.f + 0.f * rstd * z); }
#else
                    Y[(rb + t0 + c) * 1024 + h * 128 + dv] = f2bf(Oa[ct][e] * rstd * ongv * siluf_(z)); }
#endif
                __builtin_amdgcn_sched_barrier(0); }
            RELAUNDER();
        }
        __syncthreads();
    }
}
#undef RELAUNDER

#if defined(DBG_TS)
#define STAMP(k) do { if (blockIdx.x == 0 && tid == 0) ((volatile unsigned long long*)(ws + WS_BAR + 65536))[(k)] = __builtin_amdgcn_s_memrealtime(); } while (0)
#else
#define STAMP(k) do {} while (0)
#endif
#ifndef REP1
#define REP1 1
#endif
#ifndef REP0
#define REP0 1
#endif
#ifndef REP2
#define REP2 1
#endif
#ifndef REP3
#define REP3 1
#endif
#ifndef REP4
#define REP4 1
#endif
#ifndef REP10
#define REP10 1
#endif
#if defined(DBG_CUT)
#define DBGCUT(k, ptr, pitch, coloff) do { if ((k) == DBG_CUT) { asm volatile("s_waitcnt vmcnt(0) lgkmcnt(0)" ::: "memory"); cg::this_grid().sync(); \
        const bf16* src_ = (const bf16*)(ptr); float* dst_ = a.out; \
        for (size_t i_ = (size_t)blockIdx.x * 512 + tid; i_ < (size_t)M * 1024; i_ += (size_t)gridDim.x * 512) { const size_t r_ = i_ >> 10, c_ = i_ & 1023; dst_[i_] = bf2f(src_[r_ * (pitch) + (coloff) + c_]); } \
        return; } } while (0)
#else
#define DBGCUT(k, ptr, pitch, coloff) do {} while (0)
#endif
__global__ void __launch_bounds__(512, 2) mega(Args a_unused) {
    extern __shared__ __attribute__((aligned(16))) unsigned char lds_raw[];
    LAS unsigned char* lds = (LAS unsigned char*)lds_raw;
    int tid = threadIdx.x;
    volatile LAS unsigned* xb_st = (volatile LAS unsigned*)(lds + LDS_BYTES - 64);
    if (tid < 16) xb_st[tid] = 0u;
    __syncthreads();
    XcdBarrier bar = xcd_barrier_post((unsigned*)(((CArgs*)__builtin_amdgcn_kernarg_segment_ptr())->ws + WS_BAR), xb_st);
    CArgs* ap = (CArgs*)__builtin_amdgcn_kernarg_segment_ptr();
#define a (*launder_args(ap))
#define ws (a.ws)
#define rsq ((float*)(ws + WS_RSQ))
    const int lo = a.ph_lo, hi = a.ph_hi;
#ifndef PHMASK
#define PHMASK 0xFFFFFFFFu
#endif
#define IN(k) (((PHMASK >> ((k) > 11 ? (k) - 7 : (k))) & 1u) && lo <= (k) && (k) < hi)
#define SEAM(k) do { if (IN(k) && IN((k) + 1)) { if (a.pad == 0x5EED) { cg::this_grid().sync(); }     \
        xcd_barrier(bar); } } while (0)
#define GEMM(EpiT, Aptr, Bptr, N_, K_, ...) do { int k_ = (K_); asm volatile("" : "+s"(k_)); pg8::Gemm g{(const pg8::bf16_t*)(Aptr), (const pg8::bf16_t*)(Bptr), M, (N_), k_}; pg8::StaticOrder S; S.init(M, (N_), (int)gridDim.x, (int)blockIdx.x); \
        pg8::EpiT E{__VA_ARGS__}; pg8::gemm_phase<pg8::EpiT, pg8::StaticOrder, pg8::EpiT::ALIGN, true>(lds, g, S, E, tid); } while (0)
    asm volatile("; ==== PHASE 0" : "+v"(tid)); STAMP(0); if (IN(0)) { for (int rep_ = 0; rep_ < REP0; ++rep_) prologue(a, lds, tid); } SEAM(0);
    asm volatile("; ==== PHASE 1" : "+v"(tid)); STAMP(1); if (IN(1)) { for (int rep_ = 0; rep_ < REP1; ++rep_) GEMM(EpiZ, ws + WS_HBB, ws + W_EVIN, EV_NP, 1024, (pg8::bf16_t*)(ws + WS_Z), EV_NP, rsq); } SEAM(1); DBGCUT(1, ws + WS_Z, EV_NP, DBG_COL);
    asm volatile("; ==== PHASE 2" : "+v"(tid)); STAMP(2); if (IN(2)) { for (int rep_ = 0; rep_ < REP2; ++rep_) even_post(a, lds, tid); } SEAM(2); DBGCUT(2, ws + WS_QI, 512, 0);
    asm volatile("; ==== PHASE 3" : "+v"(tid)); STAMP(3); if (IN(3)) { for (int rep_ = 0; rep_ < REP3; ++rep_) idx_phase(lds, (const bf16*)(ws + WS_QI), (const bf16*)(ws + WS_KI), (const float*)(ws + WS_WI), (u64*)(ws + WS_MASK), tid); } SEAM(3);
    asm volatile("; ==== PHASE 4" : "+v"(tid)); STAMP(4); if (IN(4)) { for (int rep_ = 0; rep_ < REP4; ++rep_) attn_phase(lds, (const bf16*)(ws + WS_QP), (const bf16*)(ws + WS_KP), (const bf16*)(ws + WS_Z), (const u64*)(ws + WS_MASK), (bf16*)(ws + WS_Y), tid); } SEAM(4); DBGCUT(4, ws + WS_Y, 1024, 0);
    for (int l = 0; l < 2; ++l) {
        const int pb = 5 + 7 * l;
        bf16* hb1 = (bf16*)(ws + (l == 0 ? WS_HBA : WS_HBB)); bf16* hb2 = (bf16*)(ws + (l == 0 ? WS_HBB : WS_HBA));
        float* rs1 = rsq + (size_t)(1 + 3 * l) * M; float* rs2 = rs1 + M; float* rs3 = rs2 + M; float* rsE = rsq + (size_t)(6 + l) * M;
        asm volatile("; ==== PHASE pb" : "+v"(tid)); STAMP(pb); if (IN(pb)) { convert_p((const float*)a.in[1] + (size_t)l * M * 256, (bf16*)(ws + WS_PB), tid);
            GEMM(EpiResB, ws + WS_Y, ws + (l == 0 ? W_EVOUT : W_ODOUT), 1024, 1024, (l == 0 ? (const float*)a.in[0] : (const float*)nullptr), (const pg8::bf16_t*)(l == 0 ? nullptr : hb2), (pg8::bf16_t*)hb1, rs1); } SEAM(pb);
        asm volatile("; ==== PHASE pb1" : "+v"(tid)); STAMP(pb + 1); if (IN(pb + 1)) {
#ifndef NO_SWIGLU
 GEMM(EpiSwiGLU, hb1, ws + W_GU + (size_t)l * 2 * DFF * 1024 * 2, 2 * DFF, 1024, (pg8::bf16_t*)(ws + WS_HID), rs1);
#endif
#ifndef NO_ERAW
            GEMM(EpiEraw, ws + WS_PB, ws + W_PJ + (size_t)l * 256 * 1024 * 2, 1024, 256, (pg8::bf16_t*)(ws + WS_ERAW), rsE);
#endif
 } SEAM(pb + 1);
        asm volatile("; ==== PHASE pb2" : "+v"(tid)); STAMP(pb + 2); if (IN(pb + 2)) { GEMM(EpiResB, ws + WS_HID, ws + W_DN + (size_t)l * DFF * 1024 * 2, 1024, DFF, (const float*)nullptr, (const pg8::bf16_t*)hb1, (pg8::bf16_t*)hb2, rs2); } SEAM(pb + 2);
        asm volatile("; ==== PHASE pb3" : "+v"(tid)); STAMP(pb + 3); if (IN(pb + 3)) { GEMM(EpiPleB, hb2, ws + W_PG + (size_t)l * 1024 * 1024 * 2, 1024, 1024, (const pg8::bf16_t*)hb2, (l == 0 ? (float*)nullptr : a.out), (pg8::bf16_t*)(l == 0 ? hb1 : nullptr), (l == 0 ? rs3 : nullptr),
                               (const pg8::bf16_t*)(ws + WS_ERAW), rsE, rs2, (const float*)a.in[22] + l * 1024); } SEAM(pb + 3);
        if (l == 0) {
            asm volatile("; ==== PHASE 9" : "+v"(tid)); STAMP(9); if (IN(9)) { GEMM(EpiZ, hb1, ws + W_ODIN, OD_NP, 1024, (pg8::bf16_t*)(ws + WS_Z), OD_NP, rs3); } SEAM(9); DBGCUT(9, ws + WS_Z, OD_NP, DBG_COL);
            asm volatile("; ==== PHASE 10" : "+v"(tid)); STAMP(10); if (IN(10)) { for (int rep_ = 0; rep_ < REP10; ++rep_) dn_prep(a, lds, tid); } SEAM(10);
#if defined(DBG_CUT) && DBG_CUT == 10
            { asm volatile("s_waitcnt vmcnt(0) lgkmcnt(0)" ::: "memory"); cg::this_grid().sync();
              const bf16* s1_ = (const bf16*)(ws + WS_KPD); const bf16* s2_ = (const bf16*)(ws + WS_VBD); const float* s3_ = (const float*)(ws + WS_GCUM); float* dst_ = a.out;
              for (size_t i_ = (size_t)blockIdx.x * 512 + tid; i_ < (size_t)M * 1024; i_ += (size_t)gridDim.x * 512) dst_[i_] = bf2f(s1_[i_]) + 3.f * bf2f(s2_[i_]) + (i_ < (size_t)M * 16 ? s3_[i_] : 0.f);
              return; }
#endif
            asm volatile("; ==== PHASE 11" : "+v"(tid)); STAMP(11); if (IN(11)) { dn_scan(a, lds, tid); } SEAM(11); DBGCUT(11, ws + WS_Y, 1024, 0);
        }
    }
#if defined(DBG_TS)
    xcd_barrier(bar); STAMP(16);
    asm volatile("s_waitcnt vmcnt(0)" ::: "memory"); xcd_barrier(bar);
    { const volatile unsigned long long* ts_ = (const volatile unsigned long long*)(ws + WS_BAR + 65536);
      const float val_ = (float)(long long)(__hip_atomic_load((const unsigned long long*)ts_ + DBG_TS + 1, __ATOMIC_RELAXED, __HIP_MEMORY_SCOPE_AGENT) - __hip_atomic_load((const unsigned long long*)ts_ + DBG_TS, __ATOMIC_RELAXED, __HIP_MEMORY_SCOPE_AGENT)) * 0.01f;
      const float valq_ = 32.f * __builtin_rintf(val_ * (1.f / 32.f));
      float* dst_ = a.out; for (size_t i_ = (size_t)blockIdx.x * 512 + tid; i_ < (size_t)M * 1024; i_ += (size_t)gridDim.x * 512) dst_[i_] = valq_; }
#endif
#undef IN
#undef SEAM
#undef GEMM
#undef a
#undef ws
#undef rsq
}

extern "C" void kernel_launch(void* const* d_in, const int* in_sizes, int n_in, void* d_out, int out_size, void* d_ws, size_t ws_size, hipStream_t stream) {
    static int grid = 0;
    if (grid == 0) {
        if (n_in != 25 || out_size != M * DM || ws_size < WS_END) { fprintf(stderr, "kernel_launch: unexpected problem (n_in %d, out %d, ws %zu)\n", n_in, out_size, ws_size); grid = -1; return; }
        int dev = 0, cus = 0, per_cu = 0;
        hipGetDevice(&dev); hipDeviceGetAttribute(&cus, hipDeviceAttributeMultiprocessorCount, dev);
        hipFuncSetAttribute((const void*)mega, hipFuncAttributeMaxDynamicSharedMemorySize, LDS_BYTES);
        hipOccupancyMaxActiveBlocksPerMultiprocessor(&per_cu, (const void*)mega, 512, LDS_BYTES);
        (void)hipGetLastError();
        if (per_cu < 1) { fprintf(stderr, "kernel_launch: occupancy query says %d blocks per CU\n", per_cu); per_cu = 1; }
        grid = cus;
        if (grid > 256) grid = 256;
    }
    if (grid < 0) return;
    Args a{};
    for (int i = 0; i < 25; ++i) a.in[i] = d_in[i];
    a.out = (float*)d_out; a.ws = (unsigned char*)d_ws; a.ph_lo = 0; a.ph_hi = NPH; a.coop = 1; a.pad = 0;
    if (hipMemsetAsync((char*)d_ws + WS_BAR, 0, 16384, stream) != hipSuccess) { fprintf(stderr, "kernel_launch: memset failed\n"); return; }
#if defined(MK_MULTI)
    for (int p = 0; p < NPH; ++p) { a.ph_lo = p; a.ph_hi = p + 1; hipLaunchKernelGGL(mega, dim3(grid), dim3(512), LDS_BYTES, stream, a); }
#else
    void* args[] = {&a};
    hipError_t e = hipLaunchCooperativeKernel((const void*)mega, dim3(grid), dim3(512), args, LDS_BYTES, stream);
    if (e != hipSuccess) fprintf(stderr, "kernel_launch: cooperative launch failed: %s (grid %d)\n", hipGetErrorString(e), grid);
#endif
}
```
